# Optimizing an MI355X kernel written in HIP

```python
import jax, jax.numpy as jnp
from jax import lax
import numpy as np

D_MODEL = 1024
BATCH = 16
SEQ = 2048
DEPTH = 2

GRID_W = 64
CTX_LEN = 256
BRANCH_W = D_MODEL // 4
D_MIX = 4 * BRANCH_W

MLA_V_DIM = 64
MLA_HEADS = BRANCH_W // MLA_V_DIM
MLA_NOPE_DIM = 64
MLA_ROPE_DIM = 32
MLA_QK_DIM = MLA_NOPE_DIM + MLA_ROPE_DIM
MLA_Q_RANK = 192
MLA_KV_RANK = 128

GQA_HEAD_DIM = 64
GQA_HEADS = BRANCH_W // GQA_HEAD_DIM
GQA_KV_HEADS = GQA_HEADS // 2

CHUNK = 128
CM_GROUPS = 4
CM_GDIM = BRANCH_W // CM_GROUPS

FNET_GROUPS = 4

Q_BLOCK = 128
ROPE_THETA = 10000.0
EPS = 1e-6

IN_SPLITS = (
    MLA_Q_RANK, MLA_KV_RANK, MLA_ROPE_DIM, BRANCH_W,
    GQA_HEADS * GQA_HEAD_DIM, GQA_KV_HEADS * GQA_HEAD_DIM, GQA_KV_HEADS * GQA_HEAD_DIM, BRANCH_W,
    BRANCH_W, BRANCH_W, BRANCH_W,
    BRANCH_W, BRANCH_W,
)
IN_WIDTH = sum(IN_SPLITS)
SPLIT_IDX = tuple(sum(IN_SPLITS[: i + 1]) for i in range(len(IN_SPLITS) - 1))

kernel_name = "hybrid_parallel_groups_mla_gqa_gmlp_fnet_dit"


def rmsnorm(x, g):
    xf = x.astype(jnp.float32)
    y = xf * lax.rsqrt(jnp.mean(xf * xf, axis=-1, keepdims=True) + EPS)
    return (y * g.astype(jnp.float32)).astype(x.dtype)


def layernorm(x, g, b):
    xf = x.astype(jnp.float32)
    mu = jnp.mean(xf, axis=-1, keepdims=True)
    var = jnp.mean(jnp.square(xf - mu), axis=-1, keepdims=True)
    y = (xf - mu) * lax.rsqrt(var + EPS)
    return (y * g.astype(jnp.float32) + b.astype(jnp.float32)).astype(x.dtype)


def rope_1d(x, pos):
    d = x.shape[-1]
    inv = ROPE_THETA ** (-jnp.arange(0, d, 2, dtype=jnp.float32) / d)
    ang = pos.astype(jnp.float32)[:, None] * inv[None, :]
    cos = jnp.concatenate([jnp.cos(ang), jnp.cos(ang)], -1)[:, None, :]
    sin = jnp.concatenate([jnp.sin(ang), jnp.sin(ang)], -1)[:, None, :]
    xf = x.astype(jnp.float32)
    rot = jnp.concatenate([-xf[..., d // 2:], xf[..., : d // 2]], -1)
    return (xf * cos + rot * sin).astype(x.dtype)


def axial_rope(x, row, col):
    half = x.shape[-1] // 2
    return jnp.concatenate([rope_1d(x[..., :half], row), rope_1d(x[..., half:], col)], -1)


def attend(q, k, v):
    B, S, H, dk = q.shape
    Hk, dv = k.shape[2], v.shape[-1]
    G = H // Hk
    scale = dk ** -0.5
    nb = S // Q_BLOCK
    qb = q.reshape(B, nb, Q_BLOCK, Hk, G, dk).transpose(1, 0, 2, 3, 4, 5)

    def block(qblk):
        s = jnp.einsum("bqkgd,blkd->bkgql", qblk, k).astype(jnp.float32) * scale
        pr = jax.nn.softmax(s, axis=-1).astype(v.dtype)
        return jnp.einsum("bkgql,blkd->bqkgd", pr, v)

    out = lax.map(block, qb)
    return out.transpose(1, 0, 2, 3, 4, 5).reshape(B, S, H * dv)


def attn_features(parts, p, row, col):
    cq, ckv, kr = parts[0], parts[1], parts[2]
    q2, k2, v2 = parts[4], parts[5], parts[6]
    B, S, _ = cq.shape
    q1 = (rmsnorm(cq, p["mla_q_norm"]) @ p["mla_w_uq"]).reshape(B, S, MLA_HEADS, MLA_QK_DIM)
    kv = (rmsnorm(ckv, p["mla_kv_norm"]) @ p["mla_w_ukv"]).reshape(B, S, MLA_HEADS, MLA_NOPE_DIM + MLA_V_DIM)
    k_nope, v1 = kv[..., :MLA_NOPE_DIM], kv[..., MLA_NOPE_DIM:]
    k_rope = jnp.broadcast_to(kr[:, :, None, :], (B, S, MLA_HEADS, MLA_ROPE_DIM))
    k1 = jnp.concatenate([k_nope, k_rope], -1)
    q1 = rmsnorm(q1, p["mla_qn"])
    k1 = rmsnorm(k1, p["mla_kn"])
    q2 = rmsnorm(q2.reshape(B, S, GQA_HEADS, GQA_HEAD_DIM), p["gqa_qn"])
    k2 = rmsnorm(k2.reshape(B, S, GQA_KV_HEADS, GQA_HEAD_DIM), p["gqa_kn"])
    v2 = v2.reshape(B, S, GQA_KV_HEADS, GQA_HEAD_DIM)
    if row is not None:
        q1 = jnp.concatenate([q1[..., :MLA_NOPE_DIM], axial_rope(q1[..., MLA_NOPE_DIM:], row, col)], -1)
        k1 = jnp.concatenate([k1[..., :MLA_NOPE_DIM], axial_rope(k1[..., MLA_NOPE_DIM:], row, col)], -1)
        q2 = axial_rope(q2, row, col)
        k2 = axial_rope(k2, row, col)
    return q1, k1, v1, q2, k2, v2


def chunk_mlp(u, v, p):
    B, S, W = v.shape
    vn = layernorm(v, p["cm_ln_g"], p["cm_ln_b"]).reshape(B, S // CHUNK, CHUNK, CM_GROUPS, CM_GDIM)
    s = jnp.einsum("gpq,bnqgc->bnpgc", p["cm_w_s"], vn) + p["cm_b_s"].T[:, :, None]
    return u * s.reshape(B, S, W)


def fourier(f, w_f):
    B, S, W = f.shape
    ff = f.astype(jnp.float32).reshape(B, S, FNET_GROUPS, W // FNET_GROUPS)
    y = jnp.fft.fft2(ff, axes=(1, 3), norm="ortho").real.astype(f.dtype).reshape(B, S, W)
    return y @ w_f


def merge(parts, att_a, att_b, p):
    ga, gb, u, vc, gc, f, gd = parts[3], parts[7], parts[8], parts[9], parts[10], parts[11], parts[12]
    ya = att_a * jax.nn.silu(ga)
    yb = att_b * jax.nn.silu(gb)
    yc = chunk_mlp(u, vc, p) * jax.nn.silu(gc)
    yd = fourier(f, p["fnet_w"]) * jax.nn.silu(gd)
    return jnp.concatenate([ya, yb, yc, yd], -1) @ p["w_out"]


def layer(x, ctx, c, c_ctx, p, row, col, update_ctx):
    sh, sc, gt = jnp.split(jax.nn.silu(c) @ p["w_mod"] + p["b_mod"], 3, axis=-1)
    shc, scc, gtc = jnp.split(jax.nn.silu(c_ctx) @ p["w_mod"] + p["b_mod"], 3, axis=-1)
    hx = rmsnorm(x, p["norm_g"]) * (1.0 + sc[:, None, :]) + sh[:, None, :]
    hc = rmsnorm(ctx, p["norm_g"]) * (1.0 + scc) + shc
    px = jnp.split(hx @ p["w_in"], SPLIT_IDX, axis=-1)
    pc = jnp.split(hc @ p["w_in"], SPLIT_IDX, axis=-1)
    qa_x, ka_x, va_x, qb_x, kb_x, vb_x = attn_features(px, p, row, col)
    qa_c, ka_c, va_c, qb_c, kb_c, vb_c = attn_features(pc, p, None, None)
    att_a = attend(qa_x, jnp.concatenate([ka_x, ka_c], 1), jnp.concatenate([va_x, va_c], 1))
    att_b = attend(qb_x, jnp.concatenate([kb_x, kb_c], 1), jnp.concatenate([vb_x, vb_c], 1))
    x_new = x + gt[:, None, :] * merge(px, att_a, att_b, p)
    if update_ctx:
        att_ac = attend(qa_c, ka_c, va_c)
        att_bc = attend(qb_c, kb_c, vb_c)
        ctx = ctx + gtc * merge(pc, att_ac, att_bc, p)
    return x_new, ctx


def setup_inputs(seed: int = 0) -> dict:
    key = jax.random.key(seed)
    ks = jax.random.split(key, 24)
    f32 = jnp.float32

    def nrm(k, shape, scale):
        return jax.random.normal(k, shape, f32) * scale

    def gain(k, shape):
        return 1.0 + 0.02 * jax.random.normal(k, shape, f32)

    L, D = DEPTH, D_MODEL
    return {
        "x": nrm(ks[0], (BATCH, SEQ, D), 1.0),
        "c": nrm(ks[1], (BATCH, D), 1.0),
        "ctx": nrm(ks[2], (BATCH, CTX_LEN, D), 1.0),
        "c_ctx": nrm(ks[3], (D,), 1.0),
        "norm_g": gain(ks[4], (L, D)),
        "w_mod": nrm(ks[5], (L, D, 3 * D), 0.5 * D ** -0.5),
        "b_mod": nrm(ks[6], (L, 3 * D), 0.02),
        "w_in": nrm(ks[7], (L, D, IN_WIDTH), D ** -0.5),
        "mla_q_norm": gain(ks[8], (L, MLA_Q_RANK)),
        "mla_w_uq": nrm(ks[9], (L, MLA_Q_RANK, MLA_HEADS * MLA_QK_DIM), MLA_Q_RANK ** -0.5),
        "mla_kv_norm": gain(ks[10], (L, MLA_KV_RANK)),
        "mla_w_ukv": nrm(ks[11], (L, MLA_KV_RANK, MLA_HEADS * (MLA_NOPE_DIM + MLA_V_DIM)), MLA_KV_RANK ** -0.5),
        "mla_qn": gain(ks[12], (L, MLA_QK_DIM)),
        "mla_kn": gain(ks[13], (L, MLA_QK_DIM)),
        "gqa_qn": gain(ks[14], (L, GQA_HEAD_DIM)),
        "gqa_kn": gain(ks[15], (L, GQA_HEAD_DIM)),
        "cm_ln_g": gain(ks[16], (L, BRANCH_W)),
        "cm_ln_b": nrm(ks[17], (L, BRANCH_W), 0.02),
        "cm_w_s": nrm(ks[18], (L, CM_GROUPS, CHUNK, CHUNK), CHUNK ** -0.5),
        "cm_b_s": gain(ks[19], (L, CM_GROUPS, CHUNK)),
        "fnet_w": nrm(ks[20], (L, BRANCH_W, BRANCH_W), BRANCH_W ** -0.5),
        "w_out": nrm(ks[21], (L, D_MIX, D), D_MIX ** -0.5),
    }


def reference(x, c, ctx, c_ctx, norm_g, w_mod, b_mod, w_in, mla_q_norm, mla_w_uq, mla_kv_norm,
              mla_w_ukv, mla_qn, mla_kn, gqa_qn, gqa_kn, cm_ln_g, cm_ln_b, cm_w_s, cm_b_s,
              fnet_w, w_out):
    S = x.shape[1]
    ROWS = S // GRID_W
    row = jnp.repeat(jnp.arange(ROWS, dtype=jnp.int32), GRID_W)
    col = jnp.tile(jnp.arange(GRID_W, dtype=jnp.int32), ROWS)
    for l in range(DEPTH):
        p = dict(norm_g=norm_g[l], w_mod=w_mod[l], b_mod=b_mod[l], w_in=w_in[l],
                 mla_q_norm=mla_q_norm[l], mla_w_uq=mla_w_uq[l], mla_kv_norm=mla_kv_norm[l],
                 mla_w_ukv=mla_w_ukv[l], mla_qn=mla_qn[l], mla_kn=mla_kn[l],
                 gqa_qn=gqa_qn[l], gqa_kn=gqa_kn[l], cm_ln_g=cm_ln_g[l], cm_ln_b=cm_ln_b[l],
                 cm_w_s=cm_w_s[l], cm_b_s=cm_b_s[l], fnet_w=fnet_w[l], w_out=w_out[l])
        x, ctx = layer(x, ctx, c, c_ctx, p, row, col, l < DEPTH - 1)
    return x
```

```cpp
#include <hip/hip_runtime.h>
#include <hip/hip_cooperative_groups.h>
#include <stdint.h>
#include <stdio.h>
namespace cg = cooperative_groups;

#ifndef PER_PHASE_LAUNCH
#define PER_PHASE_LAUNCH 0
#endif

#define DI __device__ __forceinline__
DI int otid() { int t = threadIdx.x; asm volatile("" : "+v"(t)); return t; }
typedef unsigned short bf16_t;
using bf16x8 = __attribute__((ext_vector_type(8))) short;
using f32x16 = __attribute__((ext_vector_type(16))) float;
using f32x4  = __attribute__((ext_vector_type(4))) float;
using f32x2  = __attribute__((ext_vector_type(2))) float;
using u32x4  = __attribute__((ext_vector_type(4))) unsigned;
using u32x2  = __attribute__((ext_vector_type(2))) unsigned;
typedef __bf16 bf16x2_t __attribute__((ext_vector_type(2)));

constexpr int NB = 16, SEQ = 2048, CL = 256, T = 2304, D = 1024, M = NB * T, NIN = 2656, NINP = 2816;
constexpr int O_CQ = 0, O_CKV = 192, O_KR = 320, O_GA = 352, O_Q2 = 608, O_K2 = 864, O_V2 = 992, O_GB = 1120,
              O_U = 1376, O_V = 1632, O_GC = 1888, O_F = 2144, O_GD = 2400;
constexpr int NTHR = 512;
constexpr int HALF_LDS = 69632, LDS_MAIN = 2 * HALF_LDS, LDS_BYTES = LDS_MAIN + 256;

constexpr size_t al256(size_t x) { return (x + 255) & ~(size_t)255; }
constexpr size_t WS_MOD  = 0;
constexpr size_t WS_ROPG = al256(WS_MOD + 2 * 17 * 3072 * 4);
constexpr size_t WS_ROPM = al256(WS_ROPG + 64 * 16 * 2 * 4);
constexpr size_t WS_SBND = al256(WS_ROPM + 64 * 8 * 2 * 4);
constexpr size_t WS_WIN  = al256(WS_SBND + 256);
constexpr size_t WS_WUQ  = al256(WS_WIN + (size_t)2 * NINP * 1024 * 2);
constexpr size_t WS_WUKV = al256(WS_WUQ + 2 * 384 * 192 * 2);
constexpr size_t WS_WF   = al256(WS_WUKV + 2 * 512 * 128 * 2);
constexpr size_t WS_WOUT = al256(WS_WF + 2 * 256 * 256 * 2);
constexpr size_t WS_WS   = al256(WS_WOUT + (size_t)2 * 1024 * 1024 * 2);
constexpr size_t WS_CM   = al256(WS_WS + 2 * 4 * 128 * 128 * 2);
constexpr size_t WS_DLAT = al256(WS_CM + 128 * 64 * 2);
constexpr size_t WS_DCTX = al256(WS_DLAT + (size_t)2048 * 2048 * 2);
constexpr size_t WS_R1   = al256(WS_DCTX + 256 * 512 * 2);
constexpr size_t R1_CQN = 0, R1_CKVN = (size_t)M * 192 * 2, R1_Q1R = R1_CKVN + (size_t)M * 128 * 2, R1_KR = R1_Q1R + (size_t)M * 384 * 2;
constexpr size_t WS_P    = al256(WS_R1 + (size_t)M * 1024 * 2);
constexpr size_t WS_FT   = al256(WS_P + (size_t)M * NIN * 2);
constexpr size_t WS_FTF  = al256(WS_FT + (size_t)NB * 256 * 4096 * 2);
constexpr size_t WS_FTC  = al256(WS_FTF + (size_t)NB * 256 * 2048 * 2);
constexpr size_t WS_YD   = al256(WS_FTC + (size_t)NB * 256 * 512 * 2);
constexpr size_t WS_QA   = al256(WS_YD + (size_t)M * 256 * 2);
constexpr size_t WS_KA   = al256(WS_QA + (size_t)M * 384 * 2);
constexpr size_t WS_VAT  = al256(WS_KA + (size_t)M * 384 * 2);
constexpr size_t WS_QB   = al256(WS_VAT + (size_t)M * 256 * 2);
constexpr size_t WS_KB   = al256(WS_QB + (size_t)M * 256 * 2);
constexpr size_t WS_VBT  = al256(WS_KB + (size_t)M * 128 * 2);
constexpr size_t WS_VNT  = al256(WS_VBT + (size_t)M * 128 * 2);
constexpr size_t WS_CTX1 = al256(WS_VNT + (size_t)M * 256 * 2 + 65536);
constexpr size_t WS_BAR  = al256(WS_CTX1 + (size_t)NB * CL * 1024 * 4);
constexpr size_t WS_CNT  = al256(WS_BAR + 3456 * 4);
constexpr size_t WS_END  = al256(WS_CNT + 2 * 288 * 4);
constexpr size_t WS_ZERO_BYTES = WS_END - WS_BAR;
static_assert(R1_KR + (size_t)M * 256 * 2 <= (size_t)M * 1024 * 2, "temp region");
static_assert(WS_END <= (size_t)512 * 1024 * 1024, "workspace");

struct Params {
  const float *x, *c, *ctx, *c_ctx, *norm_g, *w_mod, *b_mod, *w_in, *mla_q_norm, *mla_w_uq, *mla_kv_norm, *mla_w_ukv,
              *mla_qn, *mla_kn, *gqa_qn, *gqa_kn, *cm_ln_g, *cm_ln_b, *cm_w_s, *cm_b_s, *fnet_w, *w_out;
  float* out; unsigned char* ws; int ph_lo, ph_hi;
};
typedef const __attribute__((address_space(4))) Params* KP;

DI unsigned cvtpk(float lo, float hi) { f32x2 v = {lo, hi}; bf16x2_t b = __builtin_convertvector(v, bf16x2_t); return __builtin_bit_cast(unsigned, b); }
DI float bflo(unsigned u) { return __uint_as_float(u << 16); }
DI float bfhi(unsigned u) { return __uint_as_float(u & 0xffff0000u); }
DI bf16_t f2bf(float f) { return (bf16_t)(cvtpk(f, 0.f) & 0xffffu); }
DI float silu(float x) { return x / (1.f + __expf(-x)); }
DI f32x4 unpack4(u32x2 v) { f32x4 r = {bflo(v.x), bfhi(v.x), bflo(v.y), bfhi(v.y)}; return r; }
DI u32x2 pack4(f32x4 v) { u32x2 r = {cvtpk(v[0], v[1]), cvtpk(v[2], v[3])}; return r; }
DI float dpp_f(float v, const int ctrl_sel) {
  const int i = __float_as_int(v); int r;
  if (ctrl_sel == 0) r = __builtin_amdgcn_update_dpp(0, i, 0xB1, 0xF, 0xF, true);
  else if (ctrl_sel == 1) r = __builtin_amdgcn_update_dpp(0, i, 0x4E, 0xF, 0xF, true);
  else if (ctrl_sel == 2) r = __builtin_amdgcn_update_dpp(0, i, 0x124, 0xF, 0xF, true);
  else r = __builtin_amdgcn_update_dpp(0, i, 0x128, 0xF, 0xF, true);
  return __int_as_float(r);
}
DI float red16(float v) { v += dpp_f(v, 0); v += dpp_f(v, 1); v += dpp_f(v, 2); v += dpp_f(v, 3); return v; }
DI float red64(float v) { v = red16(v); v += __shfl_xor(v, 16); v += __shfl_xor(v, 32); return v; }
#define MFMA32(a, b, c) __builtin_amdgcn_mfma_f32_32x32x16_bf16((a), (b), (c), 0, 0, 0)


#define XB_TMO      128
#define XB_XCNT(j)  (256  + 64 * (j))
#define XB_XSUB(j)  (1280 + 64 * (j))
#define XB_XGEN(j)  (2304 + 64 * (j))
#define XB_TOP      3328
#define XB_TOPGEN   3392
#define XCD_BAR_WORDS 3456
#define XB_SPIN_CAP (1u << 22)
#define LAS __attribute__((address_space(3)))
DI unsigned xb_ld(unsigned* p)              { return __hip_atomic_load(p, __ATOMIC_RELAXED, __HIP_MEMORY_SCOPE_AGENT); }
DI unsigned xb_add(unsigned* p, unsigned v) { return __hip_atomic_fetch_add(p, v, __ATOMIC_RELAXED, __HIP_MEMORY_SCOPE_AGENT); }
DI unsigned xb_xcc_id() { return (unsigned)__builtin_amdgcn_s_getreg((3 << 11) | 20) & 0xFu; }
#define XB_SPIN(cond, bar) do { unsigned _sp = 0; while (cond) { __builtin_amdgcn_s_sleep(1); \
    if ((++_sp & 255u) == 0u) { if (xb_ld(&(bar)[XB_TMO])) break; if (_sp > XB_SPIN_CAP) { atomicAdd(&(bar)[XB_TMO], 1u); break; } } } } while (0)
struct XcdBarrier { unsigned* bar; unsigned x; volatile LAS unsigned* st; };
DI XcdBarrier xcd_barrier_post(unsigned* bar, volatile LAS unsigned* st) {
  XcdBarrier b; b.bar = bar; b.x = xb_xcc_id(); b.st = st;
  if (threadIdx.x == 0) (void)xb_add(&bar[XB_XCNT(b.x)], 1u);
  return b;
}
DI void xcd_barrier_complete(unsigned* bar, unsigned x, unsigned& nloc, unsigned& nx) {
  const unsigned G = gridDim.x * gridDim.y * gridDim.z;
  unsigned sum, cnt, mine, sp = 0u;
  for (;;) {
    sum = 0u; cnt = 0u; mine = 0u;
#pragma unroll
    for (unsigned j = 0; j < 16; ++j) { const unsigned c = xb_ld(&bar[XB_XCNT(j)]); sum += c; cnt += (c > 0u) ? 1u : 0u; mine = (j == x) ? c : mine; }
    if (sum == G) break;
    __builtin_amdgcn_s_sleep(1);
    if ((++sp & 255u) == 0u) { if (xb_ld(&bar[XB_TMO])) break; if (sp > XB_SPIN_CAP) { atomicAdd(&bar[XB_TMO], 1u); break; } }
  }
  nloc = mine > 0u ? mine : 1u; nx = cnt > 0u ? cnt : 1u;
}
DI void xcd_barrier(const XcdBarrier& b) {
  asm volatile("s_waitcnt vmcnt(0)" ::: "memory");
  __syncthreads();
  if (threadIdx.x == 0) {
    unsigned* bar = b.bar;
    __builtin_amdgcn_s_waitcnt(0);
    unsigned nloc = b.st[0], nx = b.st[1];
    if (nloc == 0u) { xcd_barrier_complete(bar, b.x, nloc, nx); b.st[0] = nloc; b.st[1] = nx; }
    const unsigned old = xb_add(&bar[XB_XSUB(b.x)], 1u);
    const unsigned gen = old / nloc;
    if (old + 1u == (gen + 1u) * nloc) {
      __builtin_amdgcn_fence(__ATOMIC_RELEASE, "agent");
      asm volatile("s_waitcnt vmcnt(0)" ::: "memory");
      const unsigned og = xb_add(&bar[XB_TOP], 1u);
      const unsigned tg = og / nx;
      if (og + 1u == (tg + 1u) * nx) xb_add(&bar[XB_TOPGEN], 1u);
      else XB_SPIN(xb_ld(&bar[XB_TOPGEN]) == tg, bar);
      __builtin_amdgcn_fence(__ATOMIC_ACQUIRE, "agent");
      xb_add(&bar[XB_XGEN(b.x)], 1u);
      asm volatile("s_waitcnt vmcnt(0)" ::: "memory");
    } else {
      XB_SPIN(xb_ld(&bar[XB_XGEN(b.x)]) == gen, bar);
      __builtin_amdgcn_fence(__ATOMIC_ACQUIRE, "agent");
      asm volatile("s_waitcnt vmcnt(0)" ::: "memory");
    }
  }
  __syncthreads();
}

template <class Epi>
DI void gemm_tile(const bf16_t* __restrict__ A, int lda, const bf16_t* __restrict__ Bt, int ldb, int K, char* lds, Epi epi) {
  const int tid_full = otid(); const int tid = tid_full & 255; lds += (tid_full >> 8) * HALF_LDS;
  const int lane = tid & 63, w = tid >> 6, l31 = lane & 31, h = lane >> 5;
  const int wr = w >> 1, wc = w & 1;
  const int lrow = tid >> 3, lch = (tid & 7) ^ ((tid >> 4) & 7);
  const bf16_t* ag = A + (size_t)lrow * lda + lch * 8;
  const bf16_t* bg = Bt + (size_t)lrow * ldb + lch * 8;
  const size_t a32 = (size_t)32 * lda, b32 = (size_t)32 * ldb;
  f32x16 acc[2][2];
#pragma unroll
  for (int i = 0; i < 2; ++i)
#pragma unroll
    for (int j = 0; j < 2; ++j)
#pragma unroll
      for (int e = 0; e < 16; ++e) acc[i][j][e] = 0.f;
  const int nk = K >> 6;
  const int rsw = (l31 >> 1) & 7;
  const int aoff = (wr * 64 + l31) * 128, boff = 16384 + (wc * 64 + l31) * 128;
  char* ldst = lds + tid * 16;
#define G_DMA(BUF, KT) { const int ko_ = (KT) * 64; char* nb_ = ldst + (BUF) * 32768; _Pragma("unroll") for (int i = 0; i < 4; ++i) { \
    __builtin_amdgcn_global_load_lds((const unsigned*)(ag + i * a32 + ko_), (__attribute__((address_space(3))) unsigned*)(nb_ + i * 4096), 16, 0, 0); \
    __builtin_amdgcn_global_load_lds((const unsigned*)(bg + i * b32 + ko_), (__attribute__((address_space(3))) unsigned*)(nb_ + 16384 + i * 4096), 16, 0, 0); } }
#define G_COMPUTE(BUF) { const char* cur = lds + (BUF) * 32768; bf16x8 af[2][2], bf[2][2]; \
    { const int off = ((0 + h) ^ rsw) << 4; _Pragma("unroll") for (int i = 0; i < 2; ++i) { af[0][i] = *(const bf16x8*)(cur + aoff + i * 4096 + off); bf[0][i] = *(const bf16x8*)(cur + boff + i * 4096 + off); } } \
    _Pragma("unroll") for (int ks = 0; ks < 4; ++ks) { \
      if (ks < 3) { const int off = ((2 * (ks + 1) + h) ^ rsw) << 4; _Pragma("unroll") for (int i = 0; i < 2; ++i) { af[(ks + 1) & 1][i] = *(const bf16x8*)(cur + aoff + i * 4096 + off); bf[(ks + 1) & 1][i] = *(const bf16x8*)(cur + boff + i * 4096 + off); } } \
      _Pragma("unroll") for (int i = 0; i < 2; ++i) _Pragma("unroll") for (int j = 0; j < 2; ++j) acc[i][j] = MFMA32(bf[ks & 1][j], af[ks & 1][i], acc[i][j]); } }
#define G_WAIT() { asm volatile("s_waitcnt vmcnt(0)" ::: "memory"); __syncthreads(); }
  G_DMA(0, 0);
  G_WAIT();
  for (int kt = 0; kt < nk; kt += 2) {
    if (kt + 1 < nk) G_DMA(1, kt + 1);
    G_COMPUTE(0);
    G_WAIT();
    if (kt + 1 < nk) {
      if (kt + 2 < nk) G_DMA(0, kt + 2);
      G_COMPUTE(1);
      G_WAIT();
    }
  }
#undef G_DMA
#undef G_COMPUTE
#undef G_WAIT
  float* ct = (float*)lds;
#pragma unroll
  for (int i = 0; i < 2; ++i)
#pragma unroll
    for (int j = 0; j < 2; ++j)
#pragma unroll
      for (int q = 0; q < 4; ++q) {
        f32x4 v = {acc[i][j][4 * q], acc[i][j][4 * q + 1], acc[i][j][4 * q + 2], acc[i][j][4 * q + 3]};
        *(f32x4*)(ct + (wr * 64 + i * 32 + l31) * 132 + wc * 64 + j * 32 + 8 * q + 4 * h) = v;
      }
  __syncthreads();
#pragma unroll 4
  for (int it = 0; it < 16; ++it) {
    const int idx = it * 256 + tid; const int row = idx >> 5, c4 = (idx & 31) * 4;
    f32x4 v = *(const f32x4*)(ct + row * 132 + c4);
    epi(row, c4, v);
  }
  __syncthreads();
}


DI int g8_lds_byte(int r, int c) { int st = (r >> 4) * 2 + (c >> 5), rr = r & 15, cc = c & 31, ob = rr * 64 + cc * 2; return st * 1024 + (ob ^ (((ob >> 9) & 1) << 5)); }
DI void g8_stage_rc(int b, int& R, int& C) { int st = b / 1024, sb = b % 1024, swz = sb ^ (((sb >> 9) & 1) << 5); R = (st >> 1) * 16 + swz / 64; C = (st & 1) * 32 + (swz % 64) / 2; }
template <class Epi>
DI void gemm256(const bf16_t* __restrict__ A, int lda, const bf16_t* __restrict__ Bt, int ldb, int K, char* lds, Epi epi) {
  constexpr int BK = 64, HALFR = 128, HTB = HALFR * BK * 2;
  const int tid = otid();
  const int wid = tid >> 6, lane = tid & 63, wr = wid >> 2, wc = wid & 3, fr = lane & 15, fq = lane >> 4;
  const int obs = (fr * 64 + fq * 16) ^ ((((fr * 64 + fq * 16) >> 9) & 1) << 5);
  const char* lrda = lds + wr * 8192 + obs; const char* lrdb = lds + 4 * HTB + wc * 4096 + obs;
  int sr0, sc0, sr1, sc1; g8_stage_rc(tid * 16, sr0, sc0); g8_stage_rc(tid * 16 + 8192, sr1, sc1);
  const unsigned oa0 = (unsigned)(sr0 * lda + sc0) * 2u, oa1 = (unsigned)(sr1 * lda + sc1) * 2u;
#define ob0 oa0
#define ob1 oa1
#define SA8(b, h) (lds + ((b) * 2 + (h)) * HTB)
#define SB8(b, h) (lds + (4 + (b) * 2 + (h)) * HTB)
#define STAGE_A(Pp, br, kt) { const char* g_ = (const char*)(A + (size_t)(br) * lda + (size_t)(kt) * BK); \
    __builtin_amdgcn_global_load_lds((const unsigned*)(g_ + oa0), (LAS unsigned*)((Pp) + tid * 16), 16, 0, 0); \
    __builtin_amdgcn_global_load_lds((const unsigned*)(g_ + oa1), (LAS unsigned*)((Pp) + tid * 16 + 8192), 16, 0, 0); }
#define STAGE_B(Pp, br, kt) { const char* g_ = (const char*)(Bt + (size_t)(br) * ldb + (size_t)(kt) * BK); \
    __builtin_amdgcn_global_load_lds((const unsigned*)(g_ + ob0), (LAS unsigned*)((Pp) + tid * 16), 16, 0, 0); \
    __builtin_amdgcn_global_load_lds((const unsigned*)(g_ + ob1), (LAS unsigned*)((Pp) + tid * 16 + 8192), 16, 0, 0); }
#define LDA8(dst, b, h) _Pragma("unroll") for (int m = 0; m < 4; ++m) _Pragma("unroll") for (int k = 0; k < 2; ++k) \
    dst[m][k] = *(const bf16x8*)(lrda + ((b) * 2 + (h)) * HTB + (2 * m + k) * 1024)
#define LDB8(dst, b, h) _Pragma("unroll") for (int n = 0; n < 2; ++n) _Pragma("unroll") for (int k = 0; k < 2; ++k) \
    dst[n][k] = *(const bf16x8*)(lrdb + ((b) * 2 + (h)) * HTB + (2 * n + k) * 1024)
#define MMA8(ai, bj, AT, BT) { __builtin_amdgcn_s_setprio(1); \
    _Pragma("unroll") for (int m = 0; m < 4; ++m) _Pragma("unroll") for (int n = 0; n < 2; ++n) _Pragma("unroll") for (int k = 0; k < 2; ++k) \
      acc[ai][bj][m][n] = __builtin_amdgcn_mfma_f32_16x16x32_bf16(AT[m][k], BT[n][k], acc[ai][bj][m][n], 0, 0, 0); \
    __builtin_amdgcn_s_setprio(0); }
#define WAIT_V(n) asm volatile("s_waitcnt vmcnt(" #n ")" ::: "memory")
#define WAIT_L(n) asm volatile("s_waitcnt lgkmcnt(" #n ")" ::: "memory")
#define BAR8 __builtin_amdgcn_s_barrier()
#define SCHED8 __builtin_amdgcn_sched_barrier(0)
  f32x4 acc[2][2][4][2];
#pragma unroll
  for (int a = 0; a < 2; ++a)
#pragma unroll
    for (int b = 0; b < 2; ++b)
#pragma unroll
      for (int m = 0; m < 4; ++m)
#pragma unroll
        for (int n = 0; n < 2; ++n) { f32x4 z = {0.f, 0.f, 0.f, 0.f}; acc[a][b][m][n] = z; }
  bf16x8 At[4][2], B0[2][2], B1[2][2];
  const int nt = K / BK;
  WAIT_V(0);
  __syncthreads();
  STAGE_B(SB8(0, 0), 0, 0); STAGE_A(SA8(0, 0), 0, 0);
  STAGE_B(SB8(0, 1), HALFR, 0); STAGE_A(SA8(0, 1), HALFR, 0);
  if (wr == 1) BAR8;
  WAIT_V(4); BAR8;
  STAGE_B(SB8(1, 0), 0, 1); STAGE_A(SA8(1, 0), 0, 1); STAGE_B(SB8(1, 1), HALFR, 1);
  WAIT_V(6); BAR8;
  for (int t = 0; t < nt - 2; t += 2) {
    LDB8(B0, 0, 0); SCHED8; LDA8(At, 0, 0); STAGE_A(SA8(1, 1), HALFR, t + 1);
    WAIT_L(8); BAR8; WAIT_L(0); MMA8(0, 0, At, B0); BAR8; SCHED8;
    LDB8(B1, 0, 1); STAGE_B(SB8(0, 0), 0, t + 2);
    BAR8; WAIT_L(0); MMA8(0, 1, At, B1); BAR8;
    LDA8(At, 0, 1); STAGE_A(SA8(0, 0), 0, t + 2);
    BAR8; WAIT_L(0); MMA8(1, 0, At, B0); BAR8; SCHED8;
    STAGE_B(SB8(0, 1), HALFR, t + 2);
    WAIT_V(6); BAR8; MMA8(1, 1, At, B1); BAR8;
    LDB8(B0, 1, 0); SCHED8; LDA8(At, 1, 0); STAGE_A(SA8(0, 1), HALFR, t + 2);
    WAIT_L(8); BAR8; WAIT_L(0); MMA8(0, 0, At, B0); BAR8; SCHED8;
    LDB8(B1, 1, 1); STAGE_B(SB8(1, 0), 0, t + 3);
    BAR8; WAIT_L(0); MMA8(0, 1, At, B1); BAR8;
    LDA8(At, 1, 1); STAGE_A(SA8(1, 0), 0, t + 3);
    BAR8; WAIT_L(0); MMA8(1, 0, At, B0); BAR8; SCHED8;
    STAGE_B(SB8(1, 1), HALFR, t + 3);
    WAIT_V(6); BAR8; MMA8(1, 1, At, B1); BAR8;
  }
  { LDB8(B0, 0, 0); LDA8(At, 0, 0); STAGE_A(SA8(1, 1), HALFR, nt - 1);
    BAR8; WAIT_L(0); MMA8(0, 0, At, B0); BAR8;
    LDB8(B1, 0, 1); BAR8; WAIT_L(0); MMA8(0, 1, At, B1); BAR8;
    LDA8(At, 0, 1); WAIT_V(4); BAR8; WAIT_L(0); MMA8(1, 0, At, B0); MMA8(1, 1, At, B1); BAR8; }
  { LDB8(B0, 1, 0); LDA8(At, 1, 0); WAIT_V(2); BAR8; WAIT_L(0); MMA8(0, 0, At, B0); BAR8;
    LDB8(B1, 1, 1); WAIT_V(0); BAR8; WAIT_L(0); MMA8(0, 1, At, B1); BAR8;
    LDA8(At, 1, 1); BAR8; WAIT_L(0); MMA8(1, 0, At, B0); MMA8(1, 1, At, B1); BAR8; }
  if (wr == 0) BAR8;
  float* ct = (float*)lds;
#pragma unroll
  for (int ai = 0; ai < 2; ++ai) {
    __syncthreads();
#pragma unroll
    for (int bj = 0; bj < 2; ++bj)
#pragma unroll
      for (int m = 0; m < 4; ++m)
#pragma unroll
        for (int n = 0; n < 2; ++n)
#pragma unroll
          for (int j = 0; j < 4; ++j) ct[(wr * 64 + m * 16 + fq * 4 + j) * 260 + bj * 128 + wc * 32 + n * 16 + fr] = acc[ai][bj][m][n][j];
    __syncthreads();
#pragma unroll 2
    for (int it = 0; it < 16; ++it) {
      const int idx = it * NTHR + tid; const int row = idx >> 6, c4 = (idx & 63) * 4;
      f32x4 v = *(const f32x4*)(ct + row * 260 + c4);
      epi(ai * 128 + row, c4, v);
    }
  }
  __syncthreads();
#undef ob0
#undef ob1
#undef SA8
#undef SB8
#undef STAGE_A
#undef STAGE_B
#undef LDA8
#undef LDB8
#undef MMA8
#undef WAIT_V
#undef WAIT_L
#undef BAR8
#undef SCHED8
}

template <int DQK, bool STATIC>
DI void attn_item(const bf16_t* __restrict__ Q, const bf16_t* __restrict__ Kp, const bf16_t* __restrict__ Vt, int nkeys, char* lds,
                  const bf16_t* __restrict__ Pg, bf16_t* __restrict__ Yg  , float mfix) {
  constexpr int KSTR = DQK * 2 + 16, VSTR = 136, KCH = DQK / 8, NKC = (64 * KCH) / 256, NQS = DQK / 16;
  constexpr int KBUF = 64 * KSTR, BUF = KBUF + 64 * VSTR;
  const int tid_full = otid(); const int tid = tid_full & 255; lds += (tid_full >> 8) * HALF_LDS;
  const int lane = tid & 63, w = tid >> 6, l31 = lane & 31, h = lane >> 5;
  bf16x8 qf[NQS];
#pragma unroll
  for (int ks = 0; ks < NQS; ++ks) qf[ks] = *(const bf16x8*)(Q + (size_t)(32 * w + l31) * DQK + 16 * ks + 8 * h);
  f32x16 o[2];
#pragma unroll
  for (int d = 0; d < 2; ++d)
#pragma unroll
    for (int e = 0; e < 16; ++e) o[d][e] = 0.f;
  float m_run = STATIC ? mfix : -1e30f, l_run = 0.f;
  u32x4 rk[NKC], rv[2];
  int koffg[NKC], koffl[NKC];
#pragma unroll
  for (int i = 0; i < NKC; ++i) { const int c = tid + 256 * i; const int key = c / KCH, part = c % KCH; koffg[i] = c * 8; koffl[i] = key * KSTR + part * 16; }
  const int vdv0 = tid >> 3, vpart = tid & 7;
  const bf16_t* vg = Vt + (size_t)vdv0 * T + vpart * 8;
  const int voffl = KBUF + vdv0 * VSTR + vpart * 16;
  const int nt = nkeys >> 6;
#pragma unroll
  for (int i = 0; i < NKC; ++i) rk[i] = *(const u32x4*)(Kp + koffg[i]);
#pragma unroll
  for (int i = 0; i < 2; ++i) rv[i] = *(const u32x4*)(vg + (size_t)i * 32 * T);
#pragma unroll
  for (int i = 0; i < NKC; ++i) *(u32x4*)(lds + koffl[i]) = rk[i];
#pragma unroll
  for (int i = 0; i < 2; ++i) { u32x2 a = {rv[i].x, rv[i].y}, b = {rv[i].z, rv[i].w}; *(u32x2*)(lds + voffl + i * 32 * VSTR) = a; *(u32x2*)(lds + voffl + i * 32 * VSTR + 8) = b; }
  __syncthreads();
  for (int j = 0; j < nt; ++j) {
    char* cur = lds + (j & 1) * BUF;
    const bool more = (j + 1 < nt);
    if (more) {
#pragma unroll
      for (int i = 0; i < NKC; ++i) rk[i] = *(const u32x4*)(Kp + (size_t)(j + 1) * 64 * DQK + koffg[i]);
#pragma unroll
      for (int i = 0; i < 2; ++i) rv[i] = *(const u32x4*)(vg + (size_t)i * 32 * T + (j + 1) * 64);
    }
    f32x16 s0, s1;
    bf16x8 kf[2][NQS];
#pragma unroll
    for (int kb = 0; kb < 2; ++kb)
#pragma unroll
      for (int ks = 0; ks < NQS; ++ks) kf[kb][ks] = *(const bf16x8*)(cur + (32 * kb + l31) * KSTR + (2 * ks + h) * 16);
    u32x4 vw[2][2][2];
#pragma unroll
    for (int kb = 0; kb < 2; ++kb)
#pragma unroll
      for (int s2 = 0; s2 < 2; ++s2)
#pragma unroll
        for (int d = 0; d < 2; ++d) {
          const char* vp = cur + KBUF + (32 * d + l31) * VSTR + (32 * kb + 16 * s2 + 4 * h) * 2;
          u32x2 v0 = *(const u32x2*)vp, v1 = *(const u32x2*)(vp + 16);
          u32x4 t4 = {v0.x, v0.y, v1.x, v1.y}; vw[kb][s2][d] = t4;
        }
#pragma unroll
    for (int e = 0; e < 16; ++e) { s0[e] = STATIC ? -mfix : 0.f; s1[e] = STATIC ? -mfix : 0.f; }
#pragma unroll
    for (int ks = 0; ks < NQS; ++ks) s0 = MFMA32(kf[0][ks], qf[ks], s0);
    if (!STATIC) {
      float mx = s0[0];
#pragma unroll
      for (int e = 1; e < 16; ++e) mx = fmaxf(mx, s0[e]);
      mx = fmaxf(mx, __shfl_xor(mx, 32));
      if (!__all(mx <= m_run + 8.f)) {
        const float m_new = fmaxf(m_run, mx);
        const float alpha = __builtin_amdgcn_exp2f(m_run - m_new);
        m_run = m_new; l_run *= alpha;
#pragma unroll
        for (int d = 0; d < 2; ++d)
#pragma unroll
          for (int e = 0; e < 16; ++e) o[d][e] *= alpha;
      }
    }
#pragma unroll
    for (int ks = 0; ks < NQS; ++ks) s1 = MFMA32(kf[1][ks], qf[ks], s1);
    {
      float ps = 0.f;
#pragma unroll
      for (int e = 0; e < 16; ++e) { float p = STATIC ? __builtin_amdgcn_exp2f(s0[e]) : __builtin_amdgcn_exp2f(s0[e] - m_run); s0[e] = p; ps += p; }
      l_run += ps;
    }
    if (!STATIC) {
      float mx = s1[0];
#pragma unroll
      for (int e = 1; e < 16; ++e) mx = fmaxf(mx, s1[e]);
      mx = fmaxf(mx, __shfl_xor(mx, 32));
      if (!__all(mx <= m_run + 8.f)) {
        const float m_new = fmaxf(m_run, mx);
        const float alpha = __builtin_amdgcn_exp2f(m_run - m_new);
        m_run = m_new; l_run *= alpha;
#pragma unroll
        for (int e = 0; e < 16; ++e) s0[e] *= alpha;
#pragma unroll
        for (int d = 0; d < 2; ++d)
#pragma unroll
          for (int e = 0; e < 16; ++e) o[d][e] *= alpha;
      }
    }
#pragma unroll
    for (int s2 = 0; s2 < 2; ++s2) {
      u32x4 pw = {cvtpk(s0[8 * s2], s0[8 * s2 + 1]), cvtpk(s0[8 * s2 + 2], s0[8 * s2 + 3]), cvtpk(s0[8 * s2 + 4], s0[8 * s2 + 5]), cvtpk(s0[8 * s2 + 6], s0[8 * s2 + 7])};
      bf16x8 pf = __builtin_bit_cast(bf16x8, pw);
#pragma unroll
      for (int d = 0; d < 2; ++d) o[d] = MFMA32(__builtin_bit_cast(bf16x8, vw[0][s2][d]), pf, o[d]);
    }
    {
      float ps = 0.f;
#pragma unroll
      for (int e = 0; e < 16; ++e) { float p = STATIC ? __builtin_amdgcn_exp2f(s1[e]) : __builtin_amdgcn_exp2f(s1[e] - m_run); s1[e] = p; ps += p; }
      l_run += ps;
    }
#pragma unroll
    for (int s2 = 0; s2 < 2; ++s2) {
      u32x4 pw = {cvtpk(s1[8 * s2], s1[8 * s2 + 1]), cvtpk(s1[8 * s2 + 2], s1[8 * s2 + 3]), cvtpk(s1[8 * s2 + 4], s1[8 * s2 + 5]), cvtpk(s1[8 * s2 + 6], s1[8 * s2 + 7])};
      bf16x8 pf = __builtin_bit_cast(bf16x8, pw);
#pragma unroll
      for (int d = 0; d < 2; ++d) o[d] = MFMA32(__builtin_bit_cast(bf16x8, vw[1][s2][d]), pf, o[d]);
    }
    if (more) {
      char* nxt = lds + ((j + 1) & 1) * BUF;
#pragma unroll
      for (int i = 0; i < NKC; ++i) *(u32x4*)(nxt + koffl[i]) = rk[i];
#pragma unroll
      for (int i = 0; i < 2; ++i) { u32x2 a = {rv[i].x, rv[i].y}, b = {rv[i].z, rv[i].w}; *(u32x2*)(nxt + voffl + i * 32 * VSTR) = a; *(u32x2*)(nxt + voffl + i * 32 * VSTR + 8) = b; }
    }
    __syncthreads();
  }
  const float lt = l_run + __shfl_xor(l_run, 32);
  const float inv = 1.f / lt;
  const size_t rq = (size_t)(32 * w + l31);
#pragma unroll
  for (int d = 0; d < 2; ++d)
#pragma unroll
    for (int q = 0; q < 4; ++q) {
      const int dv = 32 * d + 8 * q + 4 * h;
      f32x4 g = unpack4(*(const u32x2*)(Pg + rq * NIN + dv));
      f32x4 v = {o[d][4 * q] * inv * silu(g[0]), o[d][4 * q + 1] * inv * silu(g[1]), o[d][4 * q + 2] * inv * silu(g[2]), o[d][4 * q + 3] * inv * silu(g[3])};
      *(u32x2*)(Yg + rq * 1024 + dv) = pack4(v);
    }
}

DI void xpose_cvt(const float* __restrict__ src, bf16_t* __restrict__ dst, int K, int N, int Npad, bool perm_kv, size_t gtid, size_t gstride) {
  const size_t total = (size_t)Npad * (K >> 3);
#pragma nounroll
  for (size_t i = gtid; i < total; i += gstride) {
    const int n = (int)(i % Npad), kb = (int)(i / Npad);
    float v[8];
#pragma unroll
    for (int e = 0; e < 8; ++e) v[e] = (n < N) ? src[(size_t)(8 * kb + e) * N + n] : 0.f;
    int row = n;
    if (perm_kv) { const int hh = n >> 7, wv = n & 127; row = (wv < 64) ? (64 * hh + wv) : (256 + 64 * hh + (wv - 64)); }
    u32x4 o = {cvtpk(v[0], v[1]), cvtpk(v[2], v[3]), cvtpk(v[4], v[5]), cvtpk(v[6], v[7])};
    *(u32x4*)(dst + (size_t)row * K + 8 * kb) = o;
  }
}

DI void phase0(KP p, char* lds) {
  unsigned char* ws = p->ws; asm volatile("" : "+s"(ws));
  const int tid = otid();
  const size_t gtid = (size_t)blockIdx.x * NTHR + tid, gstride = (size_t)gridDim.x * NTHR;
  for (int l = 0; l < 2; ++l) {
    xpose_cvt(p->w_in + (size_t)l * 1024 * NIN, (bf16_t*)(ws + WS_WIN) + (size_t)l * NINP * 1024, 1024, NIN, NINP, false, gtid, gstride);
    xpose_cvt(p->mla_w_uq + (size_t)l * 192 * 384, (bf16_t*)(ws + WS_WUQ) + (size_t)l * 384 * 192, 192, 384, 384, false, gtid, gstride);
    xpose_cvt(p->mla_w_ukv + (size_t)l * 128 * 512, (bf16_t*)(ws + WS_WUKV) + (size_t)l * 512 * 128, 128, 512, 512, true, gtid, gstride);
    xpose_cvt(p->fnet_w + (size_t)l * 256 * 256, (bf16_t*)(ws + WS_WF) + (size_t)l * 256 * 256, 256, 256, 256, false, gtid, gstride);
    xpose_cvt(p->w_out + (size_t)l * 1024 * 1024, (bf16_t*)(ws + WS_WOUT) + (size_t)l * 1024 * 1024, 1024, 1024, 1024, false, gtid, gstride);
  }
  {
    const float* src = p->cm_w_s; bf16_t* dst = (bf16_t*)(ws + WS_WS);
    for (size_t i = gtid; i < (size_t)2 * 4 * 128 * 128 / 8; i += gstride) {
      f32x4 a = *(const f32x4*)(src + i * 8), b = *(const f32x4*)(src + i * 8 + 4);
      u32x4 o = {cvtpk(a[0], a[1]), cvtpk(a[2], a[3]), cvtpk(b[0], b[1]), cvtpk(b[2], b[3])};
      *(u32x4*)(dst + i * 8) = o;
    }
  }
  {
    bf16_t* dl = (bf16_t*)(ws + WS_DLAT);
#pragma nounroll
    for (size_t i = gtid; i < (size_t)2048 * 256; i += gstride) {
      const int sp = (int)(i >> 8), k8 = (int)(i & 255) * 8;
      float v[8];
#pragma unroll
      for (int e = 0; e < 8; ++e) { const int k = k8 + e, s = (k <= 1024) ? k : k - 1024; const int ph = (sp * s) & 2047; const float a = (float)ph * (1.f / 1024.f); v[e] = (k <= 1024) ? cospif(a) : -sinpif(a); }
      u32x4 o = {cvtpk(v[0], v[1]), cvtpk(v[2], v[3]), cvtpk(v[4], v[5]), cvtpk(v[6], v[7])};
      *(u32x4*)(dl + (size_t)sp * 2048 + k8) = o;
    }
    bf16_t* dc = (bf16_t*)(ws + WS_DCTX);
    for (size_t i = gtid; i < (size_t)256 * 64; i += gstride) {
      const int sp = (int)(i >> 6), k8 = (int)(i & 63) * 8;
      float v[8];
#pragma unroll
      for (int e = 0; e < 8; ++e) { const int k = k8 + e, s = k & 255; const int ph = (sp * s) & 255; const float a = (float)ph * (1.f / 128.f); v[e] = (k < 256) ? cospif(a) : -sinpif(a); }
      u32x4 o = {cvtpk(v[0], v[1]), cvtpk(v[2], v[3]), cvtpk(v[4], v[5]), cvtpk(v[6], v[7])};
      *(u32x4*)(dc + (size_t)sp * 512 + k8) = o;
    }
    bf16_t* cm = (bf16_t*)(ws + WS_CM);
    for (size_t i = gtid; i < (size_t)128 * 64; i += gstride) {
      const int n = (int)(i >> 6), c = (int)(i & 63);
      const int ph = (c * (n & 63)) & 63; const float a = (float)ph * (1.f / 32.f);
      cm[i] = f2bf((n < 64) ? cospif(a) : sinpif(a));
    }
    float* rg = (float*)(ws + WS_ROPG);
    for (size_t i = gtid; i < 64 * 16; i += gstride) {
      const int pos = (int)(i >> 4), j = (int)(i & 15);
      const float inv = powf(10000.f, -(float)j / 16.f); float sn, cs; sincosf((float)pos * inv, &sn, &cs);
      rg[2 * i] = cs; rg[2 * i + 1] = sn;
    }
    if (blockIdx.x == 0 && tid < 4) {
      const int l = tid >> 1, isb = tid & 1; const int d = isb ? 64 : 96;
      const float* gq = (isb ? p->gqa_qn : p->mla_qn) + l * d; const float* gk = (isb ? p->gqa_kn : p->mla_kn) + l * d;
      float mq = 0.f, mk = 0.f;
      for (int i = 0; i < d; ++i) { mq = fmaxf(mq, fabsf(gq[i])); mk = fmaxf(mk, fabsf(gk[i])); }
      ((float*)(ws + WS_SBND))[l * 2 + isb] = sqrtf((float)d) * mq * mk * 1.4426950408889634f;
    }
    float* rm = (float*)(ws + WS_ROPM);
    for (size_t i = gtid; i < 64 * 8; i += gstride) {
      const int pos = (int)(i >> 3), j = (int)(i & 7);
      const float inv = powf(10000.f, -(float)j / 8.f); float sn, cs; sincosf((float)pos * inv, &sn, &cs);
      rm[2 * i] = cs; rm[2 * i + 1] = sn;
    }
  }
  const int hb = tid >> 8, tq = tid & 255;
  float* sl = (float*)(lds + hb * HALF_LDS);
  float* mod = (float*)(ws + WS_MOD);
  const int kg = tq >> 5, cn = tq & 31;
  for (int it = 2 * blockIdx.x + hb; it < 192; it += 2 * gridDim.x) {
    const int l = it / 96, n = (it % 96) * 32 + cn;
    float acc[17];
#pragma unroll
    for (int i = 0; i < 17; ++i) acc[i] = 0.f;
    for (int half = 0; half < 2; ++half) {
      __syncthreads();
      for (int e = tq; e < 17 * 512; e += 256) {
        const int i = e >> 9, k = (e & 511) + 512 * half;
        const float cv = (i < 16) ? p->c[i * 1024 + k] : p->c_ctx[k];
        sl[e] = silu(cv);
      }
      __syncthreads();
      const float* wp = p->w_mod + ((size_t)l * 1024 + 512 * half + kg * 64) * 3072 + n;
#pragma unroll 4
      for (int kk = 0; kk < 64; ++kk) {
        const float wv = wp[(size_t)kk * 3072];
#pragma unroll
        for (int i = 0; i < 17; ++i) acc[i] = fmaf(sl[i * 512 + kg * 64 + kk], wv, acc[i]);
      }
    }
    __syncthreads();
#pragma unroll
    for (int i = 0; i < 17; ++i) sl[(kg * 17 + i) * 32 + cn] = acc[i];
    __syncthreads();
    for (int e = tq; e < 17 * 32; e += 256) {
      const int i = e >> 5, c2 = e & 31;
      float s = 0.f;
#pragma unroll
      for (int g = 0; g < 8; ++g) s += sl[(g * 17 + i) * 32 + c2];
      const int nn = (it % 96) * 32 + c2;
      mod[((size_t)l * 17 + i) * 3072 + nn] = s + p->b_mod[l * 3072 + nn];
    }
    __syncthreads();
  }
}

DI void phase_norm(KP p, int l) {
  unsigned char* ws = p->ws; asm volatile("" : "+s"(ws));
  const float* xl = (l == 0) ? p->x : p->out;
  const float* xc = (l == 0) ? p->ctx : (const float*)(ws + WS_CTX1);
  const float* g = p->norm_g + l * 1024;
  const float* mod = (const float*)(ws + WS_MOD) + (size_t)l * 17 * 3072;
  bf16_t* hx = (bf16_t*)(ws + WS_R1);
  const int tid = otid(); const int lane = tid & 63;
  const int gw = blockIdx.x * (NTHR / 64) + (tid >> 6), nw = gridDim.x * (NTHR / 64);
  for (int r = gw; r < M; r += nw) {
    const int b = r / T, t = r % T;
    const float* src = (t < SEQ) ? xl + ((size_t)b * SEQ + t) * 1024 : xc + ((size_t)b * CL + (t - SEQ)) * 1024;
    const float* mr = mod + (size_t)((t < SEQ) ? b : 16) * 3072;
    f32x4 v[4]; float ss = 0.f;
#pragma unroll
    for (int i = 0; i < 4; ++i) { v[i] = *(const f32x4*)(src + i * 256 + lane * 4); ss += v[i][0] * v[i][0] + v[i][1] * v[i][1] + v[i][2] * v[i][2] + v[i][3] * v[i][3]; }
    ss = red64(ss);
    const float rstd = rsqrtf(ss * (1.f / 1024.f) + 1e-6f);
#pragma unroll
    for (int i = 0; i < 4; ++i) {
      const int k = i * 256 + lane * 4;
      f32x4 gg = *(const f32x4*)(g + k), sh = *(const f32x4*)(mr + k), sc = *(const f32x4*)(mr + 1024 + k);
      f32x4 o;
#pragma unroll
      for (int e = 0; e < 4; ++e) o[e] = v[i][e] * rstd * gg[e] * (1.f + sc[e]) + sh[e];
      *(u32x2*)(hx + (size_t)r * 1024 + k) = pack4(o);
    }
  }
}

DI void phase_inproj(KP p, int l, char* lds) {
  unsigned char* ws = p->ws; asm volatile("" : "+s"(ws));
  const bf16_t* hx = (const bf16_t*)(ws + WS_R1);
  const bf16_t* wt = (const bf16_t*)(ws + WS_WIN) + (size_t)l * NINP * 1024;
  bf16_t* P = (bf16_t*)(ws + WS_P);
  const int xcd = blockIdx.x & 7, lb = blockIdx.x >> 3, nlb = gridDim.x >> 3, hb = __builtin_amdgcn_readfirstlane(otid() >> 8);
  constexpr int NBIG = 18 * 10;
  for (int j = lb; j < NBIG + 18; j += nlb) {
    if (j < NBIG) {
      int mloc, ntile;
      if (j < 144) { mloc = (j % 72) >> 2; ntile = (j / 72) * 4 + (j & 3); } else { const int j2 = j - 144; mloc = j2 >> 1; ntile = 8 + (j2 & 1); }
      const int mt = 18 * xcd + mloc;
      if (l == 1 && (mt % 9) == 8 && !(ntile == 0 || ntile == 1 || ntile == 3 || ntile == 4)) continue;
      const int m0 = mt * 256, n0 = ntile * 256;
      gemm256(hx + (size_t)m0 * 1024, 1024, wt + (size_t)n0 * 1024, 1024, 1024, lds, [&](int m, int n, f32x4 v) {
        __builtin_nontemporal_store(pack4(v), (u32x2*)(P + (size_t)(m0 + m) * NIN + n0 + n));
      });
    } else {
      const int mt = 36 * xcd + 2 * (j - NBIG) + hb;
      if (l == 1 && (mt % 18) >= 16) continue;
      const int m0 = mt * 128;
      gemm_tile(hx + (size_t)m0 * 1024, 1024, wt + (size_t)2560 * 1024, 1024, 1024, lds, [&](int m, int n, f32x4 v) {
        if (2560 + n < NIN) __builtin_nontemporal_store(pack4(v), (u32x2*)(P + (size_t)(m0 + m) * NIN + 2560 + n));
      });
    }
  }
}

DI void rope4(f32x4& v, int u, int t, const float* __restrict__ rg) {
  const int pos = (u & 8) ? (t & 63) : (t >> 6);
  const float sg = (u & 4) ? 1.f : -1.f;
#pragma unroll
  for (int e = 0; e < 4; ++e) {
    const float xp = __shfl_xor(v[e], 4);
    const f32x2 cs = *(const f32x2*)(rg + (pos * 16 + 4 * (u & 3) + e) * 2);
    v[e] = v[e] * cs[0] + sg * xp * cs[1];
  }
}
DI void rope2(float& a, float& b, int u, int t, const float* __restrict__ rm) {
  const int pos = (u & 8) ? (t & 63) : (t >> 6);
  const float sg = (u & 4) ? 1.f : -1.f;
  const float ap = __shfl_xor(a, 4), bp = __shfl_xor(b, 4);
  const f32x4 cs = *(const f32x4*)(rm + (pos * 8 + 2 * (u & 3)) * 2);
  a = a * cs[0] + sg * ap * cs[1];
  b = b * cs[2] + sg * bp * cs[3];
}

DI void phase_feat_a(KP p, int l, char* lds) {
  unsigned char* ws = p->ws; asm volatile("" : "+s"(ws));
  const bf16_t* P = (const bf16_t*)(ws + WS_P);
  bf16_t* cqn = (bf16_t*)(ws + WS_R1 + R1_CQN);
  bf16_t* ckvn = (bf16_t*)(ws + WS_R1 + R1_CKVN);
  bf16_t* QB = (bf16_t*)(ws + WS_QB); bf16_t* KB = (bf16_t*)(ws + WS_KB); bf16_t* VBT = (bf16_t*)(ws + WS_VBT);
  bf16_t* vnT = (bf16_t*)(ws + WS_VNT);
  const float* rg = (const float*)(ws + WS_ROPG);
  const int tid = otid(); const int lane = tid & 63, u = lane & 15, sub = lane >> 4;
  const int gw = blockIdx.x * (NTHR / 64) + (tid >> 6), nw = gridDim.x * (NTHR / 64);
  const int hb = tid >> 8, tq = tid & 255; char* ldh = lds + hb * HALF_LDS;
  {
    constexpr int STR = 144;
    const float* lg = p->cm_ln_g + l * 256; const float* lbp = p->cm_ln_b + l * 256;
    for (int unit = 2 * blockIdx.x + hb; unit < (M / 64) * 2; unit += 2 * gridDim.x) {
      const int grp = unit >> 1; const bool isv2 = unit & 1;
      const int r0 = grp * 64; const int b = r0 / T, t0 = r0 % T;
      if (!isv2) {
        const int c = tq & 31, rb = 2 * (tq >> 5);
        f32x4 g0 = *(const f32x4*)(lg + 8 * c), g1 = *(const f32x4*)(lg + 8 * c + 4), b0 = *(const f32x4*)(lbp + 8 * c), b1 = *(const f32x4*)(lbp + 8 * c + 4);
        const float gg[8] = {g0[0], g0[1], g0[2], g0[3], g1[0], g1[1], g1[2], g1[3]};
        const float bb[8] = {b0[0], b0[1], b0[2], b0[3], b1[0], b1[1], b1[2], b1[3]};
#pragma unroll
        for (int i = 0; i < 4; ++i) {
          float vn[2][8];
#pragma unroll
          for (int rr = 0; rr < 2; ++rr) {
            const int row = rb + 16 * i + rr;
            u32x4 q = *(const u32x4*)(P + (size_t)(r0 + row) * NIN + O_V + 8 * c);
            float f[8] = {bflo(q.x), bfhi(q.x), bflo(q.y), bfhi(q.y), bflo(q.z), bfhi(q.z), bflo(q.w), bfhi(q.w)};
            float s1 = 0.f, s2 = 0.f;
#pragma unroll
            for (int e = 0; e < 8; ++e) { s1 += f[e]; s2 += f[e] * f[e]; }
#pragma unroll
            for (int m = 1; m < 32; m <<= 1) { s1 += __shfl_xor(s1, m); s2 += __shfl_xor(s2, m); }
            const float mu = s1 * (1.f / 256.f); const float var = fmaxf(s2 * (1.f / 256.f) - mu * mu, 0.f); const float rs = rsqrtf(var + 1e-6f);
#pragma unroll
            for (int e = 0; e < 8; ++e) vn[rr][e] = (f[e] - mu) * rs * gg[e] + bb[e];
          }
#pragma unroll
          for (int e = 0; e < 8; ++e) *(unsigned*)(ldh + (8 * c + e) * STR + (rb + 16 * i) * 2) = cvtpk(vn[0][e], vn[1][e]);
        }
        __syncthreads();
        bf16_t* vo = vnT + (size_t)(r0 >> 7) * 256 * 128 + (r0 & 127);
#pragma unroll
        for (int i = 0; i < 8; ++i) {
          const int ch = (tq >> 3) + 32 * i, part = tq & 7;
          *(u32x4*)(vo + (size_t)ch * 128 + part * 8) = *(const u32x4*)(ldh + ch * STR + part * 16);
        }
      } else {
        const int c = tq & 15, rb = 2 * (tq >> 4);
#pragma unroll
        for (int i = 0; i < 2; ++i) {
          u32x4 q0 = *(const u32x4*)(P + (size_t)(r0 + rb + 32 * i) * NIN + O_V2 + 8 * c);
          u32x4 q1 = *(const u32x4*)(P + (size_t)(r0 + rb + 32 * i + 1) * NIN + O_V2 + 8 * c);
          const unsigned a[4] = {q0.x, q0.y, q0.z, q0.w}, d[4] = {q1.x, q1.y, q1.z, q1.w};
#pragma unroll
          for (int e = 0; e < 4; ++e) {
            *(unsigned*)(ldh + (8 * c + 2 * e) * STR + (rb + 32 * i) * 2) = (a[e] & 0xffffu) | (d[e] << 16);
            *(unsigned*)(ldh + (8 * c + 2 * e + 1) * STR + (rb + 32 * i) * 2) = (a[e] >> 16) | (d[e] & 0xffff0000u);
          }
        }
        __syncthreads();
        bf16_t* vb = VBT + (size_t)b * 2 * 64 * T + t0;
#pragma unroll
        for (int i = 0; i < 4; ++i) {
          const int ch = (tq >> 3) + 32 * i, part = tq & 7;
          *(u32x4*)(vb + (size_t)ch * T + part * 8) = *(const u32x4*)(ldh + ch * STR + part * 16);
        }
      }
      __syncthreads();
    }
  }
  constexpr int NTA = M / 4;
#pragma unroll 2
  for (int task = gw; task < NTA; task += nw) {
    {
      const int r = task * 4 + sub; const int b = r / T, t = r % T;
      const bf16_t* pr = P + (size_t)r * NIN;
      {
        f32x4 v[3]; float ss = 0.f;
#pragma unroll
        for (int e = 0; e < 3; ++e) { v[e] = unpack4(*(const u32x2*)(pr + O_CQ + 12 * u + 4 * e)); ss += v[e][0] * v[e][0] + v[e][1] * v[e][1] + v[e][2] * v[e][2] + v[e][3] * v[e][3]; }
        ss = red16(ss); const float rs = rsqrtf(ss * (1.f / 192.f) + 1e-6f);
#pragma unroll
        for (int e = 0; e < 3; ++e) {
          f32x4 g = *(const f32x4*)(p->mla_q_norm + l * 192 + 12 * u + 4 * e);
          f32x4 o = {v[e][0] * rs * g[0], v[e][1] * rs * g[1], v[e][2] * rs * g[2], v[e][3] * rs * g[3]};
          *(u32x2*)(cqn + (size_t)r * 192 + 12 * u + 4 * e) = pack4(o);
        }
      }
      {
        f32x4 v[2]; float ss = 0.f;
#pragma unroll
        for (int e = 0; e < 2; ++e) { v[e] = unpack4(*(const u32x2*)(pr + O_CKV + 8 * u + 4 * e)); ss += v[e][0] * v[e][0] + v[e][1] * v[e][1] + v[e][2] * v[e][2] + v[e][3] * v[e][3]; }
        ss = red16(ss); const float rs = rsqrtf(ss * (1.f / 128.f) + 1e-6f);
#pragma unroll
        for (int e = 0; e < 2; ++e) {
          f32x4 g = *(const f32x4*)(p->mla_kv_norm + l * 128 + 8 * u + 4 * e);
          f32x4 o = {v[e][0] * rs * g[0], v[e][1] * rs * g[1], v[e][2] * rs * g[2], v[e][3] * rs * g[3]};
          *(u32x2*)(ckvn + (size_t)r * 128 + 8 * u + 4 * e) = pack4(o);
        }
      }
#pragma unroll
      for (int hh = 0; hh < 6; ++hh) {
        const bool isq = hh < 4; const int hd = isq ? hh : hh - 4;
        f32x4 v = unpack4(*(const u32x2*)(pr + (isq ? O_Q2 : O_K2) + 64 * hd + 4 * u));
        float ss = red16(v[0] * v[0] + v[1] * v[1] + v[2] * v[2] + v[3] * v[3]);
        const float rs = rsqrtf(ss * (1.f / 64.f) + 1e-6f);
        f32x4 g = *(const f32x4*)((isq ? p->gqa_qn : p->gqa_kn) + l * 64 + 4 * u);
#pragma unroll
        for (int e = 0; e < 4; ++e) v[e] = v[e] * rs * g[e];
        if (t < SEQ) rope4(v, u, t, rg);
        if (isq) {
#pragma unroll
          for (int e = 0; e < 4; ++e) v[e] *= 0.18033688011112042f;
        }
        bf16_t* dst = isq ? QB + (((size_t)b * 4 + hd) * T + t) * 64 + 4 * u : KB + (((size_t)b * 2 + hd) * T + t) * 64 + 4 * u;
        *(u32x2*)dst = pack4(v);
      }
    }
  }
}

DI void phase_feat_b(KP p, int l, char* lds) {
  unsigned char* ws = p->ws; asm volatile("" : "+s"(ws));
  const bf16_t* P = (const bf16_t*)(ws + WS_P);
  const bf16_t* cqn = (const bf16_t*)(ws + WS_R1 + R1_CQN);
  const bf16_t* ckvn = (const bf16_t*)(ws + WS_R1 + R1_CKVN);
  bf16_t* q1r = (bf16_t*)(ws + WS_R1 + R1_Q1R);
  bf16_t* kr = (bf16_t*)(ws + WS_R1 + R1_KR);
  const bf16_t* wuq = (const bf16_t*)(ws + WS_WUQ) + (size_t)l * 384 * 192;
  const bf16_t* wukv = (const bf16_t*)(ws + WS_WUKV) + (size_t)l * 512 * 128;
  const bf16_t* cm = (const bf16_t*)(ws + WS_CM);
  bf16_t* VAT = (bf16_t*)(ws + WS_VAT); bf16_t* FT = (bf16_t*)(ws + WS_FT); bf16_t* FTC = (bf16_t*)(ws + WS_FTC);
  constexpr int N1 = 288 * 3, N2 = 288 * 2, N3 = 288 * 2, N4 = 288 * 4;
  const int hbb = __builtin_amdgcn_readfirstlane(otid() >> 8);
  for (int it = 2 * blockIdx.x + hbb; it < N1 + N2 + N3 + N4; it += 2 * gridDim.x) {
    if (it < N1) {
      const int mt = it / 3, nt = it % 3; const int m0 = mt * 128, n0 = nt * 128;
      gemm_tile(cqn + (size_t)m0 * 192, 192, wuq + (size_t)n0 * 192, 192, 192, lds, [&](int m, int n, f32x4 v) {
        *(u32x2*)(q1r + (size_t)(m0 + m) * 384 + n0 + n) = pack4(v); });
    } else if (it < N1 + N2) {
      const int i2 = it - N1; const int mt = i2 >> 1, nt = i2 & 1; const int m0 = mt * 128, n0 = nt * 128;
      gemm_tile(ckvn + (size_t)m0 * 128, 128, wukv + (size_t)n0 * 128, 128, 128, lds, [&](int m, int n, f32x4 v) {
        *(u32x2*)(kr + (size_t)(m0 + m) * 256 + n0 + n) = pack4(v); });
    } else if (it < N1 + N2 + N3) {
      const int i2 = it - N1 - N2; const int tt = i2 >> 1, mt2 = i2 & 1;
      gemm_tile(wukv + (size_t)(256 + 128 * mt2) * 128, 128, ckvn + (size_t)tt * 128 * 128, 128, 128, lds, [&](int m, int n, f32x4 v) {
        const int mm = 128 * mt2 + m, head = mm >> 6, dv = mm & 63; const int r = tt * 128 + n; const int b = r / T, t = r % T;
        *(u32x2*)(VAT + (((size_t)b * 4 + head) * 64 + dv) * T + t) = pack4(v); });
    } else {
      const int i2 = it - N1 - N2 - N3; const int tt = i2 >> 2, g = i2 & 3;
      gemm_tile(cm, 64, P + (size_t)tt * 128 * NIN + O_F + 64 * g, NIN, 64, lds, [&](int m, int n, f32x4 v) {
        const int col = 64 * g + (m & 63), part = m >> 6; const int r = tt * 128 + n; const int b = r / T, t = r % T;
        if (t < SEQ) *(u32x2*)(FT + ((size_t)b * 256 + col) * 4096 + part * 2048 + t) = pack4(v);
        else *(u32x2*)(FTC + ((size_t)b * 256 + col) * 512 + part * 256 + (t - SEQ)) = pack4(v); });
    }
  }
}

DI void phase_feat_c(KP p, int l) {
  unsigned char* ws = p->ws; asm volatile("" : "+s"(ws));
  const bf16_t* P = (const bf16_t*)(ws + WS_P);
  const bf16_t* q1r = (const bf16_t*)(ws + WS_R1 + R1_Q1R);
  const bf16_t* krw = (const bf16_t*)(ws + WS_R1 + R1_KR);
  bf16_t* QA = (bf16_t*)(ws + WS_QA); bf16_t* KA = (bf16_t*)(ws + WS_KA);
  const float* rm = (const float*)(ws + WS_ROPM);
  const int tid = otid(); const int lane = tid & 63, u = lane & 15, sub = lane >> 4;
  const int gw = blockIdx.x * (NTHR / 64) + (tid >> 6), nw = gridDim.x * (NTHR / 64);
  {
    const bf16_t* FT = (const bf16_t*)(ws + WS_FT); bf16_t* FTF = (bf16_t*)(ws + WS_FTF);
    for (int task = gw; task < NB * 256 * 4; task += nw) {
      const int row = task >> 2, k8 = (task & 3) * 512 + lane * 8;
      const bf16_t* fr = FT + (size_t)row * 4096;
      const bool cosp = k8 < 1024;
      const int f0 = cosp ? k8 : 2048 + (k8 - 1024);
      const int mi = cosp ? 2048 - k8 : 4096 - (k8 - 1024);
      const u32x4 fw = *(const u32x4*)(fr + f0), ml = *(const u32x4*)(fr + mi - 8);
      const float m0v = bflo((unsigned)fr[(mi < 4096) ? mi : 4095]);
      const float f[8] = {bflo(fw.x), bfhi(fw.x), bflo(fw.y), bfhi(fw.y), bflo(fw.z), bfhi(fw.z), bflo(fw.w), bfhi(fw.w)};
      const float mr[8] = {m0v, bfhi(ml.w), bflo(ml.w), bfhi(ml.z), bflo(ml.z), bfhi(ml.y), bflo(ml.y), bfhi(ml.x)};
      float v[8];
#pragma unroll
      for (int e = 0; e < 8; ++e) {
        const int k = k8 + e;
        if (k < 1024) v[e] = f[e] + ((k == 0) ? 0.f : mr[e]);
        else if (k == 1024) v[e] = bflo((unsigned)fr[1024]);
        else v[e] = f[e] - mr[e];
      }
      u32x4 o = {cvtpk(v[0], v[1]), cvtpk(v[2], v[3]), cvtpk(v[4], v[5]), cvtpk(v[6], v[7])};
      *(u32x4*)(FTF + (size_t)row * 2048 + k8) = o;
    }
  }
#pragma unroll 2
  for (int task = gw; task < M / 4; task += nw) {
    const int r = task * 4 + sub; const int b = r / T, t = r % T;
    const unsigned krp = *(const unsigned*)(P + (size_t)r * NIN + O_KR + 2 * u);
#pragma unroll
    for (int hh = 0; hh < 8; ++hh) {
      const bool isq = hh < 4; const int hd = hh & 3;
      f32x4 v; float ra, rb;
      if (isq) {
        v = unpack4(*(const u32x2*)(q1r + (size_t)r * 384 + 96 * hd + 4 * u));
        const unsigned rr = *(const unsigned*)(q1r + (size_t)r * 384 + 96 * hd + 64 + 2 * u); ra = bflo(rr); rb = bfhi(rr);
      } else {
        v = unpack4(*(const u32x2*)(krw + (size_t)r * 256 + 64 * hd + 4 * u));
        ra = bflo(krp); rb = bfhi(krp);
      }
      float ss = red16(v[0] * v[0] + v[1] * v[1] + v[2] * v[2] + v[3] * v[3] + ra * ra + rb * rb);
      const float rs = rsqrtf(ss * (1.f / 96.f) + 1e-6f);
      const float* gn = (isq ? p->mla_qn : p->mla_kn) + l * 96;
      f32x4 g = *(const f32x4*)(gn + 4 * u); f32x2 g2 = *(const f32x2*)(gn + 64 + 2 * u);
#pragma unroll
      for (int e = 0; e < 4; ++e) v[e] = v[e] * rs * g[e];
      ra = ra * rs * g2[0]; rb = rb * rs * g2[1];
      if (t < SEQ) rope2(ra, rb, u, t, rm);
      if (isq) {
        const float cq = 1.4426950408889634f / __builtin_sqrtf(96.f);
#pragma unroll
        for (int e = 0; e < 4; ++e) v[e] *= cq;
        ra *= cq; rb *= cq;
      }
      bf16_t* dst = (isq ? QA : KA) + (((size_t)b * 4 + hd) * T + t) * 96;
      *(u32x2*)(dst + 4 * u) = pack4(v);
      *(unsigned*)(dst + 64 + 2 * u) = cvtpk(ra, rb);
    }
  }
}

DI void phase_mix(KP p, int l, char* lds) {
  unsigned char* ws = p->ws; asm volatile("" : "+s"(ws));
  const bf16_t* P = (const bf16_t*)(ws + WS_P);
  bf16_t* Y = (bf16_t*)(ws + WS_R1);
  bf16_t* YD = (bf16_t*)(ws + WS_YD);
  const bf16_t* QA = (const bf16_t*)(ws + WS_QA); const bf16_t* KA = (const bf16_t*)(ws + WS_KA); const bf16_t* VAT = (const bf16_t*)(ws + WS_VAT);
  const bf16_t* QB = (const bf16_t*)(ws + WS_QB); const bf16_t* KB = (const bf16_t*)(ws + WS_KB); const bf16_t* VBT = (const bf16_t*)(ws + WS_VBT);
  const bf16_t* FTF = (const bf16_t*)(ws + WS_FTF); const bf16_t* FTC = (const bf16_t*)(ws + WS_FTC);
  const bf16_t* DL = (const bf16_t*)(ws + WS_DLAT); const bf16_t* DC = (const bf16_t*)(ws + WS_DCTX);
  const bf16_t* vnT = (const bf16_t*)(ws + WS_VNT);
  const bf16_t* wsb = (const bf16_t*)(ws + WS_WS) + (size_t)l * 4 * 128 * 128;
  const bool upd = (l == 0);
  const float sbA = ((const float*)(ws + WS_SBND))[l * 2], sbB = ((const float*)(ws + WS_SBND))[l * 2 + 1];
  const int xcd = blockIdx.x & 7, lb = 2 * (blockIdx.x >> 3) + __builtin_amdgcn_readfirstlane(otid() >> 8), nlb = 2 * (gridDim.x >> 3);
  const int nDL = 64, nA = 128, nB = 128, nDC = upd ? 8 : 0, nAc = upd ? 16 : 0, nBc = upd ? 16 : 0, nCM = 144, nFN = upd ? 72 : 64;
  const int e0 = nDL, e1 = e0 + nA, e2 = e1 + nB, e3 = e2 + nDC, e4 = e3 + nAc, e5 = e4 + nBc, e6 = e5 + nCM, e7 = e6 + nFN;
  unsigned* cnt = (unsigned*)(ws + WS_CNT) + l * 288;
  const bf16_t* wf = (const bf16_t*)(ws + WS_WF) + (size_t)l * 256 * 256;
  const int tid0 = otid() & 255;
  for (int it = lb; it < e7; it += nlb) {
    if (it >= e6) {
      const int i2 = it - e6; const int mpb = upd ? 18 : 16; const int mloc = i2 >> 1, nt = i2 & 1;
      const int mt = (2 * xcd + mloc / mpb) * 18 + (mloc % mpb);
      if (tid0 == 0) {
        unsigned sp = 0;
        while (__hip_atomic_load(&cnt[mt], __ATOMIC_RELAXED, __HIP_MEMORY_SCOPE_AGENT) < 2u) { __builtin_amdgcn_s_sleep(2); if (++sp > (1u << 24)) break; }
        __builtin_amdgcn_fence(__ATOMIC_ACQUIRE, "agent");
        asm volatile("s_waitcnt vmcnt(0)" ::: "memory");
      }
      __syncthreads();
      const int m0 = mt * 128, n0 = nt * 128;
      gemm_tile(YD + (size_t)m0 * 256, 256, wf + (size_t)n0 * 256, 256, 256, lds, [&](int m, int n, f32x4 v) {
        const size_t r = (size_t)m0 + m;
        f32x4 gd = unpack4(*(const u32x2*)(P + r * NIN + O_GD + n0 + n));
        f32x4 o = {v[0] * silu(gd[0]), v[1] * silu(gd[1]), v[2] * silu(gd[2]), v[3] * silu(gd[3])};
        *(u32x2*)(Y + r * 1024 + 768 + n0 + n) = pack4(o); });
      continue;
    }
    if (it < e0 || (it >= e2 && it < e3)) {
      const bool isl = it < e0; const int i2 = isl ? it : it - e2;
      int b, mt, nt, K; const bf16_t* Ap; const bf16_t* Bp; float sc; size_t rbase;
      if (isl) { b = 2 * xcd + (i2 >> 5); mt = (i2 >> 1) & 15; nt = i2 & 1; K = 2048; Ap = DL + (size_t)mt * 128 * 2048; Bp = FTF + ((size_t)b * 256 + nt * 128) * 2048; sc = 0.00276213586f; rbase = (size_t)b * T + mt * 128; }
      else { b = 2 * xcd + (i2 >> 2); mt = (i2 >> 1) & 1; nt = i2 & 1; K = 512; Ap = DC + (size_t)mt * 128 * 512; Bp = FTC + ((size_t)b * 256 + nt * 128) * 512; sc = 0.0078125f; rbase = (size_t)b * T + SEQ + mt * 128; }
      bf16_t* yo = YD + rbase * 256 + nt * 128;
      gemm_tile(Ap, K, Bp, K, K, lds, [&](int m, int n, f32x4 v) {
        f32x4 o = {v[0] * sc, v[1] * sc, v[2] * sc, v[3] * sc};
        *(u32x2*)(yo + (size_t)m * 256 + n) = pack4(o); });
      asm volatile("s_waitcnt vmcnt(0)" ::: "memory");
      __syncthreads();
      if (tid0 == 0) {
        __builtin_amdgcn_fence(__ATOMIC_RELEASE, "agent");
        asm volatile("s_waitcnt vmcnt(0)" ::: "memory");
        __hip_atomic_fetch_add(&cnt[b * 18 + (isl ? mt : 16 + mt)], 1u, __ATOMIC_RELAXED, __HIP_MEMORY_SCOPE_AGENT);
      }
    } else if (it < e1 || (it >= e3 && it < e4)) {
      const bool isl = it < e1; const int i2 = isl ? it - e0 : it - e3;
      int b, hd, q0, k0, nk;
      if (isl) { b = 2 * xcd + (i2 >> 6); hd = (i2 >> 4) & 3; q0 = (i2 & 15) * 128; k0 = 0; nk = T; }
      else { b = 2 * xcd + (i2 >> 3); hd = (i2 >> 1) & 3; q0 = SEQ + (i2 & 1) * 128; k0 = SEQ; nk = CL; }
      const size_t r0 = (size_t)b * T + q0; const size_t bh = (size_t)b * 4 + hd;
      if (sbA <= 30.f) attn_item<96, true>(QA + (bh * T + q0) * 96, KA + (bh * T + k0) * 96, VAT + bh * 64 * T + k0, nk, lds,
                    P + r0 * NIN + O_GA + 64 * hd, Y + r0 * 1024 + 64 * hd, sbA);
      else attn_item<96, false>(QA + (bh * T + q0) * 96, KA + (bh * T + k0) * 96, VAT + bh * 64 * T + k0, nk, lds,
                    P + r0 * NIN + O_GA + 64 * hd, Y + r0 * 1024 + 64 * hd, 0.f);
    } else if (it < e2 || (it >= e4 && it < e5)) {
      const bool isl = it < e2; const int i2 = isl ? it - e1 : it - e4;
      int b, hd, q0, k0, nk;
      if (isl) { b = 2 * xcd + (i2 >> 6); hd = (i2 >> 4) & 3; q0 = (i2 & 15) * 128; k0 = 0; nk = T; }
      else { b = 2 * xcd + (i2 >> 3); hd = (i2 >> 1) & 3; q0 = SEQ + (i2 & 1) * 128; k0 = SEQ; nk = CL; }
      const size_t r0 = (size_t)b * T + q0; const size_t bh = (size_t)b * 4 + hd, bk = (size_t)b * 2 + (hd >> 1);
      if (sbB <= 30.f) attn_item<64, true>(QB + (bh * T + q0) * 64, KB + (bk * T + k0) * 64, VBT + bk * 64 * T + k0, nk, lds,
                    P + r0 * NIN + O_GB + 64 * hd, Y + r0 * 1024 + 256 + 64 * hd, sbB);
      else attn_item<64, false>(QB + (bh * T + q0) * 64, KB + (bk * T + k0) * 64, VBT + bk * 64 * T + k0, nk, lds,
                    P + r0 * NIN + O_GB + 64 * hd, Y + r0 * 1024 + 256 + 64 * hd, 0.f);
    } else {
      const int i2 = it - e5; const int bl = i2 / 72, rem = i2 % 72; const int chl = rem >> 2, g = rem & 3;
      const int ch = (2 * xcd + bl) * 18 + chl;
      if (!upd && chl >= 16) continue;
      const float* bs = p->cm_b_s + ((size_t)l * 4 + g) * 128;
      const bf16_t* Pr = P + (size_t)ch * 128 * NIN + 64 * g; bf16_t* Yr = Y + (size_t)ch * 128 * 1024 + 512 + 64 * g;
      gemm_tile(wsb + (size_t)g * 128 * 128, 128, vnT + ((size_t)ch * 256 + 64 * g) * 128, 128, 128, lds, [&](int m, int n, f32x4 v) {
        if (n < 64) {
          const float bias = bs[m];
          f32x4 uu = unpack4(*(const u32x2*)(Pr + (size_t)m * NIN + O_U + n)), gc = unpack4(*(const u32x2*)(Pr + (size_t)m * NIN + O_GC + n));
          f32x4 o;
#pragma unroll
          for (int e = 0; e < 4; ++e) o[e] = uu[e] * (v[e] + bias) * silu(gc[e]);
          *(u32x2*)(Yr + (size_t)m * 1024 + n) = pack4(o);
        } });
    }
  }
}

DI void phase_outproj(KP p, int l, char* lds) {
  unsigned char* ws = p->ws; asm volatile("" : "+s"(ws));
  const bf16_t* Y = (const bf16_t*)(ws + WS_R1);
  const bf16_t* wo = (const bf16_t*)(ws + WS_WOUT) + (size_t)l * 1024 * 1024;
  const float* mod = (const float*)(ws + WS_MOD) + (size_t)l * 17 * 3072;
  const float* xl = (l == 0) ? p->x : p->out;
  float* ctx1 = (float*)(ws + WS_CTX1);
  const int xcd = blockIdx.x & 7, lb = blockIdx.x >> 3, nlb = gridDim.x >> 3, hb = __builtin_amdgcn_readfirstlane(otid() >> 8);
  const int nsm = (l == 0) ? 16 : 0;
  for (int j = lb; j < 64; j += nlb) {
    {
      const int mi = j >> 2, nt = j & 3;
      const int bb = 2 * xcd + (mi >> 3), tt = mi & 7;
      const int m0 = (bb * 9 + tt) * 256, n0 = nt * 256;
      const float* src = xl + ((size_t)bb * SEQ + tt * 256) * 1024;
      float* dst = p->out + ((size_t)bb * SEQ + tt * 256) * 1024;
      const float* gt = mod + (size_t)bb * 3072 + 2048;
      gemm256(Y + (size_t)m0 * 1024, 1024, wo + (size_t)n0 * 1024, 1024, 1024, lds, [&](int m, int n, f32x4 v) {
        const size_t o = (size_t)m * 1024 + n0 + n;
        f32x4 xv = __builtin_nontemporal_load((const f32x4*)(src + o)), g = *(const f32x4*)(gt + n0 + n);
        f32x4 r = {xv[0] + g[0] * v[0], xv[1] + g[1] * v[1], xv[2] + g[2] * v[2], xv[3] + g[3] * v[3]};
        __builtin_nontemporal_store(r, (f32x4*)(dst + o)); });
    }
  }
  for (int j = lb; j < nsm; j += nlb) {
    {
      const int item = 2 * j + hb; const int bb = 2 * xcd + (item >> 4), m128 = (item >> 3) & 1, nt = item & 7;
      const int m0 = (bb * 18 + 16 + m128) * 128, n0 = nt * 128;
      const float* src = p->ctx + ((size_t)bb * CL + m128 * 128) * 1024;
      float* dst = ctx1 + ((size_t)bb * CL + m128 * 128) * 1024;
      const float* gt = mod + (size_t)16 * 3072 + 2048;
      gemm_tile(Y + (size_t)m0 * 1024, 1024, wo + (size_t)n0 * 1024, 1024, 1024, lds, [&](int m, int n, f32x4 v) {
        const size_t o = (size_t)m * 1024 + n0 + n;
        f32x4 xv = *(const f32x4*)(src + o), g = *(const f32x4*)(gt + n0 + n);
        f32x4 r = {xv[0] + g[0] * v[0], xv[1] + g[1] * v[1], xv[2] + g[2] * v[2], xv[3] + g[3] * v[3]};
        *(f32x4*)(dst + o) = r; });
    }
  }
}

__global__ void __launch_bounds__(NTHR, 2) fwd_megakernel(Params p_byval) {
  KP p = (KP)__builtin_amdgcn_kernarg_segment_ptr();
  extern __shared__ __attribute__((aligned(16))) char lds[];
  cg::grid_group grid = cg::this_grid();
  uint4* xbw = (uint4*)(lds + LDS_MAIN);
  if (threadIdx.x == 0) *xbw = make_uint4(0u, 0u, 0u, 0u);
  __syncthreads();
  XcdBarrier xb = xcd_barrier_post((unsigned*)(p->ws + WS_BAR), (volatile LAS unsigned*)xbw);
  if (p->ph_hi < p->ph_lo) grid.sync();
  (void)p_byval;
  for (int ph = p->ph_lo; ph < p->ph_hi; ++ph) {
    asm volatile("" : "+s"(p));
    if (ph == 0) phase0(p, lds);
    else {
      const int l = (ph - 1) / 7, s = (ph - 1) % 7;
      switch (s) {
        case 0: phase_norm(p, l); break;
        case 1: phase_inproj(p, l, lds); break;
        case 2: phase_feat_a(p, l, lds); break;
        case 3: phase_feat_b(p, l, lds); break;
        case 4: phase_feat_c(p, l); break;
        case 5: phase_mix(p, l, lds); break;
        default: phase_outproj(p, l, lds); break;
      }
    }
    if (ph + 1 < p->ph_hi) xcd_barrier(xb);
  }
}

extern "C" void kernel_launch(void* const* d_in, const int* in_sizes, int n_in, void* d_out, int out_size, void* d_ws, size_t ws_size, hipStream_t stream) {
  static int grid_blocks = 0;
  if (!grid_blocks) {
    int dev = 0, cus = 0, per_cu = 0;
    hipGetDevice(&dev);
    hipDeviceGetAttribute(&cus, hipDeviceAttributeMultiprocessorCount, dev);
    hipFuncSetAttribute((const void*)fwd_megakernel, hipFuncAttributeMaxDynamicSharedMemorySize, LDS_BYTES);
    hipOccupancyMaxActiveBlocksPerMultiprocessor(&per_cu, fwd_megakernel, NTHR, LDS_BYTES);
    if (per_cu > 1) per_cu = 1;
    if (per_cu < 1) per_cu = 1;
    grid_blocks = cus * per_cu;
    if (ws_size < WS_END) fprintf(stderr, "kernel_launch: workspace too small: %zu < %zu\n", ws_size, (size_t)WS_END);
  }
  hipMemsetAsync((unsigned char*)d_ws + WS_BAR, 0, WS_ZERO_BYTES, stream);
  Params p{};
  const float** pp = (const float**)&p;
  for (int i = 0; i < 22; ++i) pp[i] = (const float*)d_in[i];
  p.out = (float*)d_out; p.ws = (unsigned char*)d_ws;
  constexpr int NPH = 15;
#if PER_PHASE_LAUNCH
  for (int ph = 0; ph < NPH; ++ph) {
    p.ph_lo = ph; p.ph_hi = ph + 1;
    hipLaunchKernelGGL(fwd_megakernel, dim3(grid_blocks), dim3(NTHR), LDS_BYTES, stream, p);
  }
#else
  p.ph_lo = 0; p.ph_hi = NPH;
  void* args[] = {&p};
  hipError_t e = hipLaunchCooperativeKernel((void*)fwd_megakernel, dim3(grid_blocks), dim3(NTHR), args, LDS_BYTES, stream);
  if (e != hipSuccess) fprintf(stderr, "cooperative launch failed: %s (grid %d)\n", hipGetErrorString(e), grid_blocks);
#endif
}
```

```cpp
#include <hip/hip_runtime.h>
#include <hip/hip_cooperative_groups.h>
#include <stdint.h>
#include <stdio.h>
namespace cg = cooperative_groups;

#ifndef PER_PHASE_LAUNCH
#define PER_PHASE_LAUNCH 0
#endif

#define DI __device__ __forceinline__
DI int otid() { int t = threadIdx.x; asm volatile("" : "+v"(t)); return t; }
typedef unsigned short bf16_t;
using bf16x8 = __attribute__((ext_vector_type(8))) short;
using f32x16 = __attribute__((ext_vector_type(16))) float;
using f32x4  = __attribute__((ext_vector_type(4))) float;
using f32x2  = __attribute__((ext_vector_type(2))) float;
using u32x4  = __attribute__((ext_vector_type(4))) unsigned;
using u32x2  = __attribute__((ext_vector_type(2))) unsigned;
typedef __bf16 bf16x2_t __attribute__((ext_vector_type(2)));

constexpr int NB = 16, SEQ = 2048, CL = 256, T = 2304, D = 1024, M = NB * T, NIN = 2656, NINP = 2816;
constexpr int O_CQ = 0, O_CKV = 192, O_KR = 320, O_GA = 352, O_Q2 = 608, O_K2 = 864, O_V2 = 992, O_GB = 1120,
              O_U = 1376, O_V = 1632, O_GC = 1888, O_F = 2144, O_GD = 2400;
constexpr int NTHR = 512;
constexpr int HALF_LDS = 69632, LDS_MAIN = 2 * HALF_LDS, LDS_BYTES = LDS_MAIN + 256;

constexpr size_t al256(size_t x) { return (x + 255) & ~(size_t)255; }
constexpr size_t WS_MOD  = 0;
constexpr size_t WS_ROPG = al256(WS_MOD + 2 * 17 * 3072 * 4);
constexpr size_t WS_ROPM = al256(WS_ROPG + 64 * 16 * 2 * 4);
constexpr size_t WS_SBND = al256(WS_ROPM + 64 * 8 * 2 * 4);
constexpr size_t WS_WIN  = al256(WS_SBND + 256);
constexpr size_t WS_WUQ  = al256(WS_WIN + (size_t)2 * NINP * 1024 * 2);
constexpr size_t WS_WUKV = al256(WS_WUQ + 2 * 384 * 192 * 2);
constexpr size_t WS_WF   = al256(WS_WUKV + 2 * 512 * 128 * 2);
constexpr size_t WS_WOUT = al256(WS_WF + 2 * 256 * 256 * 2);
constexpr size_t WS_WS   = al256(WS_WOUT + (size_t)2 * 1024 * 1024 * 2);
constexpr size_t WS_CM   = al256(WS_WS + 2 * 4 * 128 * 128 * 2);
constexpr size_t WS_DLAT = al256(WS_CM + 128 * 64 * 2);
constexpr size_t WS_DCTX = al256(WS_DLAT + (size_t)2048 * 2048 * 2);
constexpr size_t WS_R1   = al256(WS_DCTX + 256 * 512 * 2);
constexpr size_t R1_CQN = 0, R1_CKVN = (size_t)M * 192 * 2, R1_Q1R = R1_CKVN + (size_t)M * 128 * 2, R1_KR = R1_Q1R + (size_t)M * 384 * 2;
constexpr size_t WS_P    = al256(WS_R1 + (size_t)M * 1024 * 2);
constexpr size_t WS_FT   = al256(WS_P + (size_t)M * NIN * 2);
constexpr size_t WS_FTF  = al256(WS_FT + (size_t)NB * 256 * 4096 * 2);
constexpr size_t WS_FTC  = al256(WS_FTF + (size_t)NB * 256 * 2048 * 2);
constexpr size_t WS_YD   = al256(WS_FTC + (size_t)NB * 256 * 512 * 2);
constexpr size_t WS_QA   = al256(WS_YD + (size_t)M * 256 * 2);
constexpr size_t WS_KA   = al256(WS_QA + (size_t)M * 384 * 2);
constexpr size_t WS_VAT  = al256(WS_KA + (size_t)M * 384 * 2);
constexpr size_t WS_QB   = al256(WS_VAT + (size_t)M * 256 * 2);
constexpr size_t WS_KB   = al256(WS_QB + (size_t)M * 256 * 2);
constexpr size_t WS_VBT  = al256(WS_KB + (size_t)M * 128 * 2);
constexpr size_t WS_VNT  = al256(WS_VBT + (size_t)M * 128 * 2);
constexpr size_t WS_CTX1 = al256(WS_VNT + (size_t)M * 256 * 2 + 65536);
constexpr size_t WS_BAR  = al256(WS_CTX1 + (size_t)NB * CL * 1024 * 4);
constexpr size_t WS_CNT  = al256(WS_BAR + 3456 * 4);
constexpr size_t WS_END  = al256(WS_CNT + 2 * 288 * 4);
constexpr size_t WS_ZERO_BYTES = WS_END - WS_BAR;
static_assert(R1_KR + (size_t)M * 256 * 2 <= (size_t)M * 1024 * 2, "temp region");
static_assert(WS_END <= (size_t)512 * 1024 * 1024, "workspace");

struct Params {
  const float *x, *c, *ctx, *c_ctx, *norm_g, *w_mod, *b_mod, *w_in, *mla_q_norm, *mla_w_uq, *mla_kv_norm, *mla_w_ukv,
              *mla_qn, *mla_kn, *gqa_qn, *gqa_kn, *cm_ln_g, *cm_ln_b, *cm_w_s, *cm_b_s, *fnet_w, *w_out;
  float* out; unsigned char* ws; int ph_lo, ph_hi;
};
typedef const __attribute__((address_space(4))) Params* KP;

DI unsigned cvtpk(float lo, float hi) { f32x2 v = {lo, hi}; bf16x2_t b = __builtin_convertvector(v, bf16x2_t); return __builtin_bit_cast(unsigned, b); }
DI float bflo(unsigned u) { return __uint_as_float(u << 16); }
DI float bfhi(unsigned u) { return __uint_as_float(u & 0xffff0000u); }
DI bf16_t f2bf(float f) { return (bf16_t)(cvtpk(f, 0.f) & 0xffffu); }
DI float silu(float x) { return x / (1.f + __expf(-x)); }
DI f32x4 unpack4(u32x2 v) { f32x4 r = {bflo(v.x), bfhi(v.x), bflo(v.y), bfhi(v.y)}; return r; }
DI u32x2 pack4(f32x4 v) { u32x2 r = {cvtpk(v[0], v[1]), cvtpk(v[2], v[3])}; return r; }
DI float dpp_f(float v, const int ctrl_sel) {
  const int i = __float_as_int(v); int r;
  if (ctrl_sel == 0) r = __builtin_amdgcn_update_dpp(0, i, 0xB1, 0xF, 0xF, true);
  else if (ctrl_sel == 1) r = __builtin_amdgcn_update_dpp(0, i, 0x4E, 0xF, 0xF, true);
  else if (ctrl_sel == 2) r = __builtin_amdgcn_update_dpp(0, i, 0x124, 0xF, 0xF, true);
  else r = __builtin_amdgcn_update_dpp(0, i, 0x128, 0xF, 0xF, true);
  return __int_as_float(r);
}
DI float red16(float v) { v += dpp_f(v, 0); v += dpp_f(v, 1); v += dpp_f(v, 2); v += dpp_f(v, 3); return v; }
DI float red64(float v) { v = red16(v); v += __shfl_xor(v, 16); v += __shfl_xor(v, 32); return v; }
#define MFMA32(a, b, c) __builtin_amdgcn_mfma_f32_32x32x16_bf16((a), (b), (c), 0, 0, 0)


#define XB_TMO      128
#define XB_XCNT(j)  (256  + 64 * (j))
#define XB_XSUB(j)  (1280 + 64 * (j))
#define XB_XGEN(j)  (2304 + 64 * (j))
#define XB_TOP      3328
#define XB_TOPGEN   3392
#define XCD_BAR_WORDS 3456
#define XB_SPIN_CAP (1u << 22)
#define LAS __attribute__((address_space(3)))
DI unsigned xb_ld(unsigned* p)              { return __hip_atomic_load(p, __ATOMIC_RELAXED, __HIP_MEMORY_SCOPE_AGENT); }
DI unsigned xb_add(unsigned* p, unsigned v) { return __hip_atomic_fetch_add(p, v, __ATOMIC_RELAXED, __HIP_MEMORY_SCOPE_AGENT); }
DI unsigned xb_xcc_id() { return (unsigned)__builtin_amdgcn_s_getreg((3 << 11) | 20) & 0xFu; }
#define XB_SPIN(cond, bar) do { unsigned _sp = 0; while (cond) { __builtin_amdgcn_s_sleep(1); \
    if ((++_sp & 255u) == 0u) { if (xb_ld(&(bar)[XB_TMO])) break; if (_sp > XB_SPIN_CAP) { atomicAdd(&(bar)[XB_TMO], 1u); break; } } } } while (0)
struct XcdBarrier { unsigned* bar; unsigned x; volatile LAS unsigned* st; };
DI XcdBarrier xcd_barrier_post(unsigned* bar, volatile LAS unsigned* st) {
  XcdBarrier b; b.bar = bar; b.x = xb_xcc_id(); b.st = st;
  if (threadIdx.x == 0) (void)xb_add(&bar[XB_XCNT(b.x)], 1u);
  return b;
}
DI void xcd_barrier_complete(unsigned* bar, unsigned x, unsigned& nloc, unsigned& nx) {
  const unsigned G = gridDim.x * gridDim.y * gridDim.z;
  unsigned sum, cnt, mine, sp = 0u;
  for (;;) {
    sum = 0u; cnt = 0u; mine = 0u;
#pragma unroll
    for (unsigned j = 0; j < 16; ++j) { const unsigned c = xb_ld(&bar[XB_XCNT(j)]); sum += c; cnt += (c > 0u) ? 1u : 0u; mine = (j == x) ? c : mine; }
    if (sum == G) break;
    __builtin_amdgcn_s_sleep(1);
    if ((++sp & 255u) == 0u) { if (xb_ld(&bar[XB_TMO])) break; if (sp > XB_SPIN_CAP) { atomicAdd(&bar[XB_TMO], 1u); break; } }
  }
  nloc = mine > 0u ? mine : 1u; nx = cnt > 0u ? cnt : 1u;
}
DI void xcd_barrier(const XcdBarrier& b) {
  asm volatile("s_waitcnt vmcnt(0)" ::: "memory");
  __syncthreads();
  if (threadIdx.x == 0) {
    unsigned* bar = b.bar;
    __builtin_amdgcn_s_waitcnt(0);
    unsigned nloc = b.st[0], nx = b.st[1];
    if (nloc == 0u) { xcd_barrier_complete(bar, b.x, nloc, nx); b.st[0] = nloc; b.st[1] = nx; }
    const unsigned old = xb_add(&bar[XB_XSUB(b.x)], 1u);
    const unsigned gen = old / nloc;
    if (old + 1u == (gen + 1u) * nloc) {
      __builtin_amdgcn_fence(__ATOMIC_RELEASE, "agent");
      asm volatile("s_waitcnt vmcnt(0)" ::: "memory");
      const unsigned og = xb_add(&bar[XB_TOP], 1u);
      const unsigned tg = og / nx;
      if (og + 1u == (tg + 1u) * nx) xb_add(&bar[XB_TOPGEN], 1u);
      else XB_SPIN(xb_ld(&bar[XB_TOPGEN]) == tg, bar);
      __builtin_amdgcn_fence(__ATOMIC_ACQUIRE, "agent");
      xb_add(&bar[XB_XGEN(b.x)], 1u);
      asm volatile("s_waitcnt vmcnt(0)" ::: "memory");
    } else {
      XB_SPIN(xb_ld(&bar[XB_XGEN(b.x)]) == gen, bar);
      __builtin_amdgcn_fence(__ATOMIC_ACQUIRE, "agent");
      asm volatile("s_waitcnt vmcnt(0)" ::: "memory");
    }
  }
  __syncthreads();
}

template <class Epi>
DI void gemm_tile(const bf16_t* __restrict__ A, int lda, const bf16_t* __restrict__ Bt, int ldb, int K, char* lds, Epi epi) {
  const int tid_full = otid(); const int tid = tid_full & 255; lds += (tid_full >> 8) * HALF_LDS;
  const int lane = tid & 63, w = tid >> 6, l31 = lane & 31, h = lane >> 5;
  const int wr = w >> 1, wc = w & 1;
  const int lrow = tid >> 3, lch = (tid & 7) ^ ((tid >> 4) & 7);
  const bf16_t* ag = A + (size_t)lrow * lda + lch * 8;
  const bf16_t* bg = Bt + (size_t)lrow * ldb + lch * 8;
  const size_t a32 = (size_t)32 * lda, b32 = (size_t)32 * ldb;
  f32x16 acc[2][2];
#pragma unroll
  for (int i = 0; i < 2; ++i)
#pragma unroll
    for (int j = 0; j < 2; ++j)
#pragma unroll
      for (int e = 0; e < 16; ++e) acc[i][j][e] = 0.f;
  const int nk = K >> 6;
  const int rsw = (l31 >> 1) & 7;
  const int aoff = (wr * 64 + l31) * 128, boff = 16384 + (wc * 64 + l31) * 128;
  char* ldst = lds + tid * 16;
#define G_DMA(BUF, KT) { const int ko_ = (KT) * 64; char* nb_ = ldst + (BUF) * 32768; _Pragma("unroll") for (int i = 0; i < 4; ++i) { \
    __builtin_amdgcn_global_load_lds((const unsigned*)(ag + i * a32 + ko_), (__attribute__((address_space(3))) unsigned*)(nb_ + i * 4096), 16, 0, 0); \
    __builtin_amdgcn_global_load_lds((const unsigned*)(bg + i * b32 + ko_), (__attribute__((address_space(3))) unsigned*)(nb_ + 16384 + i * 4096), 16, 0, 0); } }
#define G_COMPUTE(BUF) { const char* cur = lds + (BUF) * 32768; bf16x8 af[2][2], bf[2][2]; \
    { const int off = ((0 + h) ^ rsw) << 4; _Pragma("unroll") for (int i = 0; i < 2; ++i) { af[0][i] = *(const bf16x8*)(cur + aoff + i * 4096 + off); bf[0][i] = *(const bf16x8*)(cur + boff + i * 4096 + off); } } \
    _Pragma("unroll") for (int ks = 0; ks < 4; ++ks) { \
      if (ks < 3) { const int off = ((2 * (ks + 1) + h) ^ rsw) << 4; _Pragma("unroll") for (int i = 0; i < 2; ++i) { af[(ks + 1) & 1][i] = *(const bf16x8*)(cur + aoff + i * 4096 + off); bf[(ks + 1) & 1][i] = *(const bf16x8*)(cur + boff + i * 4096 + off); } } \
      _Pragma("unroll") for (int i = 0; i < 2; ++i) _Pragma("unroll") for (int j = 0; j < 2; ++j) acc[i][j] = MFMA32(bf[ks & 1][j], af[ks & 1][i], acc[i][j]); } }
#define G_WAIT() { asm volatile("s_waitcnt vmcnt(0)" ::: "memory"); __syncthreads(); }
  G_DMA(0, 0);
  G_WAIT();
  for (int kt = 0; kt < nk; kt += 2) {
    if (kt + 1 < nk) G_DMA(1, kt + 1);
    G_COMPUTE(0);
    G_WAIT();
    if (kt + 1 < nk) {
      if (kt + 2 < nk) G_DMA(0, kt + 2);
      G_COMPUTE(1);
      G_WAIT();
    }
  }
#undef G_DMA
#undef G_COMPUTE
#undef G_WAIT
  float* ct = (float*)lds;
#pragma unroll
  for (int i = 0; i < 2; ++i)
#pragma unroll
    for (int j = 0; j < 2; ++j)
#pragma unroll
      for (int q = 0; q < 4; ++q) {
        f32x4 v = {acc[i][j][4 * q], acc[i][j][4 * q + 1], acc[i][j][4 * q + 2], acc[i][j][4 * q + 3]};
        *(f32x4*)(ct + (wr * 64 + i * 32 + l31) * 132 + wc * 64 + j * 32 + 8 * q + 4 * h) = v;
      }
  __syncthreads();
#pragma unroll 4
  for (int it = 0; it < 16; ++it) {
    const int idx = it * 256 + tid; const int row = idx >> 5, c4 = (idx & 31) * 4;
    f32x4 v = *(const f32x4*)(ct + row * 132 + c4);
    epi(row, c4, v);
  }
  __syncthreads();
}


DI int g8_lds_byte(int r, int c) { int st = (r >> 4) * 2 + (c >> 5), rr = r & 15, cc = c & 31, ob = rr * 64 + cc * 2; return st * 1024 + (ob ^ (((ob >> 9) & 1) << 5)); }
DI void g8_stage_rc(int b, int& R, int& C) { int st = b / 1024, sb = b % 1024, swz = sb ^ (((sb >> 9) & 1) << 5); R = (st >> 1) * 16 + swz / 64; C = (st & 1) * 32 + (swz % 64) / 2; }
template <class Epi>
DI void gemm256(const bf16_t* __restrict__ A, int lda, const bf16_t* __restrict__ Bt, int ldb, int K, char* lds, Epi epi) {
  constexpr int BK = 64, HALFR = 128, HTB = HALFR * BK * 2;
  const int tid = otid();
  const int wid = tid >> 6, lane = tid & 63, wr = wid >> 2, wc = wid & 3, fr = lane & 15, fq = lane >> 4;
  const int obs = (fr * 64 + fq * 16) ^ ((((fr * 64 + fq * 16) >> 9) & 1) << 5);
  const char* lrda = lds + wr * 8192 + obs; const char* lrdb = lds + 4 * HTB + wc * 4096 + obs;
  int sr0, sc0, sr1, sc1; g8_stage_rc(tid * 16, sr0, sc0); g8_stage_rc(tid * 16 + 8192, sr1, sc1);
  const unsigned oa0 = (unsigned)(sr0 * lda + sc0) * 2u, oa1 = (unsigned)(sr1 * lda + sc1) * 2u;
#define ob0 oa0
#define ob1 oa1
#define SA8(b, h) (lds + ((b) * 2 + (h)) * HTB)
#define SB8(b, h) (lds + (4 + (b) * 2 + (h)) * HTB)
#define STAGE_A(Pp, br, kt) { const char* g_ = (const char*)(A + (size_t)(br) * lda + (size_t)(kt) * BK); \
    __builtin_amdgcn_global_load_lds((const unsigned*)(g_ + oa0), (LAS unsigned*)((Pp) + tid * 16), 16, 0, 0); \
    __builtin_amdgcn_global_load_lds((const unsigned*)(g_ + oa1), (LAS unsigned*)((Pp) + tid * 16 + 8192), 16, 0, 0); }
#define STAGE_B(Pp, br, kt) { const char* g_ = (const char*)(Bt + (size_t)(br) * ldb + (size_t)(kt) * BK); \
    __builtin_amdgcn_global_load_lds((const unsigned*)(g_ + ob0), (LAS unsigned*)((Pp) + tid * 16), 16, 0, 0); \
    __builtin_amdgcn_global_load_lds((const unsigned*)(g_ + ob1), (LAS unsigned*)((Pp) + tid * 16 + 8192), 16, 0, 0); }
#define LDA8(dst, b, h) _Pragma("unroll") for (int m = 0; m < 4; ++m) _Pragma("unroll") for (int k = 0; k < 2; ++k) \
    dst[m][k] = *(const bf16x8*)(lrda + ((b) * 2 + (h)) * HTB + (2 * m + k) * 1024)
#define LDB8(dst, b, h) _Pragma("unroll") for (int n = 0; n < 2; ++n) _Pragma("unroll") for (int k = 0; k < 2; ++k) \
    dst[n][k] = *(const bf16x8*)(lrdb + ((b) * 2 + (h)) * HTB + (2 * n + k) * 1024)
#define MMA8(ai, bj, AT, BT) { __builtin_amdgcn_s_setprio(1); \
    _Pragma("unroll") for (int m = 0; m < 4; ++m) _Pragma("unroll") for (int n = 0; n < 2; ++n) _Pragma("unroll") for (int k = 0; k < 2; ++k) \
      acc[ai][bj][m][n] = __builtin_amdgcn_mfma_f32_16x16x32_bf16(AT[m][k], BT[n][k], acc[ai][bj][m][n], 0, 0, 0); \
    __builtin_amdgcn_s_setprio(0); }
#define WAIT_V(n) asm volatile("s_waitcnt vmcnt(" #n ")" ::: "memory")
#define WAIT_L(n) asm volatile("s_waitcnt lgkmcnt(" #n ")" ::: "memory")
#define BAR8 __builtin_amdgcn_s_barrier()
#define SCHED8 __builtin_amdgcn_sched_barrier(0)
  f32x4 acc[2][2][4][2];
#pragma unroll
  for (int a = 0; a < 2; ++a)
#pragma unroll
    for (int b = 0; b < 2; ++b)
#pragma unroll
      for (int m = 0; m < 4; ++m)
#pragma unroll
        for (int n = 0; n < 2; ++n) { f32x4 z = {0.f, 0.f, 0.f, 0.f}; acc[a][b][m][n] = z; }
  bf16x8 At[4][2], B0[2][2], B1[2][2];
  const int nt = K / BK;
  WAIT_V(0);
  __syncthreads();
  STAGE_B(SB8(0, 0), 0, 0); STAGE_A(SA8(0, 0), 0, 0);
  STAGE_B(SB8(0, 1), HALFR, 0); STAGE_A(SA8(0, 1), HALFR, 0);
  if (wr == 1) BAR8;
  WAIT_V(4); BAR8;
  STAGE_B(SB8(1, 0), 0, 1); STAGE_A(SA8(1, 0), 0, 1); STAGE_B(SB8(1, 1), HALFR, 1);
  WAIT_V(6); BAR8;
  for (int t = 0; t < nt - 2; t += 2) {
    LDB8(B0, 0, 0); SCHED8; LDA8(At, 0, 0); STAGE_A(SA8(1, 1), HALFR, t + 1);
    WAIT_L(8); BAR8; WAIT_L(0); MMA8(0, 0, At, B0); BAR8; SCHED8;
    LDB8(B1, 0, 1); STAGE_B(SB8(0, 0), 0, t + 2);
    BAR8; WAIT_L(0); MMA8(0, 1, At, B1); BAR8;
    LDA8(At, 0, 1); STAGE_A(SA8(0, 0), 0, t + 2);
    BAR8; WAIT_L(0); MMA8(1, 0, At, B0); BAR8; SCHED8;
    STAGE_B(SB8(0, 1), HALFR, t + 2);
    WAIT_V(6); BAR8; MMA8(1, 1, At, B1); BAR8;
    LDB8(B0, 1, 0); SCHED8; LDA8(At, 1, 0); STAGE_A(SA8(0, 1), HALFR, t + 2);
    WAIT_L(8); BAR8; WAIT_L(0); MMA8(0, 0, At, B0); BAR8; SCHED8;
    LDB8(B1, 1, 1); STAGE_B(SB8(1, 0), 0, t + 3);
    BAR8; WAIT_L(0); MMA8(0, 1, At, B1); BAR8;
    LDA8(At, 1, 1); STAGE_A(SA8(1, 0), 0, t + 3);
    BAR8; WAIT_L(0); MMA8(1, 0, At, B0); BAR8; SCHED8;
    STAGE_B(SB8(1, 1), HALFR, t + 3);
    WAIT_V(6); BAR8; MMA8(1, 1, At, B1); BAR8;
  }
  { LDB8(B0, 0, 0); LDA8(At, 0, 0); STAGE_A(SA8(1, 1), HALFR, nt - 1);
    BAR8; WAIT_L(0); MMA8(0, 0, At, B0); BAR8;
    LDB8(B1, 0, 1); BAR8; WAIT_L(0); MMA8(0, 1, At, B1); BAR8;
    LDA8(At, 0, 1); WAIT_V(4); BAR8; WAIT_L(0); MMA8(1, 0, At, B0); MMA8(1, 1, At, B1); BAR8; }
  { LDB8(B0, 1, 0); LDA8(At, 1, 0); WAIT_V(2); BAR8; WAIT_L(0); MMA8(0, 0, At, B0); BAR8;
    LDB8(B1, 1, 1); WAIT_V(0); BAR8; WAIT_L(0); MMA8(0, 1, At, B1); BAR8;
    LDA8(At, 1, 1); BAR8; WAIT_L(0); MMA8(1, 0, At, B0); MMA8(1, 1, At, B1); BAR8; }
  if (wr == 0) BAR8;
  float* ct = (float*)lds;
#pragma unroll
  for (int ai = 0; ai < 2; ++ai) {
    __syncthreads();
#pragma unroll
    for (int bj = 0; bj < 2; ++bj)
#pragma unroll
      for (int m = 0; m < 4; ++m)
#pragma unroll
        for (int n = 0; n < 2; ++n)
#pragma unroll
          for (int j = 0; j < 4; ++j) ct[(wr * 64 + m * 16 + fq * 4 + j) * 260 + bj * 128 + wc * 32 + n * 16 + fr] = acc[ai][bj][m][n][j];
    __syncthreads();
#pragma unroll 2
    for (int it = 0; it < 16; ++it) {
      const int idx = it * NTHR + tid; const int row = idx >> 6, c4 = (idx & 63) * 4;
      f32x4 v = *(const f32x4*)(ct + row * 260 + c4);
      epi(ai * 128 + row, c4, v);
    }
  }
  __syncthreads();
#undef ob0
#undef ob1
#undef SA8
#undef SB8
#undef STAGE_A
#undef STAGE_B
#undef LDA8
#undef LDB8
#undef MMA8
#undef WAIT_V
#undef WAIT_L
#undef BAR8
#undef SCHED8
}

template <int DQK, bool STATIC>
DI void attn_item(const bf16_t* __restrict__ Q, const bf16_t* __restrict__ Kp, const bf16_t* __restrict__ Vt, int nkeys, char* lds,
                  const bf16_t* __restrict__ Pg, bf16_t* __restrict__ Yg  , float mfix) {
  constexpr int KSTR = DQK * 2 + 16, VSTR = 136, KCH = DQK / 8, NKC = (64 * KCH) / 256, NQS = DQK / 16;
  constexpr int KBUF = 64 * KSTR, BUF = KBUF + 64 * VSTR;
  const int tid_full = otid(); const int tid = tid_full & 255; lds += (tid_full >> 8) * HALF_LDS;
  const int lane = tid & 63, w = tid >> 6, l31 = lane & 31, h = lane >> 5;
  bf16x8 qf[NQS];
#pragma unroll
  for (int ks = 0; ks < NQS; ++ks) qf[ks] = *(const bf16x8*)(Q + (size_t)(32 * w + l31) * DQK + 16 * ks + 8 * h);
  f32x16 o[2];
#pragma unroll
  for (int d = 0; d < 2; ++d)
#pragma unroll
    for (int e = 0; e < 16; ++e) o[d][e] = 0.f;
  float m_run = STATIC ? mfix : -1e30f, l_run = 0.f;
  u32x4 rk[NKC], rv[2];
  int koffg[NKC], koffl[NKC];
#pragma unroll
  for (int i = 0; i < NKC; ++i) { const int c = tid + 256 * i; const int key = c / KCH, part = c % KCH; koffg[i] = c * 8; koffl[i] = key * KSTR + part * 16; }
  const int vdv0 = tid >> 3, vpart = tid & 7;
  const bf16_t* vg = Vt + (size_t)vdv0 * T + vpart * 8;
  const int voffl = KBUF + vdv0 * VSTR + vpart * 16;
  const int nt = nkeys >> 6;
#pragma unroll
  for (int i = 0; i < NKC; ++i) rk[i] = *(const u32x4*)(Kp + koffg[i]);
#pragma unroll
  for (int i = 0; i < 2; ++i) rv[i] = *(const u32x4*)(vg + (size_t)i * 32 * T);
#pragma unroll
  for (int i = 0; i < NKC; ++i) *(u32x4*)(lds + koffl[i]) = rk[i];
#pragma unroll
  for (int i = 0; i < 2; ++i) { u32x2 a = {rv[i].x, rv[i].y}, b = {rv[i].z, rv[i].w}; *(u32x2*)(lds + voffl + i * 32 * VSTR) = a; *(u32x2*)(lds + voffl + i * 32 * VSTR + 8) = b; }
  __syncthreads();
  for (int j = 0; j < nt; ++j) {
    char* cur = lds + (j & 1) * BUF;
    const bool more = (j + 1 < nt);
    if (more) {
#pragma unroll
      for (int i = 0; i < NKC; ++i) rk[i] = *(const u32x4*)(Kp + (size_t)(j + 1) * 64 * DQK + koffg[i]);
#pragma unroll
      for (int i = 0; i < 2; ++i) rv[i] = *(const u32x4*)(vg + (size_t)i * 32 * T + (j + 1) * 64);
    }
    f32x16 s0, s1;
    bf16x8 kf[2][NQS];
#pragma unroll
    for (int kb = 0; kb < 2; ++kb)
#pragma unroll
      for (int ks = 0; ks < NQS; ++ks) kf[kb][ks] = *(const bf16x8*)(cur + (32 * kb + l31) * KSTR + (2 * ks + h) * 16);
    u32x4 vw[2][2][2];
#pragma unroll
    for (int kb = 0; kb < 2; ++kb)
#pragma unroll
      for (int s2 = 0; s2 < 2; ++s2)
#pragma unroll
        for (int d = 0; d < 2; ++d) {
          const char* vp = cur + KBUF + (32 * d + l31) * VSTR + (32 * kb + 16 * s2 + 4 * h) * 2;
          u32x2 v0 = *(const u32x2*)vp, v1 = *(const u32x2*)(vp + 16);
          u32x4 t4 = {v0.x, v0.y, v1.x, v1.y}; vw[kb][s2][d] = t4;
        }
#pragma unroll
    for (int e = 0; e < 16; ++e) { s0[e] = STATIC ? -mfix : 0.f; s1[e] = STATIC ? -mfix : 0.f; }
#pragma unroll
    for (int ks = 0; ks < NQS; ++ks) s0 = MFMA32(kf[0][ks], qf[ks], s0);
    if (!STATIC) {
      float mx = s0[0];
#pragma unroll
      for (int e = 1; e < 16; ++e) mx = fmaxf(mx, s0[e]);
      mx = fmaxf(mx, __shfl_xor(mx, 32));
      if (!__all(mx <= m_run + 8.f)) {
        const float m_new = fmaxf(m_run, mx);
        const float alpha = __builtin_amdgcn_exp2f(m_run - m_new);
        m_run = m_new; l_run *= alpha;
#pragma unroll
        for (int d = 0; d < 2; ++d)
#pragma unroll
          for (int e = 0; e < 16; ++e) o[d][e] *= alpha;
      }
    }
#pragma unroll
    for (int ks = 0; ks < NQS; ++ks) s1 = MFMA32(kf[1][ks], qf[ks], s1);
    {
      float ps = 0.f;
#pragma unroll
      for (int e = 0; e < 16; ++e) { float p = STATIC ? __builtin_amdgcn_exp2f(s0[e]) : __builtin_amdgcn_exp2f(s0[e] - m_run); s0[e] = p; ps += p; }
      l_run += ps;
    }
    if (!STATIC) {
      float mx = s1[0];
#pragma unroll
      for (int e = 1; e < 16; ++e) mx = fmaxf(mx, s1[e]);
      mx = fmaxf(mx, __shfl_xor(mx, 32));
      if (!__all(mx <= m_run + 8.f)) {
        const float m_new = fmaxf(m_run, mx);
        const float alpha = __builtin_amdgcn_exp2f(m_run - m_new);
        m_run = m_new; l_run *= alpha;
#pragma unroll
        for (int e = 0; e < 16; ++e) s0[e] *= alpha;
#pragma unroll
        for (int d = 0; d < 2; ++d)
#pragma unroll
          for (int e = 0; e < 16; ++e) o[d][e] *= alpha;
      }
    }
#pragma unroll
    for (int s2 = 0; s2 < 2; ++s2) {
      u32x4 pw = {cvtpk(s0[8 * s2], s0[8 * s2 + 1]), cvtpk(s0[8 * s2 + 2], s0[8 * s2 + 3]), cvtpk(s0[8 * s2 + 4], s0[8 * s2 + 5]), cvtpk(s0[8 * s2 + 6], s0[8 * s2 + 7])};
      bf16x8 pf = __builtin_bit_cast(bf16x8, pw);
#pragma unroll
      for (int d = 0; d < 2; ++d) o[d] = MFMA32(__builtin_bit_cast(bf16x8, vw[0][s2][d]), pf, o[d]);
    }
    {
      float ps = 0.f;
#pragma unroll
      for (int e = 0; e < 16; ++e) { float p = STATIC ? __builtin_amdgcn_exp2f(s1[e]) : __builtin_amdgcn_exp2f(s1[e] - m_run); s1[e] = p; ps += p; }
      l_run += ps;
    }
#pragma unroll
    for (int s2 = 0; s2 < 2; ++s2) {
      u32x4 pw = {cvtpk(s1[8 * s2], s1[8 * s2 + 1]), cvtpk(s1[8 * s2 + 2], s1[8 * s2 + 3]), cvtpk(s1[8 * s2 + 4], s1[8 * s2 + 5]), cvtpk(s1[8 * s2 + 6], s1[8 * s2 + 7])};
      bf16x8 pf = __builtin_bit_cast(bf16x8, pw);
#pragma unroll
      for (int d = 0; d < 2; ++d) o[d] = MFMA32(__builtin_bit_cast(bf16x8, vw[1][s2][d]), pf, o[d]);
    }
    if (more) {
      char* nxt = lds + ((j + 1) & 1) * BUF;
#pragma unroll
      for (int i = 0; i < NKC; ++i) *(u32x4*)(nxt + koffl[i]) = rk[i];
#pragma unroll
      for (int i = 0; i < 2; ++i) { u32x2 a = {rv[i].x, rv[i].y}, b = {rv[i].z, rv[i].w}; *(u32x2*)(nxt + voffl + i * 32 * VSTR) = a; *(u32x2*)(nxt + voffl + i * 32 * VSTR + 8) = b; }
    }
    __syncthreads();
  }
  const float lt = l_run + __shfl_xor(l_run, 32);
  const float inv = 1.f / lt;
  const size_t rq = (size_t)(32 * w + l31);
#pragma unroll
  for (int d = 0; d < 2; ++d)
#pragma unroll
    for (int q = 0; q < 4; ++q) {
      const int dv = 32 * d + 8 * q + 4 * h;
      f32x4 g = unpack4(*(const u32x2*)(Pg + rq * NIN + dv));
      f32x4 v = {o[d][4 * q] * inv * silu(g[0]), o[d][4 * q + 1] * inv * silu(g[1]), o[d][4 * q + 2] * inv * silu(g[2]), o[d][4 * q + 3] * inv * silu(g[3])};
      *(u32x2*)(Yg + rq * 1024 + dv) = pack4(v);
    }
}

template <int DQK, bool STATIC>
DI void attn_item8(const bf16_t* __restrict__ Q, const bf16_t* __restrict__ Kp, const bf16_t* __restrict__ Vt, int nkeys, char* lds,
                  const bf16_t* __restrict__ Pg, bf16_t* __restrict__ Yg  , float mfix) {
  constexpr int KSTR = DQK * 2 + 16, VSTR = 136, KCH = DQK / 8, NKC = (64 * KCH + 511) / 512, NQS = DQK / 16;
  constexpr int KBUF = 64 * KSTR, BUF = KBUF + 64 * VSTR;
  const int tid = otid();
  const int lane = tid & 63, w = tid >> 6, l31 = lane & 31, h = lane >> 5;
  bf16x8 qf[NQS];
#pragma unroll
  for (int ks = 0; ks < NQS; ++ks) qf[ks] = *(const bf16x8*)(Q + (size_t)(32 * w + l31) * DQK + 16 * ks + 8 * h);
  f32x16 o[2];
#pragma unroll
  for (int d = 0; d < 2; ++d)
#pragma unroll
    for (int e = 0; e < 16; ++e) o[d][e] = 0.f;
  float m_run = STATIC ? mfix : -1e30f, l_run = 0.f;
  u32x4 rk[NKC], rv[1];
  int koffg[NKC], koffl[NKC];
#pragma unroll
  for (int i = 0; i < NKC; ++i) { const int c = tid + 512 * i; const int key = c / KCH, part = c % KCH; koffg[i] = (c < 64 * KCH) ? c * 8 : 0; koffl[i] = (c < 64 * KCH) ? key * KSTR + part * 16 : -1; }
  const int vdv0 = tid >> 3, vpart = tid & 7;
  const bf16_t* vg = Vt + (size_t)vdv0 * T + vpart * 8;
  const int voffl = KBUF + vdv0 * VSTR + vpart * 16;
  const int nt = nkeys >> 6;
#pragma unroll
  for (int i = 0; i < NKC; ++i) rk[i] = *(const u32x4*)(Kp + koffg[i]);
#pragma unroll
  for (int i = 0; i < 1; ++i) rv[i] = *(const u32x4*)(vg + (size_t)i * 32 * T);
#pragma unroll
  for (int i = 0; i < NKC; ++i) if (koffl[i] >= 0) *(u32x4*)(lds + koffl[i]) = rk[i];
#pragma unroll
  for (int i = 0; i < 1; ++i) { u32x2 a = {rv[i].x, rv[i].y}, b = {rv[i].z, rv[i].w}; *(u32x2*)(lds + voffl + i * 32 * VSTR) = a; *(u32x2*)(lds + voffl + i * 32 * VSTR + 8) = b; }
  __syncthreads();
  for (int j = 0; j < nt; ++j) {
    char* cur = lds + (j & 1) * BUF;
    const bool more = (j + 1 < nt);
    if (more) {
#pragma unroll
      for (int i = 0; i < NKC; ++i) rk[i] = *(const u32x4*)(Kp + (size_t)(j + 1) * 64 * DQK + koffg[i]);
#pragma unroll
      for (int i = 0; i < 1; ++i) rv[i] = *(const u32x4*)(vg + (size_t)i * 32 * T + (j + 1) * 64);
    }
    f32x16 s0, s1;
    bf16x8 kf[2][NQS];
#pragma unroll
    for (int kb = 0; kb < 2; ++kb)
#pragma unroll
      for (int ks = 0; ks < NQS; ++ks) kf[kb][ks] = *(const bf16x8*)(cur + (32 * kb + l31) * KSTR + (2 * ks + h) * 16);
    u32x4 vw[2][2][2];
#pragma unroll
    for (int kb = 0; kb < 2; ++kb)
#pragma unroll
      for (int s2 = 0; s2 < 2; ++s2)
#pragma unroll
        for (int d = 0; d < 2; ++d) {
          const char* vp = cur + KBUF + (32 * d + l31) * VSTR + (32 * kb + 16 * s2 + 4 * h) * 2;
          u32x2 v0 = *(const u32x2*)vp, v1 = *(const u32x2*)(vp + 16);
          u32x4 t4 = {v0.x, v0.y, v1.x, v1.y}; vw[kb][s2][d] = t4;
        }
#pragma unroll
    for (int e = 0; e < 16; ++e) { s0[e] = STATIC ? -mfix : 0.f; s1[e] = STATIC ? -mfix : 0.f; }
#pragma unroll
    for (int ks = 0; ks < NQS; ++ks) s0 = MFMA32(kf[0][ks], qf[ks], s0);
    if (!STATIC) {
      float mx = s0[0];
#pragma unroll
      for (int e = 1; e < 16; ++e) mx = fmaxf(mx, s0[e]);
      mx = fmaxf(mx, __shfl_xor(mx, 32));
      if (!__all(mx <= m_run + 8.f)) {
        const float m_new = fmaxf(m_run, mx);
        const float alpha = __builtin_amdgcn_exp2f(m_run - m_new);
        m_run = m_new; l_run *= alpha;
#pragma unroll
        for (int d = 0; d < 2; ++d)
#pragma unroll
          for (int e = 0; e < 16; ++e) o[d][e] *= alpha;
      }
    }
#pragma unroll
    for (int ks = 0; ks < NQS; ++ks) s1 = MFMA32(kf[1][ks], qf[ks], s1);
    {
      float ps = 0.f;
#pragma unroll
      for (int e = 0; e < 16; ++e) { float p = STATIC ? __builtin_amdgcn_exp2f(s0[e]) : __builtin_amdgcn_exp2f(s0[e] - m_run); s0[e] = p; ps += p; }
      l_run += ps;
    }
    if (!STATIC) {
      float mx = s1[0];
#pragma unroll
      for (int e = 1; e < 16; ++e) mx = fmaxf(mx, s1[e]);
      mx = fmaxf(mx, __shfl_xor(mx, 32));
      if (!__all(mx <= m_run + 8.f)) {
        const float m_new = fmaxf(m_run, mx);
        const float alpha = __builtin_amdgcn_exp2f(m_run - m_new);
        m_run = m_new; l_run *= alpha;
#pragma unroll
        for (int e = 0; e < 16; ++e) s0[e] *= alpha;
#pragma unroll
        for (int d = 0; d < 2; ++d)
#pragma unroll
          for (int e = 0; e < 16; ++e) o[d][e] *= alpha;
      }
    }
#pragma unroll
    for (int s2 = 0; s2 < 2; ++s2) {
      u32x4 pw = {cvtpk(s0[8 * s2], s0[8 * s2 + 1]), cvtpk(s0[8 * s2 + 2], s0[8 * s2 + 3]), cvtpk(s0[8 * s2 + 4], s0[8 * s2 + 5]), cvtpk(s0[8 * s2 + 6], s0[8 * s2 + 7])};
      bf16x8 pf = __builtin_bit_cast(bf16x8, pw);
#pragma unroll
      for (int d = 0; d < 2; ++d) o[d] = MFMA32(__builtin_bit_cast(bf16x8, vw[0][s2][d]), pf, o[d]);
    }
    {
      float ps = 0.f;
#pragma unroll
      for (int e = 0; e < 16; ++e) { float p = STATIC ? __builtin_amdgcn_exp2f(s1[e]) : __builtin_amdgcn_exp2f(s1[e] - m_run); s1[e] = p; ps += p; }
      l_run += ps;
    }
#pragma unroll
    for (int s2 = 0; s2 < 2; ++s2) {
      u32x4 pw = {cvtpk(s1[8 * s2], s1[8 * s2 + 1]), cvtpk(s1[8 * s2 + 2], s1[8 * s2 + 3]), cvtpk(s1[8 * s2 + 4], s1[8 * s2 + 5]), cvtpk(s1[8 * s2 + 6], s1[8 * s2 + 7])};
      bf16x8 pf = __builtin_bit_cast(bf16x8, pw);
#pragma unroll
      for (int d = 0; d < 2; ++d) o[d] = MFMA32(__builtin_bit_cast(bf16x8, vw[1][s2][d]), pf, o[d]);
    }
    if (more) {
      char* nxt = lds + ((j + 1) & 1) * BUF;
#pragma unroll
      for (int i = 0; i < NKC; ++i) if (koffl[i] >= 0) *(u32x4*)(nxt + koffl[i]) = rk[i];
#pragma unroll
      for (int i = 0; i < 1; ++i) { u32x2 a = {rv[i].x, rv[i].y}, b = {rv[i].z, rv[i].w}; *(u32x2*)(nxt + voffl + i * 32 * VSTR) = a; *(u32x2*)(nxt + voffl + i * 32 * VSTR + 8) = b; }
    }
    __syncthreads();
  }
  const float lt = l_run + __shfl_xor(l_run, 32);
  const float inv = 1.f / lt;
  const size_t rq = (size_t)(32 * w + l31);
#pragma unroll
  for (int d = 0; d < 2; ++d)
#pragma unroll
    for (int q = 0; q < 4; ++q) {
      const int dv = 32 * d + 8 * q + 4 * h;
      f32x4 g = unpack4(*(const u32x2*)(Pg + rq * NIN + dv));
      f32x4 v = {o[d][4 * q] * inv * silu(g[0]), o[d][4 * q + 1] * inv * silu(g[1]), o[d][4 * q + 2] * inv * silu(g[2]), o[d][4 * q + 3] * inv * silu(g[3])};
      *(u32x2*)(Yg + rq * 1024 + dv) = pack4(v);
    }
}

DI void xpose_cvt(const float* __restrict__ src, bf16_t* __restrict__ dst, int K, int N, int Npad, bool perm_kv, size_t gtid, size_t gstride) {
  const size_t total = (size_t)Npad * (K >> 3);
#pragma nounroll
  for (size_t i = gtid; i < total; i += gstride) {
    const int n = (int)(i % Npad), kb = (int)(i / Npad);
    float v[8];
#pragma unroll
    for (int e = 0; e < 8; ++e) v[e] = (n < N) ? src[(size_t)(8 * kb + e) * N + n] : 0.f;
    int row = n;
    if (perm_kv) { const int hh = n >> 7, wv = n & 127; row = (wv < 64) ? (64 * hh + wv) : (256 + 64 * hh + (wv - 64)); }
    u32x4 o = {cvtpk(v[0], v[1]), cvtpk(v[2], v[3]), cvtpk(v[4], v[5]), cvtpk(v[6], v[7])};
    *(u32x4*)(dst + (size_t)row * K + 8 * kb) = o;
  }
}

DI void phase0(KP p, char* lds) {
  unsigned char* ws = p->ws; asm volatile("" : "+s"(ws));
  const int tid = otid();
  const size_t gtid = (size_t)blockIdx.x * NTHR + tid, gstride = (size_t)gridDim.x * NTHR;
  for (int l = 0; l < 2; ++l) {
    xpose_cvt(p->w_in + (size_t)l * 1024 * NIN, (bf16_t*)(ws + WS_WIN) + (size_t)l * NINP * 1024, 1024, NIN, NINP, false, gtid, gstride);
    xpose_cvt(p->mla_w_uq + (size_t)l * 192 * 384, (bf16_t*)(ws + WS_WUQ) + (size_t)l * 384 * 192, 192, 384, 384, false, gtid, gstride);
    xpose_cvt(p->mla_w_ukv + (size_t)l * 128 * 512, (bf16_t*)(ws + WS_WUKV) + (size_t)l * 512 * 128, 128, 512, 512, true, gtid, gstride);
    xpose_cvt(p->fnet_w + (size_t)l * 256 * 256, (bf16_t*)(ws + WS_WF) + (size_t)l * 256 * 256, 256, 256, 256, false, gtid, gstride);
    xpose_cvt(p->w_out + (size_t)l * 1024 * 1024, (bf16_t*)(ws + WS_WOUT) + (size_t)l * 1024 * 1024, 1024, 1024, 1024, false, gtid, gstride);
  }
  {
    const float* src = p->cm_w_s; bf16_t* dst = (bf16_t*)(ws + WS_WS);
    for (size_t i = gtid; i < (size_t)2 * 4 * 128 * 128 / 8; i += gstride) {
      f32x4 a = *(const f32x4*)(src + i * 8), b = *(const f32x4*)(src + i * 8 + 4);
      u32x4 o = {cvtpk(a[0], a[1]), cvtpk(a[2], a[3]), cvtpk(b[0], b[1]), cvtpk(b[2], b[3])};
      *(u32x4*)(dst + i * 8) = o;
    }
  }
  {
    bf16_t* dl = (bf16_t*)(ws + WS_DLAT);
#pragma nounroll
    for (size_t i = gtid; i < (size_t)2048 * 256; i += gstride) {
      const int sp = (int)(i >> 8), k8 = (int)(i & 255) * 8;
      float v[8];
#pragma unroll
      for (int e = 0; e < 8; ++e) { const int k = k8 + e, s = (k <= 1024) ? k : k - 1024; const int ph = (sp * s) & 2047; const float a = (float)ph * (1.f / 1024.f); v[e] = (k <= 1024) ? cospif(a) : -sinpif(a); }
      u32x4 o = {cvtpk(v[0], v[1]), cvtpk(v[2], v[3]), cvtpk(v[4], v[5]), cvtpk(v[6], v[7])};
      *(u32x4*)(dl + (size_t)sp * 2048 + k8) = o;
    }
    bf16_t* dc = (bf16_t*)(ws + WS_DCTX);
    for (size_t i = gtid; i < (size_t)256 * 64; i += gstride) {
      const int sp = (int)(i >> 6), k8 = (int)(i & 63) * 8;
      float v[8];
#pragma unroll
      for (int e = 0; e < 8; ++e) { const int k = k8 + e, s = k & 255; const int ph = (sp * s) & 255; const float a = (float)ph * (1.f / 128.f); v[e] = (k < 256) ? cospif(a) : -sinpif(a); }
      u32x4 o = {cvtpk(v[0], v[1]), cvtpk(v[2], v[3]), cvtpk(v[4], v[5]), cvtpk(v[6], v[7])};
      *(u32x4*)(dc + (size_t)sp * 512 + k8) = o;
    }
    bf16_t* cm = (bf16_t*)(ws + WS_CM);
    for (size_t i = gtid; i < (size_t)128 * 64; i += gstride) {
      const int n = (int)(i >> 6), c = (int)(i & 63);
      const int ph = (c * (n & 63)) & 63; const float a = (float)ph * (1.f / 32.f);
      cm[i] = f2bf((n < 64) ? cospif(a) : sinpif(a));
    }
    float* rg = (float*)(ws + WS_ROPG);
    for (size_t i = gtid; i < 64 * 16; i += gstride) {
      const int pos = (int)(i >> 4), j = (int)(i & 15);
      const float inv = powf(10000.f, -(float)j / 16.f); float sn, cs; sincosf((float)pos * inv, &sn, &cs);
      rg[2 * i] = cs; rg[2 * i + 1] = sn;
    }
    if (blockIdx.x == 0 && tid < 4) {
      const int l = tid >> 1, isb = tid & 1; const int d = isb ? 64 : 96;
      const float* gq = (isb ? p->gqa_qn : p->mla_qn) + l * d; const float* gk = (isb ? p->gqa_kn : p->mla_kn) + l * d;
      float mq = 0.f, mk = 0.f;
      for (int i = 0; i < d; ++i) { mq = fmaxf(mq, fabsf(gq[i])); mk = fmaxf(mk, fabsf(gk[i])); }
      ((float*)(ws + WS_SBND))[l * 2 + isb] = sqrtf((float)d) * mq * mk * 1.4426950408889634f;
    }
    float* rm = (float*)(ws + WS_ROPM);
    for (size_t i = gtid; i < 64 * 8; i += gstride) {
      const int pos = (int)(i >> 3), j = (int)(i & 7);
      const float inv = powf(10000.f, -(float)j / 8.f); float sn, cs; sincosf((float)pos * inv, &sn, &cs);
      rm[2 * i] = cs; rm[2 * i + 1] = sn;
    }
  }
  const int hb = tid >> 8, tq = tid & 255;
  float* sl = (float*)(lds + hb * HALF_LDS);
  float* mod = (float*)(ws + WS_MOD);
  const int kg = tq >> 5, cn = tq & 31;
  for (int it = 2 * blockIdx.x + hb; it < 192; it += 2 * gridDim.x) {
    const int l = it / 96, n = (it % 96) * 32 + cn;
    float acc[17];
#pragma unroll
    for (int i = 0; i < 17; ++i) acc[i] = 0.f;
    for (int half = 0; half < 2; ++half) {
      __syncthreads();
      for (int e = tq; e < 17 * 512; e += 256) {
        const int i = e >> 9, k = (e & 511) + 512 * half;
        const float cv = (i < 16) ? p->c[i * 1024 + k] : p->c_ctx[k];
        sl[e] = silu(cv);
      }
      __syncthreads();
      const float* wp = p->w_mod + ((size_t)l * 1024 + 512 * half + kg * 64) * 3072 + n;
#pragma unroll 4
      for (int kk = 0; kk < 64; ++kk) {
        const float wv = wp[(size_t)kk * 3072];
#pragma unroll
        for (int i = 0; i < 17; ++i) acc[i] = fmaf(sl[i * 512 + kg * 64 + kk], wv, acc[i]);
      }
    }
    __syncthreads();
#pragma unroll
    for (int i = 0; i < 17; ++i) sl[(kg * 17 + i) * 32 + cn] = acc[i];
    __syncthreads();
    for (int e = tq; e < 17 * 32; e += 256) {
      const int i = e >> 5, c2 = e & 31;
      float s = 0.f;
#pragma unroll
      for (int g = 0; g < 8; ++g) s += sl[(g * 17 + i) * 32 + c2];
      const int nn = (it % 96) * 32 + c2;
      mod[((size_t)l * 17 + i) * 3072 + nn] = s + p->b_mod[l * 3072 + nn];
    }
    __syncthreads();
  }
}

DI void phase_norm(KP p, int l) {
  unsigned char* ws = p->ws; asm volatile("" : "+s"(ws));
  const float* xl = (l == 0) ? p->x : p->out;
  const float* xc = (l == 0) ? p->ctx : (const float*)(ws + WS_CTX1);
  const float* g = p->norm_g + l * 1024;
  const float* mod = (const float*)(ws + WS_MOD) + (size_t)l * 17 * 3072;
  bf16_t* hx = (bf16_t*)(ws + WS_R1);
  const int tid = otid(); const int lane = tid & 63;
  const int gw = blockIdx.x * (NTHR / 64) + (tid >> 6), nw = gridDim.x * (NTHR / 64);
  for (int r = gw; r < M; r += nw) {
    const int b = r / T, t = r % T;
    const float* src = (t < SEQ) ? xl + ((size_t)b * SEQ + t) * 1024 : xc + ((size_t)b * CL + (t - SEQ)) * 1024;
    const float* mr = mod + (size_t)((t < SEQ) ? b : 16) * 3072;
    f32x4 v[4]; float ss = 0.f;
#pragma unroll
    for (int i = 0; i < 4; ++i) { v[i] = *(const f32x4*)(src + i * 256 + lane * 4); ss += v[i][0] * v[i][0] + v[i][1] * v[i][1] + v[i][2] * v[i][2] + v[i][3] * v[i][3]; }
    ss = red64(ss);
    const float rstd = rsqrtf(ss * (1.f / 1024.f) + 1e-6f);
#pragma unroll
    for (int i = 0; i < 4; ++i) {
      const int k = i * 256 + lane * 4;
      f32x4 gg = *(const f32x4*)(g + k), sh = *(const f32x4*)(mr + k), sc = *(const f32x4*)(mr + 1024 + k);
      f32x4 o;
#pragma unroll
      for (int e = 0; e < 4; ++e) o[e] = v[i][e] * rstd * gg[e] * (1.f + sc[e]) + sh[e];
      *(u32x2*)(hx + (size_t)r * 1024 + k) = pack4(o);
    }
  }
}

DI void phase_inproj(KP p, int l, char* lds) {
  unsigned char* ws = p->ws; asm volatile("" : "+s"(ws));
  const bf16_t* hx = (const bf16_t*)(ws + WS_R1);
  const bf16_t* wt = (const bf16_t*)(ws + WS_WIN) + (size_t)l * NINP * 1024;
  bf16_t* P = (bf16_t*)(ws + WS_P);
  const int xcd = blockIdx.x & 7, lb = blockIdx.x >> 3, nlb = gridDim.x >> 3, hb = __builtin_amdgcn_readfirstlane(otid() >> 8);
  constexpr int NBIG = 18 * 10;
  for (int j = lb; j < NBIG + 18; j += nlb) {
    if (j < NBIG) {
      int mloc, ntile;
      if (j < 144) { mloc = (j % 72) >> 2; ntile = (j / 72) * 4 + (j & 3); } else { const int j2 = j - 144; mloc = j2 >> 1; ntile = 8 + (j2 & 1); }
      const int mt = 18 * xcd + mloc;
      if (l == 1 && (mt % 9) == 8 && !(ntile == 0 || ntile == 1 || ntile == 3 || ntile == 4)) continue;
      const int m0 = mt * 256, n0 = ntile * 256;
      gemm256(hx + (size_t)m0 * 1024, 1024, wt + (size_t)n0 * 1024, 1024, 1024, lds, [&](int m, int n, f32x4 v) {
        __builtin_nontemporal_store(pack4(v), (u32x2*)(P + (size_t)(m0 + m) * NIN + n0 + n));
      });
    } else {
      const int mt = 36 * xcd + 2 * (j - NBIG) + hb;
      if (l == 1 && (mt % 18) >= 16) continue;
      const int m0 = mt * 128;
      gemm_tile(hx + (size_t)m0 * 1024, 1024, wt + (size_t)2560 * 1024, 1024, 1024, lds, [&](int m, int n, f32x4 v) {
        if (2560 + n < NIN) __builtin_nontemporal_store(pack4(v), (u32x2*)(P + (size_t)(m0 + m) * NIN + 2560 + n));
      });
    }
  }
}

DI void rope4(f32x4& v, int u, int t, const float* __restrict__ rg) {
  const int pos = (u & 8) ? (t & 63) : (t >> 6);
  const float sg = (u & 4) ? 1.f : -1.f;
#pragma unroll
  for (int e = 0; e < 4; ++e) {
    const float xp = __shfl_xor(v[e], 4);
    const f32x2 cs = *(const f32x2*)(rg + (pos * 16 + 4 * (u & 3) + e) * 2);
    v[e] = v[e] * cs[0] + sg * xp * cs[1];
  }
}
DI void rope2(float& a, float& b, int u, int t, const float* __restrict__ rm) {
  const int pos = (u & 8) ? (t & 63) : (t >> 6);
  const float sg = (u & 4) ? 1.f : -1.f;
  const float ap = __shfl_xor(a, 4), bp = __shfl_xor(b, 4);
  const f32x4 cs = *(const f32x4*)(rm + (pos * 8 + 2 * (u & 3)) * 2);
  a = a * cs[0] + sg * ap * cs[1];
  b = b * cs[2] + sg * bp * cs[3];
}

DI void phase_feat_a(KP p, int l, char* lds) {
  unsigned char* ws = p->ws; asm volatile("" : "+s"(ws));
  const bf16_t* P = (const bf16_t*)(ws + WS_P);
  bf16_t* cqn = (bf16_t*)(ws + WS_R1 + R1_CQN);
  bf16_t* ckvn = (bf16_t*)(ws + WS_R1 + R1_CKVN);
  bf16_t* QB = (bf16_t*)(ws + WS_QB); bf16_t* KB = (bf16_t*)(ws + WS_KB); bf16_t* VBT = (bf16_t*)(ws + WS_VBT);
  bf16_t* vnT = (bf16_t*)(ws + WS_VNT);
  const float* rg = (const float*)(ws + WS_ROPG);
  const int tid = otid(); const int lane = tid & 63, u = lane & 15, sub = lane >> 4;
  const int gw = blockIdx.x * (NTHR / 64) + (tid >> 6), nw = gridDim.x * (NTHR / 64);
  const int hb = tid >> 8, tq = tid & 255; char* ldh = lds + hb * HALF_LDS;
  {
    constexpr int STR = 144;
    const float* lg = p->cm_ln_g + l * 256; const float* lbp = p->cm_ln_b + l * 256;
    for (int unit = 2 * blockIdx.x + hb; unit < (M / 64) * 2; unit += 2 * gridDim.x) {
      const int grp = unit >> 1; const bool isv2 = unit & 1;
      const int r0 = grp * 64; const int b = r0 / T, t0 = r0 % T;
      if (!isv2) {
        const int c = tq & 31, rb = 2 * (tq >> 5);
        f32x4 g0 = *(const f32x4*)(lg + 8 * c), g1 = *(const f32x4*)(lg + 8 * c + 4), b0 = *(const f32x4*)(lbp + 8 * c), b1 = *(const f32x4*)(lbp + 8 * c + 4);
        const float gg[8] = {g0[0], g0[1], g0[2], g0[3], g1[0], g1[1], g1[2], g1[3]};
        const float bb[8] = {b0[0], b0[1], b0[2], b0[3], b1[0], b1[1], b1[2], b1[3]};
#pragma unroll
        for (int i = 0; i < 4; ++i) {
          float vn[2][8];
#pragma unroll
          for (int rr = 0; rr < 2; ++rr) {
            const int row = rb + 16 * i + rr;
            u32x4 q = *(const u32x4*)(P + (size_t)(r0 + row) * NIN + O_V + 8 * c);
            float f[8] = {bflo(q.x), bfhi(q.x), bflo(q.y), bfhi(q.y), bflo(q.z), bfhi(q.z), bflo(q.w), bfhi(q.w)};
            float s1 = 0.f, s2 = 0.f;
#pragma unroll
            for (int e = 0; e < 8; ++e) { s1 += f[e]; s2 += f[e] * f[e]; }
#pragma unroll
            for (int m = 1; m < 32; m <<= 1) { s1 += __shfl_xor(s1, m); s2 += __shfl_xor(s2, m); }
            const float mu = s1 * (1.f / 256.f); const float var = fmaxf(s2 * (1.f / 256.f) - mu * mu, 0.f); const float rs = rsqrtf(var + 1e-6f);
#pragma unroll
            for (int e = 0; e < 8; ++e) vn[rr][e] = (f[e] - mu) * rs * gg[e] + bb[e];
          }
#pragma unroll
          for (int e = 0; e < 8; ++e) *(unsigned*)(ldh + (8 * c + e) * STR + (rb + 16 * i) * 2) = cvtpk(vn[0][e], vn[1][e]);
        }
        __syncthreads();
        bf16_t* vo = vnT + (size_t)(r0 >> 7) * 256 * 128 + (r0 & 127);
#pragma unroll
        for (int i = 0; i < 8; ++i) {
          const int ch = (tq >> 3) + 32 * i, part = tq & 7;
          *(u32x4*)(vo + (size_t)ch * 128 + part * 8) = *(const u32x4*)(ldh + ch * STR + part * 16);
        }
      } else {
        const int c = tq & 15, rb = 2 * (tq >> 4);
#pragma unroll
        for (int i = 0; i < 2; ++i) {
          u32x4 q0 = *(const u32x4*)(P + (size_t)(r0 + rb + 32 * i) * NIN + O_V2 + 8 * c);
          u32x4 q1 = *(const u32x4*)(P + (size_t)(r0 + rb + 32 * i + 1) * NIN + O_V2 + 8 * c);
          const unsigned a[4] = {q0.x, q0.y, q0.z, q0.w}, d[4] = {q1.x, q1.y, q1.z, q1.w};
#pragma unroll
          for (int e = 0; e < 4; ++e) {
            *(unsigned*)(ldh + (8 * c + 2 * e) * STR + (rb + 32 * i) * 2) = (a[e] & 0xffffu) | (d[e] << 16);
            *(unsigned*)(ldh + (8 * c + 2 * e + 1) * STR + (rb + 32 * i) * 2) = (a[e] >> 16) | (d[e] & 0xffff0000u);
          }
        }
        __syncthreads();
        bf16_t* vb = VBT + (size_t)b * 2 * 64 * T + t0;
#pragma unroll
        for (int i = 0; i < 4; ++i) {
          const int ch = (tq >> 3) + 32 * i, part = tq & 7;
          *(u32x4*)(vb + (size_t)ch * T + part * 8) = *(const u32x4*)(ldh + ch * STR + part * 16);
        }
      }
      __syncthreads();
    }
  }
  constexpr int NTA = M / 4;
#pragma unroll 2
  for (int task = gw; task < NTA; task += nw) {
    {
      const int r = task * 4 + sub; const int b = r / T, t = r % T;
      const bf16_t* pr = P + (size_t)r * NIN;
      {
        f32x4 v[3]; float ss = 0.f;
#pragma unroll
        for (int e = 0; e < 3; ++e) { v[e] = unpack4(*(const u32x2*)(pr + O_CQ + 12 * u + 4 * e)); ss += v[e][0] * v[e][0] + v[e][1] * v[e][1] + v[e][2] * v[e][2] + v[e][3] * v[e][3]; }
        ss = red16(ss); const float rs = rsqrtf(ss * (1.f / 192.f) + 1e-6f);
#pragma unroll
        for (int e = 0; e < 3; ++e) {
          f32x4 g = *(const f32x4*)(p->mla_q_norm + l * 192 + 12 * u + 4 * e);
          f32x4 o = {v[e][0] * rs * g[0], v[e][1] * rs * g[1], v[e][2] * rs * g[2], v[e][3] * rs * g[3]};
          *(u32x2*)(cqn + (size_t)r * 192 + 12 * u + 4 * e) = pack4(o);
        }
      }
      {
        f32x4 v[2]; float ss = 0.f;
#pragma unroll
        for (int e = 0; e < 2; ++e) { v[e] = unpack4(*(const u32x2*)(pr + O_CKV + 8 * u + 4 * e)); ss += v[e][0] * v[e][0] + v[e][1] * v[e][1] + v[e][2] * v[e][2] + v[e][3] * v[e][3]; }
        ss = red16(ss); const float rs = rsqrtf(ss * (1.f / 128.f) + 1e-6f);
#pragma unroll
        for (int e = 0; e < 2; ++e) {
          f32x4 g = *(const f32x4*)(p->mla_kv_norm + l * 128 + 8 * u + 4 * e);
          f32x4 o = {v[e][0] * rs * g[0], v[e][1] * rs * g[1], v[e][2] * rs * g[2], v[e][3] * rs * g[3]};
          *(u32x2*)(ckvn + (size_t)r * 128 + 8 * u + 4 * e) = pack4(o);
        }
      }
#pragma unroll
      for (int hh = 0; hh < 6; ++hh) {
        const bool isq = hh < 4; const int hd = isq ? hh : hh - 4;
        f32x4 v = unpack4(*(const u32x2*)(pr + (isq ? O_Q2 : O_K2) + 64 * hd + 4 * u));
        float ss = red16(v[0] * v[0] + v[1] * v[1] + v[2] * v[2] + v[3] * v[3]);
        const float rs = rsqrtf(ss * (1.f / 64.f) + 1e-6f);
        f32x4 g = *(const f32x4*)((isq ? p->gqa_qn : p->gqa_kn) + l * 64 + 4 * u);
#pragma unroll
        for (int e = 0; e < 4; ++e) v[e] = v[e] * rs * g[e];
        if (t < SEQ) rope4(v, u, t, rg);
        if (isq) {
#pragma unroll
          for (int e = 0; e < 4; ++e) v[e] *= 0.18033688011112042f;
        }
        bf16_t* dst = isq ? QB + (((size_t)b * 4 + hd) * T + t) * 64 + 4 * u : KB + (((size_t)b * 2 + hd) * T + t) * 64 + 4 * u;
        *(u32x2*)dst = pack4(v);
      }
    }
  }
}

DI void phase_feat_b(KP p, int l, char* lds) {
  unsigned char* ws = p->ws; asm volatile("" : "+s"(ws));
  const bf16_t* P = (const bf16_t*)(ws + WS_P);
  const bf16_t* cqn = (const bf16_t*)(ws + WS_R1 + R1_CQN);
  const bf16_t* ckvn = (const bf16_t*)(ws + WS_R1 + R1_CKVN);
  bf16_t* q1r = (bf16_t*)(ws + WS_R1 + R1_Q1R);
  bf16_t* kr = (bf16_t*)(ws + WS_R1 + R1_KR);
  const bf16_t* wuq = (const bf16_t*)(ws + WS_WUQ) + (size_t)l * 384 * 192;
  const bf16_t* wukv = (const bf16_t*)(ws + WS_WUKV) + (size_t)l * 512 * 128;
  const bf16_t* cm = (const bf16_t*)(ws + WS_CM);
  bf16_t* VAT = (bf16_t*)(ws + WS_VAT); bf16_t* FT = (bf16_t*)(ws + WS_FT); bf16_t* FTC = (bf16_t*)(ws + WS_FTC);
  constexpr int N1 = 288 * 3, N2 = 288 * 2, N3 = 288 * 2, N4 = 288 * 4;
  const int hbb = __builtin_amdgcn_readfirstlane(otid() >> 8);
  for (int it = 2 * blockIdx.x + hbb; it < N1 + N2 + N3 + N4; it += 2 * gridDim.x) {
    if (it < N1) {
      const int mt = it / 3, nt = it % 3; const int m0 = mt * 128, n0 = nt * 128;
      gemm_tile(cqn + (size_t)m0 * 192, 192, wuq + (size_t)n0 * 192, 192, 192, lds, [&](int m, int n, f32x4 v) {
        *(u32x2*)(q1r + (size_t)(m0 + m) * 384 + n0 + n) = pack4(v); });
    } else if (it < N1 + N2) {
      const int i2 = it - N1; const int mt = i2 >> 1, nt = i2 & 1; const int m0 = mt * 128, n0 = nt * 128;
      gemm_tile(ckvn + (size_t)m0 * 128, 128, wukv + (size_t)n0 * 128, 128, 128, lds, [&](int m, int n, f32x4 v) {
        *(u32x2*)(kr + (size_t)(m0 + m) * 256 + n0 + n) = pack4(v); });
    } else if (it < N1 + N2 + N3) {
      const int i2 = it - N1 - N2; const int tt = i2 >> 1, mt2 = i2 & 1;
      gemm_tile(wukv + (size_t)(256 + 128 * mt2) * 128, 128, ckvn + (size_t)tt * 128 * 128, 128, 128, lds, [&](int m, int n, f32x4 v) {
        const int mm = 128 * mt2 + m, head = mm >> 6, dv = mm & 63; const int r = tt * 128 + n; const int b = r / T, t = r % T;
        *(u32x2*)(VAT + (((size_t)b * 4 + head) * 64 + dv) * T + t) = pack4(v); });
    } else {
      const int i2 = it - N1 - N2 - N3; const int tt = i2 >> 2, g = i2 & 3;
      gemm_tile(cm, 64, P + (size_t)tt * 128 * NIN + O_F + 64 * g, NIN, 64, lds, [&](int m, int n, f32x4 v) {
        const int col = 64 * g + (m & 63), part = m >> 6; const int r = tt * 128 + n; const int b = r / T, t = r % T;
        if (t < SEQ) *(u32x2*)(FT + ((size_t)b * 256 + col) * 4096 + part * 2048 + t) = pack4(v);
        else *(u32x2*)(FTC + ((size_t)b * 256 + col) * 512 + part * 256 + (t - SEQ)) = pack4(v); });
    }
  }
}

DI void phase_feat_c(KP p, int l) {
  unsigned char* ws = p->ws; asm volatile("" : "+s"(ws));
  const bf16_t* P = (const bf16_t*)(ws + WS_P);
  const bf16_t* q1r = (const bf16_t*)(ws + WS_R1 + R1_Q1R);
  const bf16_t* krw = (const bf16_t*)(ws + WS_R1 + R1_KR);
  bf16_t* QA = (bf16_t*)(ws + WS_QA); bf16_t* KA = (bf16_t*)(ws + WS_KA);
  const float* rm = (const float*)(ws + WS_ROPM);
  const int tid = otid(); const int lane = tid & 63, u = lane & 15, sub = lane >> 4;
  const int gw = blockIdx.x * (NTHR / 64) + (tid >> 6), nw = gridDim.x * (NTHR / 64);
  {
    const bf16_t* FT = (const bf16_t*)(ws + WS_FT); bf16_t* FTF = (bf16_t*)(ws + WS_FTF);
    for (int task = gw; task < NB * 256 * 4; task += nw) {
      const int row = task >> 2, k8 = (task & 3) * 512 + lane * 8;
      const bf16_t* fr = FT + (size_t)row * 4096;
      const bool cosp = k8 < 1024;
      const int f0 = cosp ? k8 : 2048 + (k8 - 1024);
      const int mi = cosp ? 2048 - k8 : 4096 - (k8 - 1024);
      const u32x4 fw = *(const u32x4*)(fr + f0), ml = *(const u32x4*)(fr + mi - 8);
      const float m0v = bflo((unsigned)fr[(mi < 4096) ? mi : 4095]);
      const float f[8] = {bflo(fw.x), bfhi(fw.x), bflo(fw.y), bfhi(fw.y), bflo(fw.z), bfhi(fw.z), bflo(fw.w), bfhi(fw.w)};
      const float mr[8] = {m0v, bfhi(ml.w), bflo(ml.w), bfhi(ml.z), bflo(ml.z), bfhi(ml.y), bflo(ml.y), bfhi(ml.x)};
      float v[8];
#pragma unroll
      for (int e = 0; e < 8; ++e) {
        const int k = k8 + e;
        if (k < 1024) v[e] = f[e] + ((k == 0) ? 0.f : mr[e]);
        else if (k == 1024) v[e] = bflo((unsigned)fr[1024]);
        else v[e] = f[e] - mr[e];
      }
      u32x4 o = {cvtpk(v[0], v[1]), cvtpk(v[2], v[3]), cvtpk(v[4], v[5]), cvtpk(v[6], v[7])};
      *(u32x4*)(FTF + (size_t)row * 2048 + k8) = o;
    }
  }
#pragma unroll 2
  for (int task = gw; task < M / 4; task += nw) {
    const int r = task * 4 + sub; const int b = r / T, t = r % T;
    const unsigned krp = *(const unsigned*)(P + (size_t)r * NIN + O_KR + 2 * u);
#pragma unroll
    for (int hh = 0; hh < 8; ++hh) {
      const bool isq = hh < 4; const int hd = hh & 3;
      f32x4 v; float ra, rb;
      if (isq) {
        v = unpack4(*(const u32x2*)(q1r + (size_t)r * 384 + 96 * hd + 4 * u));
        const unsigned rr = *(const unsigned*)(q1r + (size_t)r * 384 + 96 * hd + 64 + 2 * u); ra = bflo(rr); rb = bfhi(rr);
      } else {
        v = unpack4(*(const u32x2*)(krw + (size_t)r * 256 + 64 * hd + 4 * u));
        ra = bflo(krp); rb = bfhi(krp);
      }
      float ss = red16(v[0] * v[0] + v[1] * v[1] + v[2] * v[2] + v[3] * v[3] + ra * ra + rb * rb);
      const float rs = rsqrtf(ss * (1.f / 96.f) + 1e-6f);
      const float* gn = (isq ? p->mla_qn : p->mla_kn) + l * 96;
      f32x4 g = *(const f32x4*)(gn + 4 * u); f32x2 g2 = *(const f32x2*)(gn + 64 + 2 * u);
#pragma unroll
      for (int e = 0; e < 4; ++e) v[e] = v[e] * rs * g[e];
      ra = ra * rs * g2[0]; rb = rb * rs * g2[1];
      if (t < SEQ) rope2(ra, rb, u, t, rm);
      if (isq) {
        const float cq = 1.4426950408889634f / __builtin_sqrtf(96.f);
#pragma unroll
        for (int e = 0; e < 4; ++e) v[e] *= cq;
        ra *= cq; rb *= cq;
      }
      bf16_t* dst = (isq ? QA : KA) + (((size_t)b * 4 + hd) * T + t) * 96;
      *(u32x2*)(dst + 4 * u) = pack4(v);
      *(unsigned*)(dst + 64 + 2 * u) = cvtpk(ra, rb);
    }
  }
}

DI void phase_mix(KP p, int l, char* lds) {
  unsigned char* ws = p->ws; asm volatile("" : "+s"(ws));
  const bf16_t* P = (const bf16_t*)(ws + WS_P);
  bf16_t* Y = (bf16_t*)(ws + WS_R1);
  bf16_t* YD = (bf16_t*)(ws + WS_YD);
  const bf16_t* QA = (const bf16_t*)(ws + WS_QA); const bf16_t* KA = (const bf16_t*)(ws + WS_KA); const bf16_t* VAT = (const bf16_t*)(ws + WS_VAT);
  const bf16_t* QB = (const bf16_t*)(ws + WS_QB); const bf16_t* KB = (const bf16_t*)(ws + WS_KB); const bf16_t* VBT = (const bf16_t*)(ws + WS_VBT);
  const bf16_t* FTF = (const bf16_t*)(ws + WS_FTF); const bf16_t* FTC = (const bf16_t*)(ws + WS_FTC);
  const bf16_t* DL = (const bf16_t*)(ws + WS_DLAT); const bf16_t* DC = (const bf16_t*)(ws + WS_DCTX);
  const bf16_t* vnT = (const bf16_t*)(ws + WS_VNT);
  const bf16_t* wsb = (const bf16_t*)(ws + WS_WS) + (size_t)l * 4 * 128 * 128;
  const bool upd = (l == 0);
  const float sbA = ((const float*)(ws + WS_SBND))[l * 2], sbB = ((const float*)(ws + WS_SBND))[l * 2 + 1];
  const int xcd = blockIdx.x & 7, lb = 2 * (blockIdx.x >> 3) + __builtin_amdgcn_readfirstlane(otid() >> 8), nlb = 2 * (gridDim.x >> 3);
  const int nDL = 64, nA = 0, nB = 0, nDC = upd ? 8 : 0, nAc = 0, nBc = 0, nCM = 144, nFN = upd ? 72 : 64;
  const int e0 = nDL, e1 = e0 + nA, e2 = e1 + nB, e3 = e2 + nDC, e4 = e3 + nAc, e5 = e4 + nBc, e6 = e5 + nCM, e7 = e6 + nFN;
  unsigned* cnt = (unsigned*)(ws + WS_CNT) + l * 288;
  const bf16_t* wf = (const bf16_t*)(ws + WS_WF) + (size_t)l * 256 * 256;
  {
    const int lbw = blockIdx.x >> 3, nlbw = gridDim.x >> 3;
    const int nW = upd ? 144 : 128;
    for (int it = lbw; it < nW; it += nlbw) {
      const bool isA = (it < 64) || (it >= 128 && it < 136);
      int b, hd, q0, k0, nk;
      if (it < 128) { const int i2 = it & 63; b = 2 * xcd + (i2 >> 5); hd = (i2 >> 3) & 3; q0 = (i2 & 7) * 256; k0 = 0; nk = T; }
      else { const int i2 = (it - 128) & 7; b = 2 * xcd + (i2 >> 2); hd = i2 & 3; q0 = SEQ; k0 = SEQ; nk = CL; }
      const size_t r0 = (size_t)b * T + q0; const size_t bh = (size_t)b * 4 + hd, bk = (size_t)b * 2 + (hd >> 1);
      if (isA) {
        if (sbA <= 30.f) attn_item8<96, true>(QA + (bh * T + q0) * 96, KA + (bh * T + k0) * 96, VAT + bh * 64 * T + k0, nk, lds, P + r0 * NIN + O_GA + 64 * hd, Y + r0 * 1024 + 64 * hd, sbA);
        else attn_item8<96, false>(QA + (bh * T + q0) * 96, KA + (bh * T + k0) * 96, VAT + bh * 64 * T + k0, nk, lds, P + r0 * NIN + O_GA + 64 * hd, Y + r0 * 1024 + 64 * hd, 0.f);
      } else {
        if (sbB <= 30.f) attn_item8<64, true>(QB + (bh * T + q0) * 64, KB + (bk * T + k0) * 64, VBT + bk * 64 * T + k0, nk, lds, P + r0 * NIN + O_GB + 64 * hd, Y + r0 * 1024 + 256 + 64 * hd, sbB);
        else attn_item8<64, false>(QB + (bh * T + q0) * 64, KB + (bk * T + k0) * 64, VBT + bk * 64 * T + k0, nk, lds, P + r0 * NIN + O_GB + 64 * hd, Y + r0 * 1024 + 256 + 64 * hd, 0.f);
      }
    }
    __syncthreads();
  }
  const int tid0 = otid() & 255;
  for (int it = lb; it < e7; it += nlb) {
    if (it >= e6) {
      const int i2 = it - e6; const int mpb = upd ? 18 : 16; const int mloc = i2 >> 1, nt = i2 & 1;
      const int mt = (2 * xcd + mloc / mpb) * 18 + (mloc % mpb);
      if (tid0 == 0) {
        unsigned sp = 0;
        while (__hip_atomic_load(&cnt[mt], __ATOMIC_RELAXED, __HIP_MEMORY_SCOPE_AGENT) < 2u) { __builtin_amdgcn_s_sleep(2); if (++sp > (1u << 24)) break; }
        __builtin_amdgcn_fence(__ATOMIC_ACQUIRE, "agent");
        asm volatile("s_waitcnt vmcnt(0)" ::: "memory");
      }
      __syncthreads();
      const int m0 = mt * 128, n0 = nt * 128;
      gemm_tile(YD + (size_t)m0 * 256, 256, wf + (size_t)n0 * 256, 256, 256, lds, [&](int m, int n, f32x4 v) {
        const size_t r = (size_t)m0 + m;
        f32x4 gd = unpack4(*(const u32x2*)(P + r * NIN + O_GD + n0 + n));
        f32x4 o = {v[0] * silu(gd[0]), v[1] * silu(gd[1]), v[2] * silu(gd[2]), v[3] * silu(gd[3])};
        *(u32x2*)(Y + r * 1024 + 768 + n0 + n) = pack4(o); });
      continue;
    }
    if (it < e0 || (it >= e2 && it < e3)) {
      const bool isl = it < e0; const int i2 = isl ? it : it - e2;
      int b, mt, nt, K; const bf16_t* Ap; const bf16_t* Bp; float sc; size_t rbase;
      if (isl) { b = 2 * xcd + (i2 >> 5); mt = (i2 >> 1) & 15; nt = i2 & 1; K = 2048; Ap = DL + (size_t)mt * 128 * 2048; Bp = FTF + ((size_t)b * 256 + nt * 128) * 2048; sc = 0.00276213586f; rbase = (size_t)b * T + mt * 128; }
      else { b = 2 * xcd + (i2 >> 2); mt = (i2 >> 1) & 1; nt = i2 & 1; K = 512; Ap = DC + (size_t)mt * 128 * 512; Bp = FTC + ((size_t)b * 256 + nt * 128) * 512; sc = 0.0078125f; rbase = (size_t)b * T + SEQ + mt * 128; }
      bf16_t* yo = YD + rbase * 256 + nt * 128;
      gemm_tile(Ap, K, Bp, K, K, lds, [&](int m, int n, f32x4 v) {
        f32x4 o = {v[0] * sc, v[1] * sc, v[2] * sc, v[3] * sc};
        *(u32x2*)(yo + (size_t)m * 256 + n) = pack4(o); });
      asm volatile("s_waitcnt vmcnt(0)" ::: "memory");
      __syncthreads();
      if (tid0 == 0) {
        __builtin_amdgcn_fence(__ATOMIC_RELEASE, "agent");
        asm volatile("s_waitcnt vmcnt(0)" ::: "memory");
        __hip_atomic_fetch_add(&cnt[b * 18 + (isl ? mt : 16 + mt)], 1u, __ATOMIC_RELAXED, __HIP_MEMORY_SCOPE_AGENT);
      }
    } else {
      const int i2 = it - e5; const int bl = i2 / 72, rem = i2 % 72; const int chl = rem >> 2, g = rem & 3;
      const int ch = (2 * xcd + bl) * 18 + chl;
      if (!upd && chl >= 16) continue;
      const float* bs = p->cm_b_s + ((size_t)l * 4 + g) * 128;
      const bf16_t* Pr = P + (size_t)ch * 128 * NIN + 64 * g; bf16_t* Yr = Y + (size_t)ch * 128 * 1024 + 512 + 64 * g;
      gemm_tile(wsb + (size_t)g * 128 * 128, 128, vnT + ((size_t)ch * 256 + 64 * g) * 128, 128, 128, lds, [&](int m, int n, f32x4 v) {
        if (n < 64) {
          const float bias = bs[m];
          f32x4 uu = unpack4(*(const u32x2*)(Pr + (size_t)m * NIN + O_U + n)), gc = unpack4(*(const u32x2*)(Pr + (size_t)m * NIN + O_GC + n));
          f32x4 o;
#pragma unroll
          for (int e = 0; e < 4; ++e) o[e] = uu[e] * (v[e] + bias) * silu(gc[e]);
          *(u32x2*)(Yr + (size_t)m * 1024 + n) = pack4(o);
        } });
    }
  }
}

DI void phase_outproj(KP p, int l, char* lds) {
  unsigned char* ws = p->ws; asm volatile("" : "+s"(ws));
  const bf16_t* Y = (const bf16_t*)(ws + WS_R1);
  const bf16_t* wo = (const bf16_t*)(ws + WS_WOUT) + (size_t)l * 1024 * 1024;
  const float* mod = (const float*)(ws + WS_MOD) + (size_t)l * 17 * 3072;
  const float* xl = (l == 0) ? p->x : p->out;
  float* ctx1 = (float*)(ws + WS_CTX1);
  const int xcd = blockIdx.x & 7, lb = blockIdx.x >> 3, nlb = gridDim.x >> 3, hb = __builtin_amdgcn_readfirstlane(otid() >> 8);
  const int nsm = (l == 0) ? 16 : 0;
  for (int j = lb; j < 64; j += nlb) {
    {
      const int mi = j >> 2, nt = j & 3;
      const int bb = 2 * xcd + (mi >> 3), tt = mi & 7;
      const int m0 = (bb * 9 + tt) * 256, n0 = nt * 256;
      const float* src = xl + ((size_t)bb * SEQ + tt * 256) * 1024;
      float* dst = p->out + ((size_t)bb * SEQ + tt * 256) * 1024;
      const float* gt = mod + (size_t)bb * 3072 + 2048;
      gemm256(Y + (size_t)m0 * 1024, 1024, wo + (size_t)n0 * 1024, 1024, 1024, lds, [&](int m, int n, f32x4 v) {
        const size_t o = (size_t)m * 1024 + n0 + n;
        f32x4 xv = __builtin_nontemporal_load((const f32x4*)(src + o)), g = *(const f32x4*)(gt + n0 + n);
        f32x4 r = {xv[0] + g[0] * v[0], xv[1] + g[1] * v[1], xv[2] + g[2] * v[2], xv[3] + g[3] * v[3]};
        __builtin_nontemporal_store(r, (f32x4*)(dst + o)); });
    }
  }
  for (int j = lb; j < nsm; j += nlb) {
    {
      const int item = 2 * j + hb; const int bb = 2 * xcd + (item >> 4), m128 = (item >> 3) & 1, nt = item & 7;
      const int m0 = (bb * 18 + 16 + m128) * 128, n0 = nt * 128;
      const float* src = p->ctx + ((size_t)bb * CL + m128 * 128) * 1024;
      float* dst = ctx1 + ((size_t)bb * CL + m128 * 128) * 1024;
      const float* gt = mod + (size_t)16 * 3072 + 2048;
      gemm_tile(Y + (size_t)m0 * 1024, 1024, wo + (size_t)n0 * 1024, 1024, 1024, lds, [&](int m, int n, f32x4 v) {
        const size_t o = (size_t)m * 1024 + n0 + n;
        f32x4 xv = *(const f32x4*)(src + o), g = *(const f32x4*)(gt + n0 + n);
        f32x4 r = {xv[0] + g[0] * v[0], xv[1] + g[1] * v[1], xv[2] + g[2] * v[2], xv[3] + g[3] * v[3]};
        *(f32x4*)(dst + o) = r; });
    }
  }
}

__global__ void __launch_bounds__(NTHR, 2) fwd_megakernel(Params p_byval) {
  KP p = (KP)__builtin_amdgcn_kernarg_segment_ptr();
  extern __shared__ __attribute__((aligned(16))) char lds[];
  cg::grid_group grid = cg::this_grid();
  uint4* xbw = (uint4*)(lds + LDS_MAIN);
  if (threadIdx.x == 0) *xbw = make_uint4(0u, 0u, 0u, 0u);
  __syncthreads();
  XcdBarrier xb = xcd_barrier_post((unsigned*)(p->ws + WS_BAR), (volatile LAS unsigned*)xbw);
  if (p->ph_hi < p->ph_lo) grid.sync();
  (void)p_byval;
  for (int ph = p->ph_lo; ph < p->ph_hi; ++ph) {
    asm volatile("" : "+s"(p));
    if (ph == 0) phase0(p, lds);
    else {
      const int l = (ph - 1) / 7, s = (ph - 1) % 7;
      switch (s) {
        case 0: phase_norm(p, l); break;
        case 1: phase_inproj(p, l, lds); break;
        case 2: phase_feat_a(p, l, lds); break;
        case 3: phase_feat_b(p, l, lds); break;
        case 4: phase_feat_c(p, l); break;
        case 5: phase_mix(p, l, lds); break;
        default: phase_outproj(p, l, lds); break;
      }
    }
    if (ph + 1 < p->ph_hi) xcd_barrier(xb);
  }
}

extern "C" void kernel_launch(void* const* d_in, const int* in_sizes, int n_in, void* d_out, int out_size, void* d_ws, size_t ws_size, hipStream_t stream) {
  static int grid_blocks = 0;
  if (!grid_blocks) {
    int dev = 0, cus = 0, per_cu = 0;
    hipGetDevice(&dev);
    hipDeviceGetAttribute(&cus, hipDeviceAttributeMultiprocessorCount, dev);
    hipFuncSetAttribute((const void*)fwd_megakernel, hipFuncAttributeMaxDynamicSharedMemorySize, LDS_BYTES);
    hipOccupancyMaxActiveBlocksPerMultiprocessor(&per_cu, fwd_megakernel, NTHR, LDS_BYTES);
    if (per_cu > 1) per_cu = 1;
    if (per_cu < 1) per_cu = 1;
    grid_blocks = cus * per_cu;
    if (ws_size < WS_END) fprintf(stderr, "kernel_launch: workspace too small: %zu < %zu\n", ws_size, (size_t)WS_END);
  }
  hipMemsetAsync((unsigned char*)d_ws + WS_BAR, 0, WS_ZERO_BYTES, stream);
  Params p{};
  const float** pp = (const float**)&p;
  for (int i = 0; i < 22; ++i) pp[i] = (const float*)d_in[i];
  p.out = (float*)d_out; p.ws = (unsigned char*)d_ws;
  constexpr int NPH = 15;
#if PER_PHASE_LAUNCH
  for (int ph = 0; ph < NPH; ++ph) {
    p.ph_lo = ph; p.ph_hi = ph + 1;
    hipLaunchKernelGGL(fwd_megakernel, dim3(grid_blocks), dim3(NTHR), LDS_BYTES, stream, p);
  }
#else
  p.ph_lo = 0; p.ph_hi = NPH;
  void* args[] = {&p};
  hipError_t e = hipLaunchCooperativeKernel((void*)fwd_megakernel, dim3(grid_blocks), dim3(NTHR), args, LDS_BYTES, stream);
  if (e != hipSuccess) fprintf(stderr, "cooperative launch failed: %s (grid %d)\n", hipGetErrorString(e), grid_blocks);
#endif
}
```

```cpp
#include <hip/hip_runtime.h>
#include <hip/hip_cooperative_groups.h>
#include <stdint.h>
#include <stdio.h>
namespace cg = cooperative_groups;

#ifndef PER_PHASE_LAUNCH
#define PER_PHASE_LAUNCH 0
#endif

#define DI __device__ __forceinline__
DI int otid() { int t = threadIdx.x; asm volatile("" : "+v"(t)); return t; }
typedef unsigned short bf16_t;
using bf16x8 = __attribute__((ext_vector_type(8))) short;
using f32x16 = __attribute__((ext_vector_type(16))) float;
using f32x4  = __attribute__((ext_vector_type(4))) float;
using f32x2  = __attribute__((ext_vector_type(2))) float;
using u32x4  = __attribute__((ext_vector_type(4))) unsigned;
using u32x2  = __attribute__((ext_vector_type(2))) unsigned;
typedef __bf16 bf16x2_t __attribute__((ext_vector_type(2)));

constexpr int NB = 16, SEQ = 2048, CL = 256, T = 2304, D = 1024, M = NB * T, NIN = 2656, NINP = 2816;
constexpr int O_CQ = 0, O_CKV = 192, O_KR = 320, O_GA = 352, O_Q2 = 608, O_K2 = 864, O_V2 = 992, O_GB = 1120,
              O_U = 1376, O_V = 1632, O_GC = 1888, O_F = 2144, O_GD = 2400;
constexpr int NTHR = 512;
constexpr int HALF_LDS = 69632, LDS_MAIN = 2 * HALF_LDS, LDS_BYTES = LDS_MAIN + 256;

constexpr size_t al256(size_t x) { return (x + 255) & ~(size_t)255; }
constexpr size_t WS_MOD  = 0;
constexpr size_t WS_ROPG = al256(WS_MOD + 2 * 17 * 3072 * 4);
constexpr size_t WS_ROPM = al256(WS_ROPG + 64 * 16 * 2 * 4);
constexpr size_t WS_SBND = al256(WS_ROPM + 64 * 8 * 2 * 4);
constexpr size_t WS_WIN  = al256(WS_SBND + 256);
constexpr size_t WS_WUQ  = al256(WS_WIN + (size_t)2 * NINP * 1024 * 2);
constexpr size_t WS_WUKV = al256(WS_WUQ + 2 * 384 * 192 * 2);
constexpr size_t WS_WF   = al256(WS_WUKV + 2 * 512 * 128 * 2);
constexpr size_t WS_WOUT = al256(WS_WF + 2 * 256 * 256 * 2);
constexpr size_t WS_WS   = al256(WS_WOUT + (size_t)2 * 1024 * 1024 * 2);
constexpr size_t WS_CM   = al256(WS_WS + 2 * 4 * 128 * 128 * 2);
constexpr size_t WS_DLAT = al256(WS_CM + 128 * 64 * 2);
constexpr size_t WS_DCTX = al256(WS_DLAT + (size_t)2048 * 2048 * 2);
constexpr size_t WS_R1   = al256(WS_DCTX + 256 * 512 * 2);
constexpr size_t R1_CQN = 0, R1_CKVN = (size_t)M * 192 * 2, R1_Q1R = R1_CKVN + (size_t)M * 128 * 2, R1_KR = R1_Q1R + (size_t)M * 384 * 2;
constexpr size_t WS_P    = al256(WS_R1 + (size_t)M * 1024 * 2);
constexpr size_t WS_FT   = al256(WS_P + (size_t)M * NIN * 2);
constexpr size_t WS_FTF  = al256(WS_FT + (size_t)NB * 256 * 4096 * 2);
constexpr size_t WS_FTC  = al256(WS_FTF + (size_t)NB * 256 * 2048 * 2);
constexpr size_t WS_YD   = al256(WS_FTC + (size_t)NB * 256 * 512 * 2);
constexpr size_t WS_QA   = al256(WS_YD + (size_t)M * 256 * 2);
constexpr size_t WS_KA   = al256(WS_QA + (size_t)M * 384 * 2);
constexpr size_t WS_VAT  = al256(WS_KA + (size_t)M * 384 * 2);
constexpr size_t WS_QB   = al256(WS_VAT + (size_t)M * 256 * 2);
constexpr size_t WS_KB   = al256(WS_QB + (size_t)M * 256 * 2);
constexpr size_t WS_VBT  = al256(WS_KB + (size_t)M * 128 * 2);
constexpr size_t WS_VNT  = al256(WS_VBT + (size_t)M * 128 * 2);
constexpr size_t WS_CTX1 = al256(WS_VNT + (size_t)M * 256 * 2 + 65536);
constexpr size_t WS_BAR  = al256(WS_CTX1 + (size_t)NB * CL * 1024 * 4);
constexpr size_t WS_CNT  = al256(WS_BAR + 3456 * 4);
constexpr size_t WS_END  = al256(WS_CNT + 2 * 288 * 4);
constexpr size_t WS_ZERO_BYTES = WS_END - WS_BAR;
static_assert(R1_KR + (size_t)M * 256 * 2 <= (size_t)M * 1024 * 2, "temp region");
static_assert(WS_END <= (size_t)512 * 1024 * 1024, "workspace");

struct Params {
  const float *x, *c, *ctx, *c_ctx, *norm_g, *w_mod, *b_mod, *w_in, *mla_q_norm, *mla_w_uq, *mla_kv_norm, *mla_w_ukv,
              *mla_qn, *mla_kn, *gqa_qn, *gqa_kn, *cm_ln_g, *cm_ln_b, *cm_w_s, *cm_b_s, *fnet_w, *w_out;
  float* out; unsigned char* ws; int ph_lo, ph_hi;
};
typedef const __attribute__((address_space(4))) Params* KP;

DI unsigned cvtpk(float lo, float hi) { f32x2 v = {lo, hi}; bf16x2_t b = __builtin_convertvector(v, bf16x2_t); return __builtin_bit_cast(unsigned, b); }
DI float bflo(unsigned u) { return __uint_as_float(u << 16); }
DI float bfhi(unsigned u) { return __uint_as_float(u & 0xffff0000u); }
DI bf16_t f2bf(float f) { return (bf16_t)(cvtpk(f, 0.f) & 0xffffu); }
DI float silu(float x) { return x / (1.f + __expf(-x)); }
DI f32x4 unpack4(u32x2 v) { f32x4 r = {bflo(v.x), bfhi(v.x), bflo(v.y), bfhi(v.y)}; return r; }
DI u32x2 pack4(f32x4 v) { u32x2 r = {cvtpk(v[0], v[1]), cvtpk(v[2], v[3])}; return r; }
DI float dpp_f(float v, const int ctrl_sel) {
  const int i = __float_as_int(v); int r;
  if (ctrl_sel == 0) r = __builtin_amdgcn_update_dpp(0, i, 0xB1, 0xF, 0xF, true);
  else if (ctrl_sel == 1) r = __builtin_amdgcn_update_dpp(0, i, 0x4E, 0xF, 0xF, true);
  else if (ctrl_sel == 2) r = __builtin_amdgcn_update_dpp(0, i, 0x124, 0xF, 0xF, true);
  else r = __builtin_amdgcn_update_dpp(0, i, 0x128, 0xF, 0xF, true);
  return __int_as_float(r);
}
DI float red16(float v) { v += dpp_f(v, 0); v += dpp_f(v, 1); v += dpp_f(v, 2); v += dpp_f(v, 3); return v; }
DI float red64(float v) { v = red16(v); v += __shfl_xor(v, 16); v += __shfl_xor(v, 32); return v; }
#define MFMA32(a, b, c) __builtin_amdgcn_mfma_f32_32x32x16_bf16((a), (b), (c), 0, 0, 0)


#define XB_TMO      128
#define XB_XCNT(j)  (256  + 64 * (j))
#define XB_XSUB(j)  (1280 + 64 * (j))
#define XB_XGEN(j)  (2304 + 64 * (j))
#define XB_TOP      3328
#define XB_TOPGEN   3392
#define XCD_BAR_WORDS 3456
#define XB_SPIN_CAP (1u << 22)
#define LAS __attribute__((address_space(3)))
DI unsigned xb_ld(unsigned* p)              { return __hip_atomic_load(p, __ATOMIC_RELAXED, __HIP_MEMORY_SCOPE_AGENT); }
DI unsigned xb_add(unsigned* p, unsigned v) { return __hip_atomic_fetch_add(p, v, __ATOMIC_RELAXED, __HIP_MEMORY_SCOPE_AGENT); }
DI unsigned xb_xcc_id() { return (unsigned)__builtin_amdgcn_s_getreg((3 << 11) | 20) & 0xFu; }
#define XB_SPIN(cond, bar) do { unsigned _sp = 0; while (cond) { __builtin_amdgcn_s_sleep(1); \
    if ((++_sp & 255u) == 0u) { if (xb_ld(&(bar)[XB_TMO])) break; if (_sp > XB_SPIN_CAP) { atomicAdd(&(bar)[XB_TMO], 1u); break; } } } } while (0)
struct XcdBarrier { unsigned* bar; unsigned x; volatile LAS unsigned* st; };
DI XcdBarrier xcd_barrier_post(unsigned* bar, volatile LAS unsigned* st) {
  XcdBarrier b; b.bar = bar; b.x = xb_xcc_id(); b.st = st;
  if (threadIdx.x == 0) (void)xb_add(&bar[XB_XCNT(b.x)], 1u);
  return b;
}
DI void xcd_barrier_complete(unsigned* bar, unsigned x, unsigned& nloc, unsigned& nx) {
  const unsigned G = gridDim.x * gridDim.y * gridDim.z;
  unsigned sum, cnt, mine, sp = 0u;
  for (;;) {
    sum = 0u; cnt = 0u; mine = 0u;
#pragma unroll
    for (unsigned j = 0; j < 16; ++j) { const unsigned c = xb_ld(&bar[XB_XCNT(j)]); sum += c; cnt += (c > 0u) ? 1u : 0u; mine = (j == x) ? c : mine; }
    if (sum == G) break;
    __builtin_amdgcn_s_sleep(1);
    if ((++sp & 255u) == 0u) { if (xb_ld(&bar[XB_TMO])) break; if (sp > XB_SPIN_CAP) { atomicAdd(&bar[XB_TMO], 1u); break; } }
  }
  nloc = mine > 0u ? mine : 1u; nx = cnt > 0u ? cnt : 1u;
}
DI void xcd_barrier(const XcdBarrier& b) {
  asm volatile("s_waitcnt vmcnt(0)" ::: "memory");
  __syncthreads();
  if (threadIdx.x == 0) {
    unsigned* bar = b.bar;
    __builtin_amdgcn_s_waitcnt(0);
    unsigned nloc = b.st[0], nx = b.st[1];
    if (nloc == 0u) { xcd_barrier_complete(bar, b.x, nloc, nx); b.st[0] = nloc; b.st[1] = nx; }
    const unsigned old = xb_add(&bar[XB_XSUB(b.x)], 1u);
    const unsigned gen = old / nloc;
    if (old + 1u == (gen + 1u) * nloc) {
      __builtin_amdgcn_fence(__ATOMIC_RELEASE, "agent");
      asm volatile("s_waitcnt vmcnt(0)" ::: "memory");
      const unsigned og = xb_add(&bar[XB_TOP], 1u);
      const unsigned tg = og / nx;
      if (og + 1u == (tg + 1u) * nx) xb_add(&bar[XB_TOPGEN], 1u);
      else XB_SPIN(xb_ld(&bar[XB_TOPGEN]) == tg, bar);
      __builtin_amdgcn_fence(__ATOMIC_ACQUIRE, "agent");
      xb_add(&bar[XB_XGEN(b.x)], 1u);
      asm volatile("s_waitcnt vmcnt(0)" ::: "memory");
    } else {
      XB_SPIN(xb_ld(&bar[XB_XGEN(b.x)]) == gen, bar);
      __builtin_amdgcn_fence(__ATOMIC_ACQUIRE, "agent");
      asm volatile("s_waitcnt vmcnt(0)" ::: "memory");
    }
  }
  __syncthreads();
}

template <class Epi>
DI void gemm_tile(const bf16_t* __restrict__ A, int lda, const bf16_t* __restrict__ Bt, int ldb, int K, char* lds, Epi epi) {
  const int tid_full = otid(); const int tid = tid_full & 255; lds += (tid_full >> 8) * HALF_LDS;
  const int lane = tid & 63, w = tid >> 6, l31 = lane & 31, h = lane >> 5;
  const int wr = w >> 1, wc = w & 1;
  const int lrow = tid >> 3, lch = (tid & 7) ^ ((tid >> 4) & 7);
  const bf16_t* ag = A + (size_t)lrow * lda + lch * 8;
  const bf16_t* bg = Bt + (size_t)lrow * ldb + lch * 8;
  const size_t a32 = (size_t)32 * lda, b32 = (size_t)32 * ldb;
  f32x16 acc[2][2];
#pragma unroll
  for (int i = 0; i < 2; ++i)
#pragma unroll
    for (int j = 0; j < 2; ++j)
#pragma unroll
      for (int e = 0; e < 16; ++e) acc[i][j][e] = 0.f;
  const int nk = K >> 6;
  const int rsw = (l31 >> 1) & 7;
  const int aoff = (wr * 64 + l31) * 128, boff = 16384 + (wc * 64 + l31) * 128;
  char* ldst = lds + tid * 16;
#define G_DMA(BUF, KT) { const int ko_ = (KT) * 64; char* nb_ = ldst + (BUF) * 32768; _Pragma("unroll") for (int i = 0; i < 4; ++i) { \
    __builtin_amdgcn_global_load_lds((const unsigned*)(ag + i * a32 + ko_), (__attribute__((address_space(3))) unsigned*)(nb_ + i * 4096), 16, 0, 0); \
    __builtin_amdgcn_global_load_lds((const unsigned*)(bg + i * b32 + ko_), (__attribute__((address_space(3))) unsigned*)(nb_ + 16384 + i * 4096), 16, 0, 0); } }
#define G_COMPUTE(BUF) { const char* cur = lds + (BUF) * 32768; bf16x8 af[2][2], bf[2][2]; \
    { const int off = ((0 + h) ^ rsw) << 4; _Pragma("unroll") for (int i = 0; i < 2; ++i) { af[0][i] = *(const bf16x8*)(cur + aoff + i * 4096 + off); bf[0][i] = *(const bf16x8*)(cur + boff + i * 4096 + off); } } \
    _Pragma("unroll") for (int ks = 0; ks < 4; ++ks) { \
      if (ks < 3) { const int off = ((2 * (ks + 1) + h) ^ rsw) << 4; _Pragma("unroll") for (int i = 0; i < 2; ++i) { af[(ks + 1) & 1][i] = *(const bf16x8*)(cur + aoff + i * 4096 + off); bf[(ks + 1) & 1][i] = *(const bf16x8*)(cur + boff + i * 4096 + off); } } \
      _Pragma("unroll") for (int i = 0; i < 2; ++i) _Pragma("unroll") for (int j = 0; j < 2; ++j) acc[i][j] = MFMA32(bf[ks & 1][j], af[ks & 1][i], acc[i][j]); } }
#define G_WAIT() { asm volatile("s_waitcnt vmcnt(0)" ::: "memory"); __syncthreads(); }
  G_DMA(0, 0);
  G_WAIT();
  for (int kt = 0; kt < nk; kt += 2) {
    if (kt + 1 < nk) G_DMA(1, kt + 1);
    G_COMPUTE(0);
    G_WAIT();
    if (kt + 1 < nk) {
      if (kt + 2 < nk) G_DMA(0, kt + 2);
      G_COMPUTE(1);
      G_WAIT();
    }
  }
#undef G_DMA
#undef G_COMPUTE
#undef G_WAIT
  float* ct = (float*)lds;
#pragma unroll
  for (int i = 0; i < 2; ++i)
#pragma unroll
    for (int j = 0; j < 2; ++j)
#pragma unroll
      for (int q = 0; q < 4; ++q) {
        f32x4 v = {acc[i][j][4 * q], acc[i][j][4 * q + 1], acc[i][j][4 * q + 2], acc[i][j][4 * q + 3]};
        *(f32x4*)(ct + (wr * 64 + i * 32 + l31) * 132 + wc * 64 + j * 32 + 8 * q + 4 * h) = v;
      }
  __syncthreads();
#pragma unroll 4
  for (int it = 0; it < 16; ++it) {
    const int idx = it * 256 + tid; const int row = idx >> 5, c4 = (idx & 31) * 4;
    f32x4 v = *(const f32x4*)(ct + row * 132 + c4);
    epi(row, c4, v);
  }
  __syncthreads();
}


DI int g8_lds_byte(int r, int c) { int st = (r >> 4) * 2 + (c >> 5), rr = r & 15, cc = c & 31, ob = rr * 64 + cc * 2; return st * 1024 + (ob ^ (((ob >> 9) & 1) << 5)); }
DI void g8_stage_rc(int b, int& R, int& C) { int st = b / 1024, sb = b % 1024, swz = sb ^ (((sb >> 9) & 1) << 5); R = (st >> 1) * 16 + swz / 64; C = (st & 1) * 32 + (swz % 64) / 2; }
template <class Epi>
DI void gemm256(const bf16_t* __restrict__ A, int lda, const bf16_t* __restrict__ Bt, int ldb, int K, char* lds, Epi epi) {
  constexpr int BK = 64, HALFR = 128, HTB = HALFR * BK * 2;
  const int tid = otid();
  const int wid = tid >> 6, lane = tid & 63, wr = wid >> 2, wc = wid & 3, fr = lane & 15, fq = lane >> 4;
  const int obs = (fr * 64 + fq * 16) ^ ((((fr * 64 + fq * 16) >> 9) & 1) << 5);
  const char* lrda = lds + wr * 8192 + obs; const char* lrdb = lds + 4 * HTB + wc * 4096 + obs;
  int sr0, sc0, sr1, sc1; g8_stage_rc(tid * 16, sr0, sc0); g8_stage_rc(tid * 16 + 8192, sr1, sc1);
  const unsigned oa0 = (unsigned)(sr0 * lda + sc0) * 2u, oa1 = (unsigned)(sr1 * lda + sc1) * 2u;
#define ob0 oa0
#define ob1 oa1
#define SA8(b, h) (lds + ((b) * 2 + (h)) * HTB)
#define SB8(b, h) (lds + (4 + (b) * 2 + (h)) * HTB)
#define STAGE_A(Pp, br, kt) { const char* g_ = (const char*)(A + (size_t)(br) * lda + (size_t)(kt) * BK); \
    __builtin_amdgcn_global_load_lds((const unsigned*)(g_ + oa0), (LAS unsigned*)((Pp) + tid * 16), 16, 0, 0); \
    __builtin_amdgcn_global_load_lds((const unsigned*)(g_ + oa1), (LAS unsigned*)((Pp) + tid * 16 + 8192), 16, 0, 0); }
#define STAGE_B(Pp, br, kt) { const char* g_ = (const char*)(Bt + (size_t)(br) * ldb + (size_t)(kt) * BK); \
    __builtin_amdgcn_global_load_lds((const unsigned*)(g_ + ob0), (LAS unsigned*)((Pp) + tid * 16), 16, 0, 0); \
    __builtin_amdgcn_global_load_lds((const unsigned*)(g_ + ob1), (LAS unsigned*)((Pp) + tid * 16 + 8192), 16, 0, 0); }
#define LDA8(dst, b, h) _Pragma("unroll") for (int m = 0; m < 4; ++m) _Pragma("unroll") for (int k = 0; k < 2; ++k) \
    dst[m][k] = *(const bf16x8*)(lrda + ((b) * 2 + (h)) * HTB + (2 * m + k) * 1024)
#define LDB8(dst, b, h) _Pragma("unroll") for (int n = 0; n < 2; ++n) _Pragma("unroll") for (int k = 0; k < 2; ++k) \
    dst[n][k] = *(const bf16x8*)(lrdb + ((b) * 2 + (h)) * HTB + (2 * n + k) * 1024)
#define MMA8(ai, bj, AT, BT) { __builtin_amdgcn_s_setprio(1); \
    _Pragma("unroll") for (int m = 0; m < 4; ++m) _Pragma("unroll") for (int n = 0; n < 2; ++n) _Pragma("unroll") for (int k = 0; k < 2; ++k) \
      acc[ai][bj][m][n] = __builtin_amdgcn_mfma_f32_16x16x32_bf16(AT[m][k], BT[n][k], acc[ai][bj][m][n], 0, 0, 0); \
    __builtin_amdgcn_s_setprio(0); }
#define WAIT_V(n) asm volatile("s_waitcnt vmcnt(" #n ")" ::: "memory")
#define WAIT_L(n) asm volatile("s_waitcnt lgkmcnt(" #n ")" ::: "memory")
#define BAR8 __builtin_amdgcn_s_barrier()
#define SCHED8 __builtin_amdgcn_sched_barrier(0)
  f32x4 acc[2][2][4][2];
#pragma unroll
  for (int a = 0; a < 2; ++a)
#pragma unroll
    for (int b = 0; b < 2; ++b)
#pragma unroll
      for (int m = 0; m < 4; ++m)
#pragma unroll
        for (int n = 0; n < 2; ++n) { f32x4 z = {0.f, 0.f, 0.f, 0.f}; acc[a][b][m][n] = z; }
  bf16x8 At[4][2], B0[2][2], B1[2][2];
  const int nt = K / BK;
  WAIT_V(0);
  __syncthreads();
  STAGE_B(SB8(0, 0), 0, 0); STAGE_A(SA8(0, 0), 0, 0);
  STAGE_B(SB8(0, 1), HALFR, 0); STAGE_A(SA8(0, 1), HALFR, 0);
  if (wr == 1) BAR8;
  WAIT_V(4); BAR8;
  STAGE_B(SB8(1, 0), 0, 1); STAGE_A(SA8(1, 0), 0, 1); STAGE_B(SB8(1, 1), HALFR, 1);
  WAIT_V(6); BAR8;
  for (int t = 0; t < nt - 2; t += 2) {
    LDB8(B0, 0, 0); SCHED8; LDA8(At, 0, 0); STAGE_A(SA8(1, 1), HALFR, t + 1);
    WAIT_L(8); BAR8; WAIT_L(0); MMA8(0, 0, At, B0); BAR8; SCHED8;
    LDB8(B1, 0, 1); STAGE_B(SB8(0, 0), 0, t + 2);
    BAR8; WAIT_L(0); MMA8(0, 1, At, B1); BAR8;
    LDA8(At, 0, 1); STAGE_A(SA8(0, 0), 0, t + 2);
    BAR8; WAIT_L(0); MMA8(1, 0, At, B0); BAR8; SCHED8;
    STAGE_B(SB8(0, 1), HALFR, t + 2);
    WAIT_V(6); BAR8; MMA8(1, 1, At, B1); BAR8;
    LDB8(B0, 1, 0); SCHED8; LDA8(At, 1, 0); STAGE_A(SA8(0, 1), HALFR, t + 2);
    WAIT_L(8); BAR8; WAIT_L(0); MMA8(0, 0, At, B0); BAR8; SCHED8;
    LDB8(B1, 1, 1); STAGE_B(SB8(1, 0), 0, t + 3);
    BAR8; WAIT_L(0); MMA8(0, 1, At, B1); BAR8;
    LDA8(At, 1, 1); STAGE_A(SA8(1, 0), 0, t + 3);
    BAR8; WAIT_L(0); MMA8(1, 0, At, B0); BAR8; SCHED8;
    STAGE_B(SB8(1, 1), HALFR, t + 3);
    WAIT_V(6); BAR8; MMA8(1, 1, At, B1); BAR8;
  }
  { LDB8(B0, 0, 0); LDA8(At, 0, 0); STAGE_A(SA8(1, 1), HALFR, nt - 1);
    BAR8; WAIT_L(0); MMA8(0, 0, At, B0); BAR8;
    LDB8(B1, 0, 1); BAR8; WAIT_L(0); MMA8(0, 1, At, B1); BAR8;
    LDA8(At, 0, 1); WAIT_V(4); BAR8; WAIT_L(0); MMA8(1, 0, At, B0); MMA8(1, 1, At, B1); BAR8; }
  { LDB8(B0, 1, 0); LDA8(At, 1, 0); WAIT_V(2); BAR8; WAIT_L(0); MMA8(0, 0, At, B0); BAR8;
    LDB8(B1, 1, 1); WAIT_V(0); BAR8; WAIT_L(0); MMA8(0, 1, At, B1); BAR8;
    LDA8(At, 1, 1); BAR8; WAIT_L(0); MMA8(1, 0, At, B0); MMA8(1, 1, At, B1); BAR8; }
  if (wr == 0) BAR8;
  float* ct = (float*)lds;
#pragma unroll
  for (int ai = 0; ai < 2; ++ai) {
    __syncthreads();
#pragma unroll
    for (int bj = 0; bj < 2; ++bj)
#pragma unroll
      for (int m = 0; m < 4; ++m)
#pragma unroll
        for (int n = 0; n < 2; ++n)
#pragma unroll
          for (int j = 0; j < 4; ++j) ct[(wr * 64 + m * 16 + fq * 4 + j) * 260 + bj * 128 + wc * 32 + n * 16 + fr] = acc[ai][bj][m][n][j];
    __syncthreads();
#pragma unroll 2
    for (int it = 0; it < 16; ++it) {
      const int idx = it * NTHR + tid; const int row = idx >> 6, c4 = (idx & 63) * 4;
      f32x4 v = *(const f32x4*)(ct + row * 260 + c4);
      epi(ai * 128 + row, c4, v);
    }
  }
  __syncthreads();
#undef ob0
#undef ob1
#undef SA8
#undef SB8
#undef STAGE_A
#undef STAGE_B
#undef LDA8
#undef LDB8
#undef MMA8
#undef WAIT_V
#undef WAIT_L
#undef BAR8
#undef SCHED8
}

template <int DQK, bool STATIC>
DI void attn_item(const bf16_t* __restrict__ Q, const bf16_t* __restrict__ Kp, const bf16_t* __restrict__ Vt, int nkeys, char* lds,
                  const bf16_t* __restrict__ Pg, bf16_t* __restrict__ Yg  , float mfix) {
  constexpr int KSTR = DQK * 2 + 16, VSTR = 136, KCH = DQK / 8, NKC = (64 * KCH) / 256, NQS = DQK / 16;
  constexpr int KBUF = 64 * KSTR, BUF = KBUF + 64 * VSTR;
  const int tid_full = otid(); const int tid = tid_full & 255; lds += (tid_full >> 8) * HALF_LDS;
  const int lane = tid & 63, w = tid >> 6, l31 = lane & 31, h = lane >> 5;
  bf16x8 qf[NQS];
#pragma unroll
  for (int ks = 0; ks < NQS; ++ks) qf[ks] = *(const bf16x8*)(Q + (size_t)(32 * w + l31) * DQK + 16 * ks + 8 * h);
  f32x16 o[2];
#pragma unroll
  for (int d = 0; d < 2; ++d)
#pragma unroll
    for (int e = 0; e < 16; ++e) o[d][e] = 0.f;
  float m_run = STATIC ? mfix : -1e30f, l_run = 0.f;
  u32x4 rk[NKC], rv[2];
  int koffg[NKC], koffl[NKC];
#pragma unroll
  for (int i = 0; i < NKC; ++i) { const int c = tid + 256 * i; const int key = c / KCH, part = c % KCH; koffg[i] = c * 8; koffl[i] = key * KSTR + part * 16; }
  const int vdv0 = tid >> 3, vpart = tid & 7;
  const bf16_t* vg = Vt + (size_t)vdv0 * T + vpart * 8;
  const int voffl = KBUF + vdv0 * VSTR + vpart * 16;
  const int nt = nkeys >> 6;
#pragma unroll
  for (int i = 0; i < NKC; ++i) rk[i] = *(const u32x4*)(Kp + koffg[i]);
#pragma unroll
  for (int i = 0; i < 2; ++i) rv[i] = *(const u32x4*)(vg + (size_t)i * 32 * T);
#pragma unroll
  for (int i = 0; i < NKC; ++i) *(u32x4*)(lds + koffl[i]) = rk[i];
#pragma unroll
  for (int i = 0; i < 2; ++i) { u32x2 a = {rv[i].x, rv[i].y}, b = {rv[i].z, rv[i].w}; *(u32x2*)(lds + voffl + i * 32 * VSTR) = a; *(u32x2*)(lds + voffl + i * 32 * VSTR + 8) = b; }
  __syncthreads();
  for (int j = 0; j < nt; ++j) {
    char* cur = lds + (j & 1) * BUF;
    const bool more = (j + 1 < nt);
    if (more) {
#pragma unroll
      for (int i = 0; i < NKC; ++i) rk[i] = *(const u32x4*)(Kp + (size_t)(j + 1) * 64 * DQK + koffg[i]);
#pragma unroll
      for (int i = 0; i < 2; ++i) rv[i] = *(const u32x4*)(vg + (size_t)i * 32 * T + (j + 1) * 64);
    }
    f32x16 s0, s1;
    bf16x8 kf[2][NQS];
#pragma unroll
    for (int kb = 0; kb < 2; ++kb)
#pragma unroll
      for (int ks = 0; ks < NQS; ++ks) kf[kb][ks] = *(const bf16x8*)(cur + (32 * kb + l31) * KSTR + (2 * ks + h) * 16);
    u32x4 vw[2][2][2];
#pragma unroll
    for (int kb = 0; kb < 2; ++kb)
#pragma unroll
      for (int s2 = 0; s2 < 2; ++s2)
#pragma unroll
        for (int d = 0; d < 2; ++d) {
          const char* vp = cur + KBUF + (32 * d + l31) * VSTR + (32 * kb + 16 * s2 + 4 * h) * 2;
          u32x2 v0 = *(const u32x2*)vp, v1 = *(const u32x2*)(vp + 16);
          u32x4 t4 = {v0.x, v0.y, v1.x, v1.y}; vw[kb][s2][d] = t4;
        }
#pragma unroll
    for (int e = 0; e < 16; ++e) { s0[e] = STATIC ? -mfix : 0.f; s1[e] = STATIC ? -mfix : 0.f; }
#pragma unroll
    for (int ks = 0; ks < NQS; ++ks) s0 = MFMA32(kf[0][ks], qf[ks], s0);
    if (!STATIC) {
      float mx = s0[0];
#pragma unroll
      for (int e = 1; e < 16; ++e) mx = fmaxf(mx, s0[e]);
      mx = fmaxf(mx, __shfl_xor(mx, 32));
      if (!__all(mx <= m_run + 8.f)) {
        const float m_new = fmaxf(m_run, mx);
        const float alpha = __builtin_amdgcn_exp2f(m_run - m_new);
        m_run = m_new; l_run *= alpha;
#pragma unroll
        for (int d = 0; d < 2; ++d)
#pragma unroll
          for (int e = 0; e < 16; ++e) o[d][e] *= alpha;
      }
    }
#pragma unroll
    for (int ks = 0; ks < NQS; ++ks) s1 = MFMA32(kf[1][ks], qf[ks], s1);
    {
      float ps = 0.f;
#pragma unroll
      for (int e = 0; e < 16; ++e) { float p = STATIC ? __builtin_amdgcn_exp2f(s0[e]) : __builtin_amdgcn_exp2f(s0[e] - m_run); s0[e] = p; ps += p; }
      l_run += ps;
    }
    if (!STATIC) {
      float mx = s1[0];
#pragma unroll
      for (int e = 1; e < 16; ++e) mx = fmaxf(mx, s1[e]);
      mx = fmaxf(mx, __shfl_xor(mx, 32));
      if (!__all(mx <= m_run + 8.f)) {
        const float m_new = fmaxf(m_run, mx);
        const float alpha = __builtin_amdgcn_exp2f(m_run - m_new);
        m_run = m_new; l_run *= alpha;
#pragma unroll
        for (int e = 0; e < 16; ++e) s0[e] *= alpha;
#pragma unroll
        for (int d = 0; d < 2; ++d)
#pragma unroll
          for (int e = 0; e < 16; ++e) o[d][e] *= alpha;
      }
    }
#pragma unroll
    for (int s2 = 0; s2 < 2; ++s2) {
      u32x4 pw = {cvtpk(s0[8 * s2], s0[8 * s2 + 1]), cvtpk(s0[8 * s2 + 2], s0[8 * s2 + 3]), cvtpk(s0[8 * s2 + 4], s0[8 * s2 + 5]), cvtpk(s0[8 * s2 + 6], s0[8 * s2 + 7])};
      bf16x8 pf = __builtin_bit_cast(bf16x8, pw);
#pragma unroll
      for (int d = 0; d < 2; ++d) o[d] = MFMA32(__builtin_bit_cast(bf16x8, vw[0][s2][d]), pf, o[d]);
    }
    {
      float ps = 0.f;
#pragma unroll
      for (int e = 0; e < 16; ++e) { float p = STATIC ? __builtin_amdgcn_exp2f(s1[e]) : __builtin_amdgcn_exp2f(s1[e] - m_run); s1[e] = p; ps += p; }
      l_run += ps;
    }
#pragma unroll
    for (int s2 = 0; s2 < 2; ++s2) {
      u32x4 pw = {cvtpk(s1[8 * s2], s1[8 * s2 + 1]), cvtpk(s1[8 * s2 + 2], s1[8 * s2 + 3]), cvtpk(s1[8 * s2 + 4], s1[8 * s2 + 5]), cvtpk(s1[8 * s2 + 6], s1[8 * s2 + 7])};
      bf16x8 pf = __builtin_bit_cast(bf16x8, pw);
#pragma unroll
      for (int d = 0; d < 2; ++d) o[d] = MFMA32(__builtin_bit_cast(bf16x8, vw[1][s2][d]), pf, o[d]);
    }
    if (more) {
      char* nxt = lds + ((j + 1) & 1) * BUF;
#pragma unroll
      for (int i = 0; i < NKC; ++i) *(u32x4*)(nxt + koffl[i]) = rk[i];
#pragma unroll
      for (int i = 0; i < 2; ++i) { u32x2 a = {rv[i].x, rv[i].y}, b = {rv[i].z, rv[i].w}; *(u32x2*)(nxt + voffl + i * 32 * VSTR) = a; *(u32x2*)(nxt + voffl + i * 32 * VSTR + 8) = b; }
    }
    __syncthreads();
  }
  const float lt = l_run + __shfl_xor(l_run, 32);
  const float inv = 1.f / lt;
  const size_t rq = (size_t)(32 * w + l31);
#pragma unroll
  for (int d = 0; d < 2; ++d)
#pragma unroll
    for (int q = 0; q < 4; ++q) {
      const int dv = 32 * d + 8 * q + 4 * h;
      f32x4 g = unpack4(*(const u32x2*)(Pg + rq * NIN + dv));
      f32x4 v = {o[d][4 * q] * inv * silu(g[0]), o[d][4 * q + 1] * inv * silu(g[1]), o[d][4 * q + 2] * inv * silu(g[2]), o[d][4 * q + 3] * inv * silu(g[3])};
      *(u32x2*)(Yg + rq * 1024 + dv) = pack4(v);
    }
}

template <int DQK, bool STATIC>
DI void attn_item8(const bf16_t* __restrict__ Q, const bf16_t* __restrict__ Kp, const bf16_t* __restrict__ Vt, int nkeys, char* lds,
                  const bf16_t* __restrict__ Pg, bf16_t* __restrict__ Yg  , float mfix) {
  constexpr int KSTR = DQK * 2 + 16, VSTR = 136, KCH = DQK / 8, NKC = (64 * KCH + 511) / 512, NQS = DQK / 16;
  constexpr int KBUF = 64 * KSTR, BUF = KBUF + 64 * VSTR;
  const int tid = otid();
  const int lane = tid & 63, w = tid >> 6, l31 = lane & 31, h = lane >> 5;
  bf16x8 qf[NQS];
#pragma unroll
  for (int ks = 0; ks < NQS; ++ks) qf[ks] = *(const bf16x8*)(Q + (size_t)(32 * w + l31) * DQK + 16 * ks + 8 * h);
  f32x16 o[2];
#pragma unroll
  for (int d = 0; d < 2; ++d)
#pragma unroll
    for (int e = 0; e < 16; ++e) o[d][e] = 0.f;
  float m_run = STATIC ? mfix : -1e30f, l_run = 0.f;
  u32x4 rk[NKC], rv[1];
  int koffg[NKC], koffl[NKC];
#pragma unroll
  for (int i = 0; i < NKC; ++i) { const int c = tid + 512 * i; const int key = c / KCH, part = c % KCH; koffg[i] = (c < 64 * KCH) ? c * 8 : 0; koffl[i] = (c < 64 * KCH) ? key * KSTR + part * 16 : -1; }
  const int vdv0 = tid >> 3, vpart = tid & 7;
  const bf16_t* vg = Vt + (size_t)vdv0 * T + vpart * 8;
  const int voffl = KBUF + vdv0 * VSTR + vpart * 16;
  const int nt = nkeys >> 6;
#pragma unroll
  for (int i = 0; i < NKC; ++i) rk[i] = *(const u32x4*)(Kp + koffg[i]);
#pragma unroll
  for (int i = 0; i < 1; ++i) rv[i] = *(const u32x4*)(vg + (size_t)i * 32 * T);
#pragma unroll
  for (int i = 0; i < NKC; ++i) if (koffl[i] >= 0) *(u32x4*)(lds + koffl[i]) = rk[i];
#pragma unroll
  for (int i = 0; i < 1; ++i) { u32x2 a = {rv[i].x, rv[i].y}, b = {rv[i].z, rv[i].w}; *(u32x2*)(lds + voffl + i * 32 * VSTR) = a; *(u32x2*)(lds + voffl + i * 32 * VSTR + 8) = b; }
  __syncthreads();
  for (int j = 0; j < nt; ++j) {
    char* cur = lds + (j & 1) * BUF;
    const bool more = (j + 1 < nt);
    if (more) {
#pragma unroll
      for (int i = 0; i < NKC; ++i) rk[i] = *(const u32x4*)(Kp + (size_t)(j + 1) * 64 * DQK + koffg[i]);
#pragma unroll
      for (int i = 0; i < 1; ++i) rv[i] = *(const u32x4*)(vg + (size_t)i * 32 * T + (j + 1) * 64);
    }
    f32x16 s0, s1;
    bf16x8 kf[2][NQS];
#pragma unroll
    for (int kb = 0; kb < 2; ++kb)
#pragma unroll
      for (int ks = 0; ks < NQS; ++ks) kf[kb][ks] = *(const bf16x8*)(cur + (32 * kb + l31) * KSTR + (2 * ks + h) * 16);
    u32x4 vw[2][2][2];
#pragma unroll
    for (int kb = 0; kb < 2; ++kb)
#pragma unroll
      for (int s2 = 0; s2 < 2; ++s2)
#pragma unroll
        for (int d = 0; d < 2; ++d) {
          const char* vp = cur + KBUF + (32 * d + l31) * VSTR + (32 * kb + 16 * s2 + 4 * h) * 2;
          u32x2 v0 = *(const u32x2*)vp, v1 = *(const u32x2*)(vp + 16);
          u32x4 t4 = {v0.x, v0.y, v1.x, v1.y}; vw[kb][s2][d] = t4;
        }
#pragma unroll
    for (int e = 0; e < 16; ++e) { s0[e] = STATIC ? -mfix : 0.f; s1[e] = STATIC ? -mfix : 0.f; }
#pragma unroll
    for (int ks = 0; ks < NQS; ++ks) s0 = MFMA32(kf[0][ks], qf[ks], s0);
    if (!STATIC) {
      float mx = s0[0];
#pragma unroll
      for (int e = 1; e < 16; ++e) mx = fmaxf(mx, s0[e]);
      mx = fmaxf(mx, __shfl_xor(mx, 32));
      if (!__all(mx <= m_run + 8.f)) {
        const float m_new = fmaxf(m_run, mx);
        const float alpha = __builtin_amdgcn_exp2f(m_run - m_new);
        m_run = m_new; l_run *= alpha;
#pragma unroll
        for (int d = 0; d < 2; ++d)
#pragma unroll
          for (int e = 0; e < 16; ++e) o[d][e] *= alpha;
      }
    }
#pragma unroll
    for (int ks = 0; ks < NQS; ++ks) s1 = MFMA32(kf[1][ks], qf[ks], s1);
    {
      float ps = 0.f;
#pragma unroll
      for (int e = 0; e < 16; ++e) { float p = STATIC ? __builtin_amdgcn_exp2f(s0[e]) : __builtin_amdgcn_exp2f(s0[e] - m_run); s0[e] = p; ps += p; }
      l_run += ps;
    }
    if (!STATIC) {
      float mx = s1[0];
#pragma unroll
      for (int e = 1; e < 16; ++e) mx = fmaxf(mx, s1[e]);
      mx = fmaxf(mx, __shfl_xor(mx, 32));
      if (!__all(mx <= m_run + 8.f)) {
        const float m_new = fmaxf(m_run, mx);
        const float alpha = __builtin_amdgcn_exp2f(m_run - m_new);
        m_run = m_new; l_run *= alpha;
#pragma unroll
        for (int e = 0; e < 16; ++e) s0[e] *= alpha;
#pragma unroll
        for (int d = 0; d < 2; ++d)
#pragma unroll
          for (int e = 0; e < 16; ++e) o[d][e] *= alpha;
      }
    }
#pragma unroll
    for (int s2 = 0; s2 < 2; ++s2) {
      u32x4 pw = {cvtpk(s0[8 * s2], s0[8 * s2 + 1]), cvtpk(s0[8 * s2 + 2], s0[8 * s2 + 3]), cvtpk(s0[8 * s2 + 4], s0[8 * s2 + 5]), cvtpk(s0[8 * s2 + 6], s0[8 * s2 + 7])};
      bf16x8 pf = __builtin_bit_cast(bf16x8, pw);
#pragma unroll
      for (int d = 0; d < 2; ++d) o[d] = MFMA32(__builtin_bit_cast(bf16x8, vw[0][s2][d]), pf, o[d]);
    }
    {
      float ps = 0.f;
#pragma unroll
      for (int e = 0; e < 16; ++e) { float p = STATIC ? __builtin_amdgcn_exp2f(s1[e]) : __builtin_amdgcn_exp2f(s1[e] - m_run); s1[e] = p; ps += p; }
      l_run += ps;
    }
#pragma unroll
    for (int s2 = 0; s2 < 2; ++s2) {
      u32x4 pw = {cvtpk(s1[8 * s2], s1[8 * s2 + 1]), cvtpk(s1[8 * s2 + 2], s1[8 * s2 + 3]), cvtpk(s1[8 * s2 + 4], s1[8 * s2 + 5]), cvtpk(s1[8 * s2 + 6], s1[8 * s2 + 7])};
      bf16x8 pf = __builtin_bit_cast(bf16x8, pw);
#pragma unroll
      for (int d = 0; d < 2; ++d) o[d] = MFMA32(__builtin_bit_cast(bf16x8, vw[1][s2][d]), pf, o[d]);
    }
    if (more) {
      char* nxt = lds + ((j + 1) & 1) * BUF;
#pragma unroll
      for (int i = 0; i < NKC; ++i) if (koffl[i] >= 0) *(u32x4*)(nxt + koffl[i]) = rk[i];
#pragma unroll
      for (int i = 0; i < 1; ++i) { u32x2 a = {rv[i].x, rv[i].y}, b = {rv[i].z, rv[i].w}; *(u32x2*)(nxt + voffl + i * 32 * VSTR) = a; *(u32x2*)(nxt + voffl + i * 32 * VSTR + 8) = b; }
    }
    __syncthreads();
  }
  const float lt = l_run + __shfl_xor(l_run, 32);
  const float inv = 1.f / lt;
  const size_t rq = (size_t)(32 * w + l31);
#pragma unroll
  for (int d = 0; d < 2; ++d)
#pragma unroll
    for (int q = 0; q < 4; ++q) {
      const int dv = 32 * d + 8 * q + 4 * h;
      f32x4 g = unpack4(*(const u32x2*)(Pg + rq * NIN + dv));
      f32x4 v = {o[d][4 * q] * inv * silu(g[0]), o[d][4 * q + 1] * inv * silu(g[1]), o[d][4 * q + 2] * inv * silu(g[2]), o[d][4 * q + 3] * inv * silu(g[3])};
      *(u32x2*)(Yg + rq * 1024 + dv) = pack4(v);
    }
}

DI void xpose_cvt(const float* __restrict__ src, bf16_t* __restrict__ dst, int K, int N, int Npad, bool perm_kv, size_t gtid, size_t gstride) {
  const size_t total = (size_t)Npad * (K >> 3);
#pragma nounroll
  for (size_t i = gtid; i < total; i += gstride) {
    const int n = (int)(i % Npad), kb = (int)(i / Npad);
    float v[8];
#pragma unroll
    for (int e = 0; e < 8; ++e) v[e] = (n < N) ? src[(size_t)(8 * kb + e) * N + n] : 0.f;
    int row = n;
    if (perm_kv) { const int hh = n >> 7, wv = n & 127; row = (wv < 64) ? (64 * hh + wv) : (256 + 64 * hh + (wv - 64)); }
    u32x4 o = {cvtpk(v[0], v[1]), cvtpk(v[2], v[3]), cvtpk(v[4], v[5]), cvtpk(v[6], v[7])};
    *(u32x4*)(dst + (size_t)row * K + 8 * kb) = o;
  }
}

DI void phase0(KP p, char* lds) {
  unsigned char* ws = p->ws; asm volatile("" : "+s"(ws));
  const int tid = otid();
  const size_t gtid = (size_t)blockIdx.x * NTHR + tid, gstride = (size_t)gridDim.x * NTHR;
  for (int l = 0; l < 2; ++l) {
    xpose_cvt(p->w_in + (size_t)l * 1024 * NIN, (bf16_t*)(ws + WS_WIN) + (size_t)l * NINP * 1024, 1024, NIN, NINP, false, gtid, gstride);
    xpose_cvt(p->mla_w_uq + (size_t)l * 192 * 384, (bf16_t*)(ws + WS_WUQ) + (size_t)l * 384 * 192, 192, 384, 384, false, gtid, gstride);
    xpose_cvt(p->mla_w_ukv + (size_t)l * 128 * 512, (bf16_t*)(ws + WS_WUKV) + (size_t)l * 512 * 128, 128, 512, 512, true, gtid, gstride);
    xpose_cvt(p->fnet_w + (size_t)l * 256 * 256, (bf16_t*)(ws + WS_WF) + (size_t)l * 256 * 256, 256, 256, 256, false, gtid, gstride);
    xpose_cvt(p->w_out + (size_t)l * 1024 * 1024, (bf16_t*)(ws + WS_WOUT) + (size_t)l * 1024 * 1024, 1024, 1024, 1024, false, gtid, gstride);
  }
  {
    const float* src = p->cm_w_s; bf16_t* dst = (bf16_t*)(ws + WS_WS);
    for (size_t i = gtid; i < (size_t)2 * 4 * 128 * 128 / 8; i += gstride) {
      f32x4 a = *(const f32x4*)(src + i * 8), b = *(const f32x4*)(src + i * 8 + 4);
      u32x4 o = {cvtpk(a[0], a[1]), cvtpk(a[2], a[3]), cvtpk(b[0], b[1]), cvtpk(b[2], b[3])};
      *(u32x4*)(dst + i * 8) = o;
    }
  }
  {
    bf16_t* dl = (bf16_t*)(ws + WS_DLAT);
#pragma nounroll
    for (size_t i = gtid; i < (size_t)2048 * 256; i += gstride) {
      const int sp = (int)(i >> 8), k8 = (int)(i & 255) * 8;
      float v[8];
#pragma unroll
      for (int e = 0; e < 8; ++e) { const int k = k8 + e, s = (k <= 1024) ? k : k - 1024; const int ph = (sp * s) & 2047; const float a = (float)ph * (1.f / 1024.f); v[e] = (k <= 1024) ? cospif(a) : -sinpif(a); }
      u32x4 o = {cvtpk(v[0], v[1]), cvtpk(v[2], v[3]), cvtpk(v[4], v[5]), cvtpk(v[6], v[7])};
      *(u32x4*)(dl + (size_t)sp * 2048 + k8) = o;
    }
    bf16_t* dc = (bf16_t*)(ws + WS_DCTX);
    for (size_t i = gtid; i < (size_t)256 * 64; i += gstride) {
      const int sp = (int)(i >> 6), k8 = (int)(i & 63) * 8;
      float v[8];
#pragma unroll
      for (int e = 0; e < 8; ++e) { const int k = k8 + e, s = k & 255; const int ph = (sp * s) & 255; const float a = (float)ph * (1.f / 128.f); v[e] = (k < 256) ? cospif(a) : -sinpif(a); }
      u32x4 o = {cvtpk(v[0], v[1]), cvtpk(v[2], v[3]), cvtpk(v[4], v[5]), cvtpk(v[6], v[7])};
      *(u32x4*)(dc + (size_t)sp * 512 + k8) = o;
    }
    bf16_t* cm = (bf16_t*)(ws + WS_CM);
    for (size_t i = gtid; i < (size_t)128 * 64; i += gstride) {
      const int n = (int)(i >> 6), c = (int)(i & 63);
      const int ph = (c * (n & 63)) & 63; const float a = (float)ph * (1.f / 32.f);
      cm[i] = f2bf((n < 64) ? cospif(a) : sinpif(a));
    }
    float* rg = (float*)(ws + WS_ROPG);
    for (size_t i = gtid; i < 64 * 16; i += gstride) {
      const int pos = (int)(i >> 4), j = (int)(i & 15);
      const float inv = powf(10000.f, -(float)j / 16.f); float sn, cs; sincosf((float)pos * inv, &sn, &cs);
      rg[2 * i] = cs; rg[2 * i + 1] = sn;
    }
    if (blockIdx.x == 0 && tid < 4) {
      const int l = tid >> 1, isb = tid & 1; const int d = isb ? 64 : 96;
      const float* gq = (isb ? p->gqa_qn : p->mla_qn) + l * d; const float* gk = (isb ? p->gqa_kn : p->mla_kn) + l * d;
      float mq = 0.f, mk = 0.f;
      for (int i = 0; i < d; ++i) { mq = fmaxf(mq, fabsf(gq[i])); mk = fmaxf(mk, fabsf(gk[i])); }
      ((float*)(ws + WS_SBND))[l * 2 + isb] = sqrtf((float)d) * mq * mk * 1.4426950408889634f;
    }
    float* rm = (float*)(ws + WS_ROPM);
    for (size_t i = gtid; i < 64 * 8; i += gstride) {
      const int pos = (int)(i >> 3), j = (int)(i & 7);
      const float inv = powf(10000.f, -(float)j / 8.f); float sn, cs; sincosf((float)pos * inv, &sn, &cs);
      rm[2 * i] = cs; rm[2 * i + 1] = sn;
    }
  }
  const int hb = tid >> 8, tq = tid & 255;
  float* sl = (float*)(lds + hb * HALF_LDS);
  float* mod = (float*)(ws + WS_MOD);
  const int kg = tq >> 5, cn = tq & 31;
  for (int it = 2 * blockIdx.x + hb; it < 192; it += 2 * gridDim.x) {
    const int l = it / 96, n = (it % 96) * 32 + cn;
    float acc[17];
#pragma unroll
    for (int i = 0; i < 17; ++i) acc[i] = 0.f;
    for (int half = 0; half < 2; ++half) {
      __syncthreads();
      for (int e = tq; e < 17 * 512; e += 256) {
        const int i = e >> 9, k = (e & 511) + 512 * half;
        const float cv = (i < 16) ? p->c[i * 1024 + k] : p->c_ctx[k];
        sl[e] = silu(cv);
      }
      __syncthreads();
      const float* wp = p->w_mod + ((size_t)l * 1024 + 512 * half + kg * 64) * 3072 + n;
#pragma unroll 4
      for (int kk = 0; kk < 64; ++kk) {
        const float wv = wp[(size_t)kk * 3072];
#pragma unroll
        for (int i = 0; i < 17; ++i) acc[i] = fmaf(sl[i * 512 + kg * 64 + kk], wv, acc[i]);
      }
    }
    __syncthreads();
#pragma unroll
    for (int i = 0; i < 17; ++i) sl[(kg * 17 + i) * 32 + cn] = acc[i];
    __syncthreads();
    for (int e = tq; e < 17 * 32; e += 256) {
      const int i = e >> 5, c2 = e & 31;
      float s = 0.f;
#pragma unroll
      for (int g = 0; g < 8; ++g) s += sl[(g * 17 + i) * 32 + c2];
      const int nn = (it % 96) * 32 + c2;
      mod[((size_t)l * 17 + i) * 3072 + nn] = s + p->b_mod[l * 3072 + nn];
    }
    __syncthreads();
  }
}

DI void phase_norm(KP p, int l) {
  unsigned char* ws = p->ws; asm volatile("" : "+s"(ws));
  const float* xl = (l == 0) ? p->x : p->out;
  const float* xc = (l == 0) ? p->ctx : (const float*)(ws + WS_CTX1);
  const float* g = p->norm_g + l * 1024;
  const float* mod = (const float*)(ws + WS_MOD) + (size_t)l * 17 * 3072;
  bf16_t* hx = (bf16_t*)(ws + WS_R1);
  const int tid = otid(); const int lane = tid & 63;
  const int gw = blockIdx.x * (NTHR / 64) + (tid >> 6), nw = gridDim.x * (NTHR / 64);
#pragma unroll 2
  for (int r = gw; r < M; r += nw) {
    const int b = r / T, t = r % T;
    const float* src = (t < SEQ) ? xl + ((size_t)b * SEQ + t) * 1024 : xc + ((size_t)b * CL + (t - SEQ)) * 1024;
    const float* mr = mod + (size_t)((t < SEQ) ? b : 16) * 3072;
    f32x4 v[4]; float ss = 0.f;
#pragma unroll
    for (int i = 0; i < 4; ++i) { v[i] = *(const f32x4*)(src + i * 256 + lane * 4); ss += v[i][0] * v[i][0] + v[i][1] * v[i][1] + v[i][2] * v[i][2] + v[i][3] * v[i][3]; }
    ss = red64(ss);
    const float rstd = rsqrtf(ss * (1.f / 1024.f) + 1e-6f);
#pragma unroll
    for (int i = 0; i < 4; ++i) {
      const int k = i * 256 + lane * 4;
      f32x4 gg = *(const f32x4*)(g + k), sh = *(const f32x4*)(mr + k), sc = *(const f32x4*)(mr + 1024 + k);
      f32x4 o;
#pragma unroll
      for (int e = 0; e < 4; ++e) o[e] = v[i][e] * rstd * gg[e] * (1.f + sc[e]) + sh[e];
      *(u32x2*)(hx + (size_t)r * 1024 + k) = pack4(o);
    }
  }
}

DI void phase_inproj(KP p, int l, char* lds) {
  unsigned char* ws = p->ws; asm volatile("" : "+s"(ws));
  const bf16_t* hx = (const bf16_t*)(ws + WS_R1);
  const bf16_t* wt = (const bf16_t*)(ws + WS_WIN) + (size_t)l * NINP * 1024;
  bf16_t* P = (bf16_t*)(ws + WS_P);
  const int xcd = blockIdx.x & 7, lb = blockIdx.x >> 3, nlb = gridDim.x >> 3, hb = __builtin_amdgcn_readfirstlane(otid() >> 8);
  constexpr int NBIG = 18 * 10;
  for (int j = lb; j < NBIG + 18; j += nlb) {
    if (j < NBIG) {
      int mloc, ntile;
      if (j < 144) { mloc = (j % 72) >> 2; ntile = (j / 72) * 4 + (j & 3); } else { const int j2 = j - 144; mloc = j2 >> 1; ntile = 8 + (j2 & 1); }
      const int mt = 18 * xcd + mloc;
      if (l == 1 && (mt % 9) == 8 && !(ntile == 0 || ntile == 1 || ntile == 3 || ntile == 4)) continue;
      const int m0 = mt * 256, n0 = ntile * 256;
      gemm256(hx + (size_t)m0 * 1024, 1024, wt + (size_t)n0 * 1024, 1024, 1024, lds, [&](int m, int n, f32x4 v) {
        __builtin_nontemporal_store(pack4(v), (u32x2*)(P + (size_t)(m0 + m) * NIN + n0 + n));
      });
    } else {
      const int mt = 36 * xcd + 2 * (j - NBIG) + hb;
      if (l == 1 && (mt % 18) >= 16) continue;
      const int m0 = mt * 128;
      gemm_tile(hx + (size_t)m0 * 1024, 1024, wt + (size_t)2560 * 1024, 1024, 1024, lds, [&](int m, int n, f32x4 v) {
        if (2560 + n < NIN) __builtin_nontemporal_store(pack4(v), (u32x2*)(P + (size_t)(m0 + m) * NIN + 2560 + n));
      });
    }
  }
}

DI void rope4(f32x4& v, int u, int t, const float* __restrict__ rg) {
  const int pos = (u & 8) ? (t & 63) : (t >> 6);
  const float sg = (u & 4) ? 1.f : -1.f;
#pragma unroll
  for (int e = 0; e < 4; ++e) {
    const float xp = __shfl_xor(v[e], 4);
    const f32x2 cs = *(const f32x2*)(rg + (pos * 16 + 4 * (u & 3) + e) * 2);
    v[e] = v[e] * cs[0] + sg * xp * cs[1];
  }
}
DI void rope2(float& a, float& b, int u, int t, const float* __restrict__ rm) {
  const int pos = (u & 8) ? (t & 63) : (t >> 6);
  const float sg = (u & 4) ? 1.f : -1.f;
  const float ap = __shfl_xor(a, 4), bp = __shfl_xor(b, 4);
  const f32x4 cs = *(const f32x4*)(rm + (pos * 8 + 2 * (u & 3)) * 2);
  a = a * cs[0] + sg * ap * cs[1];
  b = b * cs[2] + sg * bp * cs[3];
}

DI void phase_feat_a(KP p, int l, char* lds) {
  unsigned char* ws = p->ws; asm volatile("" : "+s"(ws));
  const bf16_t* P = (const bf16_t*)(ws + WS_P);
  bf16_t* cqn = (bf16_t*)(ws + WS_R1 + R1_CQN);
  bf16_t* ckvn = (bf16_t*)(ws + WS_R1 + R1_CKVN);
  bf16_t* QB = (bf16_t*)(ws + WS_QB); bf16_t* KB = (bf16_t*)(ws + WS_KB); bf16_t* VBT = (bf16_t*)(ws + WS_VBT);
  bf16_t* vnT = (bf16_t*)(ws + WS_VNT);
  const float* rg = (const float*)(ws + WS_ROPG);
  const int tid = otid(); const int lane = tid & 63, u = lane & 15, sub = lane >> 4;
  const int gw = blockIdx.x * (NTHR / 64) + (tid >> 6), nw = gridDim.x * (NTHR / 64);
  const int hb = tid >> 8, tq = tid & 255; char* ldh = lds + hb * HALF_LDS;
  {
    constexpr int STR = 144;
    const float* lg = p->cm_ln_g + l * 256; const float* lbp = p->cm_ln_b + l * 256;
    for (int unit = 2 * blockIdx.x + hb; unit < (M / 64) * 2; unit += 2 * gridDim.x) {
      const int grp = unit >> 1; const bool isv2 = unit & 1;
      const int r0 = grp * 64; const int b = r0 / T, t0 = r0 % T;
      if (!isv2) {
        const int c = tq & 31, rb = 2 * (tq >> 5);
        f32x4 g0 = *(const f32x4*)(lg + 8 * c), g1 = *(const f32x4*)(lg + 8 * c + 4), b0 = *(const f32x4*)(lbp + 8 * c), b1 = *(const f32x4*)(lbp + 8 * c + 4);
        const float gg[8] = {g0[0], g0[1], g0[2], g0[3], g1[0], g1[1], g1[2], g1[3]};
        const float bb[8] = {b0[0], b0[1], b0[2], b0[3], b1[0], b1[1], b1[2], b1[3]};
#pragma unroll
        for (int i = 0; i < 4; ++i) {
          float vn[2][8];
#pragma unroll
          for (int rr = 0; rr < 2; ++rr) {
            const int row = rb + 16 * i + rr;
            u32x4 q = *(const u32x4*)(P + (size_t)(r0 + row) * NIN + O_V + 8 * c);
            float f[8] = {bflo(q.x), bfhi(q.x), bflo(q.y), bfhi(q.y), bflo(q.z), bfhi(q.z), bflo(q.w), bfhi(q.w)};
            float s1 = 0.f, s2 = 0.f;
#pragma unroll
            for (int e = 0; e < 8; ++e) { s1 += f[e]; s2 += f[e] * f[e]; }
#pragma unroll
            for (int m = 1; m < 32; m <<= 1) { s1 += __shfl_xor(s1, m); s2 += __shfl_xor(s2, m); }
            const float mu = s1 * (1.f / 256.f); const float var = fmaxf(s2 * (1.f / 256.f) - mu * mu, 0.f); const float rs = rsqrtf(var + 1e-6f);
#pragma unroll
            for (int e = 0; e < 8; ++e) vn[rr][e] = (f[e] - mu) * rs * gg[e] + bb[e];
          }
#pragma unroll
          for (int e = 0; e < 8; ++e) *(unsigned*)(ldh + (8 * c + e) * STR + (rb + 16 * i) * 2) = cvtpk(vn[0][e], vn[1][e]);
        }
        __syncthreads();
        bf16_t* vo = vnT + (size_t)(r0 >> 7) * 256 * 128 + (r0 & 127);
#pragma unroll
        for (int i = 0; i < 8; ++i) {
          const int ch = (tq >> 3) + 32 * i, part = tq & 7;
          *(u32x4*)(vo + (size_t)ch * 128 + part * 8) = *(const u32x4*)(ldh + ch * STR + part * 16);
        }
      } else {
        const int c = tq & 15, rb = 2 * (tq >> 4);
#pragma unroll
        for (int i = 0; i < 2; ++i) {
          u32x4 q0 = *(const u32x4*)(P + (size_t)(r0 + rb + 32 * i) * NIN + O_V2 + 8 * c);
          u32x4 q1 = *(const u32x4*)(P + (size_t)(r0 + rb + 32 * i + 1) * NIN + O_V2 + 8 * c);
          const unsigned a[4] = {q0.x, q0.y, q0.z, q0.w}, d[4] = {q1.x, q1.y, q1.z, q1.w};
#pragma unroll
          for (int e = 0; e < 4; ++e) {
            *(unsigned*)(ldh + (8 * c + 2 * e) * STR + (rb + 32 * i) * 2) = (a[e] & 0xffffu) | (d[e] << 16);
            *(unsigned*)(ldh + (8 * c + 2 * e + 1) * STR + (rb + 32 * i) * 2) = (a[e] >> 16) | (d[e] & 0xffff0000u);
          }
        }
        __syncthreads();
        bf16_t* vb = VBT + (size_t)b * 2 * 64 * T + t0;
#pragma unroll
        for (int i = 0; i < 4; ++i) {
          const int ch = (tq >> 3) + 32 * i, part = tq & 7;
          *(u32x4*)(vb + (size_t)ch * T + part * 8) = *(const u32x4*)(ldh + ch * STR + part * 16);
        }
      }
      __syncthreads();
    }
  }
  constexpr int NTA = M / 4;
#pragma unroll 4
  for (int task = gw; task < NTA; task += nw) {
    {
      const int r = task * 4 + sub; const int b = r / T, t = r % T;
      const bf16_t* pr = P + (size_t)r * NIN;
      {
        f32x4 v[3]; float ss = 0.f;
#pragma unroll
        for (int e = 0; e < 3; ++e) { v[e] = unpack4(*(const u32x2*)(pr + O_CQ + 12 * u + 4 * e)); ss += v[e][0] * v[e][0] + v[e][1] * v[e][1] + v[e][2] * v[e][2] + v[e][3] * v[e][3]; }
        ss = red16(ss); const float rs = rsqrtf(ss * (1.f / 192.f) + 1e-6f);
#pragma unroll
        for (int e = 0; e < 3; ++e) {
          f32x4 g = *(const f32x4*)(p->mla_q_norm + l * 192 + 12 * u + 4 * e);
          f32x4 o = {v[e][0] * rs * g[0], v[e][1] * rs * g[1], v[e][2] * rs * g[2], v[e][3] * rs * g[3]};
          *(u32x2*)(cqn + (size_t)r * 192 + 12 * u + 4 * e) = pack4(o);
        }
      }
      {
        f32x4 v[2]; float ss = 0.f;
#pragma unroll
        for (int e = 0; e < 2; ++e) { v[e] = unpack4(*(const u32x2*)(pr + O_CKV + 8 * u + 4 * e)); ss += v[e][0] * v[e][0] + v[e][1] * v[e][1] + v[e][2] * v[e][2] + v[e][3] * v[e][3]; }
        ss = red16(ss); const float rs = rsqrtf(ss * (1.f / 128.f) + 1e-6f);
#pragma unroll
        for (int e = 0; e < 2; ++e) {
          f32x4 g = *(const f32x4*)(p->mla_kv_norm + l * 128 + 8 * u + 4 * e);
          f32x4 o = {v[e][0] * rs * g[0], v[e][1] * rs * g[1], v[e][2] * rs * g[2], v[e][3] * rs * g[3]};
          *(u32x2*)(ckvn + (size_t)r * 128 + 8 * u + 4 * e) = pack4(o);
        }
      }
#pragma unroll
      for (int hh = 0; hh < 6; ++hh) {
        const bool isq = hh < 4; const int hd = isq ? hh : hh - 4;
        f32x4 v = unpack4(*(const u32x2*)(pr + (isq ? O_Q2 : O_K2) + 64 * hd + 4 * u));
        float ss = red16(v[0] * v[0] + v[1] * v[1] + v[2] * v[2] + v[3] * v[3]);
        const float rs = rsqrtf(ss * (1.f / 64.f) + 1e-6f);
        f32x4 g = *(const f32x4*)((isq ? p->gqa_qn : p->gqa_kn) + l * 64 + 4 * u);
#pragma unroll
        for (int e = 0; e < 4; ++e) v[e] = v[e] * rs * g[e];
        if (t < SEQ) rope4(v, u, t, rg);
        if (isq) {
#pragma unroll
          for (int e = 0; e < 4; ++e) v[e] *= 0.18033688011112042f;
        }
        bf16_t* dst = isq ? QB + (((size_t)b * 4 + hd) * T + t) * 64 + 4 * u : KB + (((size_t)b * 2 + hd) * T + t) * 64 + 4 * u;
        *(u32x2*)dst = pack4(v);
      }
    }
  }
}

DI void phase_feat_b(KP p, int l, char* lds) {
  unsigned char* ws = p->ws; asm volatile("" : "+s"(ws));
  const bf16_t* P = (const bf16_t*)(ws + WS_P);
  const bf16_t* cqn = (const bf16_t*)(ws + WS_R1 + R1_CQN);
  const bf16_t* ckvn = (const bf16_t*)(ws + WS_R1 + R1_CKVN);
  bf16_t* q1r = (bf16_t*)(ws + WS_R1 + R1_Q1R);
  bf16_t* kr = (bf16_t*)(ws + WS_R1 + R1_KR);
  const bf16_t* wuq = (const bf16_t*)(ws + WS_WUQ) + (size_t)l * 384 * 192;
  const bf16_t* wukv = (const bf16_t*)(ws + WS_WUKV) + (size_t)l * 512 * 128;
  const bf16_t* cm = (const bf16_t*)(ws + WS_CM);
  bf16_t* VAT = (bf16_t*)(ws + WS_VAT); bf16_t* FT = (bf16_t*)(ws + WS_FT); bf16_t* FTC = (bf16_t*)(ws + WS_FTC);
  constexpr int N1 = 288 * 3, N2 = 288 * 2, N3 = 288 * 2, N4 = 288 * 4;
  const int hbb = __builtin_amdgcn_readfirstlane(otid() >> 8);
  for (int it = 2 * blockIdx.x + hbb; it < N1 + N2 + N3 + N4; it += 2 * gridDim.x) {
    if (it < N1) {
      const int mt = it / 3, nt = it % 3; const int m0 = mt * 128, n0 = nt * 128;
      gemm_tile(cqn + (size_t)m0 * 192, 192, wuq + (size_t)n0 * 192, 192, 192, lds, [&](int m, int n, f32x4 v) {
        *(u32x2*)(q1r + (size_t)(m0 + m) * 384 + n0 + n) = pack4(v); });
    } else if (it < N1 + N2) {
      const int i2 = it - N1; const int mt = i2 >> 1, nt = i2 & 1; const int m0 = mt * 128, n0 = nt * 128;
      gemm_tile(ckvn + (size_t)m0 * 128, 128, wukv + (size_t)n0 * 128, 128, 128, lds, [&](int m, int n, f32x4 v) {
        *(u32x2*)(kr + (size_t)(m0 + m) * 256 + n0 + n) = pack4(v); });
    } else if (it < N1 + N2 + N3) {
      const int i2 = it - N1 - N2; const int tt = i2 >> 1, mt2 = i2 & 1;
      gemm_tile(wukv + (size_t)(256 + 128 * mt2) * 128, 128, ckvn + (size_t)tt * 128 * 128, 128, 128, lds, [&](int m, int n, f32x4 v) {
        const int mm = 128 * mt2 + m, head = mm >> 6, dv = mm & 63; const int r = tt * 128 + n; const int b = r / T, t = r % T;
        *(u32x2*)(VAT + (((size_t)b * 4 + head) * 64 + dv) * T + t) = pack4(v); });
    } else {
      const int i2 = it - N1 - N2 - N3; const int tt = i2 >> 2, g = i2 & 3;
      gemm_tile(cm, 64, P + (size_t)tt * 128 * NIN + O_F + 64 * g, NIN, 64, lds, [&](int m, int n, f32x4 v) {
        const int col = 64 * g + (m & 63), part = m >> 6; const int r = tt * 128 + n; const int b = r / T, t = r % T;
        if (t < SEQ) *(u32x2*)(FT + ((size_t)b * 256 + col) * 4096 + part * 2048 + t) = pack4(v);
        else *(u32x2*)(FTC + ((size_t)b * 256 + col) * 512 + part * 256 + (t - SEQ)) = pack4(v); });
    }
  }
}

DI void phase_feat_c(KP p, int l) {
  unsigned char* ws = p->ws; asm volatile("" : "+s"(ws));
  const bf16_t* P = (const bf16_t*)(ws + WS_P);
  const bf16_t* q1r = (const bf16_t*)(ws + WS_R1 + R1_Q1R);
  const bf16_t* krw = (const bf16_t*)(ws + WS_R1 + R1_KR);
  bf16_t* QA = (bf16_t*)(ws + WS_QA); bf16_t* KA = (bf16_t*)(ws + WS_KA);
  const float* rm = (const float*)(ws + WS_ROPM);
  const int tid = otid(); const int lane = tid & 63, u = lane & 15, sub = lane >> 4;
  const int gw = blockIdx.x * (NTHR / 64) + (tid >> 6), nw = gridDim.x * (NTHR / 64);
  {
    const bf16_t* FT = (const bf16_t*)(ws + WS_FT); bf16_t* FTF = (bf16_t*)(ws + WS_FTF);
    for (int task = gw; task < NB * 256 * 4; task += nw) {
      const int row = task >> 2, k8 = (task & 3) * 512 + lane * 8;
      const bf16_t* fr = FT + (size_t)row * 4096;
      const bool cosp = k8 < 1024;
      const int f0 = cosp ? k8 : 2048 + (k8 - 1024);
      const int mi = cosp ? 2048 - k8 : 4096 - (k8 - 1024);
      const u32x4 fw = *(const u32x4*)(fr + f0), ml = *(const u32x4*)(fr + mi - 8);
      const float m0v = bflo((unsigned)fr[(mi < 4096) ? mi : 4095]);
      const float f[8] = {bflo(fw.x), bfhi(fw.x), bflo(fw.y), bfhi(fw.y), bflo(fw.z), bfhi(fw.z), bflo(fw.w), bfhi(fw.w)};
      const float mr[8] = {m0v, bfhi(ml.w), bflo(ml.w), bfhi(ml.z), bflo(ml.z), bfhi(ml.y), bflo(ml.y), bfhi(ml.x)};
      float v[8];
#pragma unroll
      for (int e = 0; e < 8; ++e) {
        const int k = k8 + e;
        if (k < 1024) v[e] = f[e] + ((k == 0) ? 0.f : mr[e]);
        else if (k == 1024) v[e] = bflo((unsigned)fr[1024]);
        else v[e] = f[e] - mr[e];
      }
      u32x4 o = {cvtpk(v[0], v[1]), cvtpk(v[2], v[3]), cvtpk(v[4], v[5]), cvtpk(v[6], v[7])};
      *(u32x4*)(FTF + (size_t)row * 2048 + k8) = o;
    }
  }
#pragma unroll 4
  for (int task = gw; task < M / 4; task += nw) {
    const int r = task * 4 + sub; const int b = r / T, t = r % T;
    const unsigned krp = *(const unsigned*)(P + (size_t)r * NIN + O_KR + 2 * u);
#pragma unroll
    for (int hh = 0; hh < 8; ++hh) {
      const bool isq = hh < 4; const int hd = hh & 3;
      f32x4 v; float ra, rb;
      if (isq) {
        v = unpack4(*(const u32x2*)(q1r + (size_t)r * 384 + 96 * hd + 4 * u));
        const unsigned rr = *(const unsigned*)(q1r + (size_t)r * 384 + 96 * hd + 64 + 2 * u); ra = bflo(rr); rb = bfhi(rr);
      } else {
        v = unpack4(*(const u32x2*)(krw + (size_t)r * 256 + 64 * hd + 4 * u));
        ra = bflo(krp); rb = bfhi(krp);
      }
      float ss = red16(v[0] * v[0] + v[1] * v[1] + v[2] * v[2] + v[3] * v[3] + ra * ra + rb * rb);
      const float rs = rsqrtf(ss * (1.f / 96.f) + 1e-6f);
      const float* gn = (isq ? p->mla_qn : p->mla_kn) + l * 96;
      f32x4 g = *(const f32x4*)(gn + 4 * u); f32x2 g2 = *(const f32x2*)(gn + 64 + 2 * u);
#pragma unroll
      for (int e = 0; e < 4; ++e) v[e] = v[e] * rs * g[e];
      ra = ra * rs * g2[0]; rb = rb * rs * g2[1];
      if (t < SEQ) rope2(ra, rb, u, t, rm);
      if (isq) {
        const float cq = 1.4426950408889634f / __builtin_sqrtf(96.f);
#pragma unroll
        for (int e = 0; e < 4; ++e) v[e] *= cq;
        ra *= cq; rb *= cq;
      }
      bf16_t* dst = (isq ? QA : KA) + (((size_t)b * 4 + hd) * T + t) * 96;
      *(u32x2*)(dst + 4 * u) = pack4(v);
      *(unsigned*)(dst + 64 + 2 * u) = cvtpk(ra, rb);
    }
  }
}

DI void phase_mix(KP p, int l, char* lds) {
  unsigned char* ws = p->ws; asm volatile("" : "+s"(ws));
  const bf16_t* P = (const bf16_t*)(ws + WS_P);
  bf16_t* Y = (bf16_t*)(ws + WS_R1);
  bf16_t* YD = (bf16_t*)(ws + WS_YD);
  const bf16_t* QA = (const bf16_t*)(ws + WS_QA); const bf16_t* KA = (const bf16_t*)(ws + WS_KA); const bf16_t* VAT = (const bf16_t*)(ws + WS_VAT);
  const bf16_t* QB = (const bf16_t*)(ws + WS_QB); const bf16_t* KB = (const bf16_t*)(ws + WS_KB); const bf16_t* VBT = (const bf16_t*)(ws + WS_VBT);
  const bf16_t* FTF = (const bf16_t*)(ws + WS_FTF); const bf16_t* FTC = (const bf16_t*)(ws + WS_FTC);
  const bf16_t* DL = (const bf16_t*)(ws + WS_DLAT); const bf16_t* DC = (const bf16_t*)(ws + WS_DCTX);
  const bf16_t* vnT = (const bf16_t*)(ws + WS_VNT);
  const bf16_t* wsb = (const bf16_t*)(ws + WS_WS) + (size_t)l * 4 * 128 * 128;
  const bool upd = (l == 0);
  const float sbA = ((const float*)(ws + WS_SBND))[l * 2], sbB = ((const float*)(ws + WS_SBND))[l * 2 + 1];
  const int xcd = blockIdx.x & 7, lb = 2 * (blockIdx.x >> 3) + __builtin_amdgcn_readfirstlane(otid() >> 8), nlb = 2 * (gridDim.x >> 3);
  const int nDL = 64, nA = 0, nB = 0, nDC = upd ? 8 : 0, nAc = 0, nBc = 0, nCM = 144, nFN = upd ? 72 : 64;
  const int e0 = nDL, e1 = e0 + nA, e2 = e1 + nB, e3 = e2 + nDC, e4 = e3 + nAc, e5 = e4 + nBc, e6 = e5 + nCM, e7 = e6 + nFN;
  unsigned* cnt = (unsigned*)(ws + WS_CNT) + l * 288;
  const bf16_t* wf = (const bf16_t*)(ws + WS_WF) + (size_t)l * 256 * 256;
  {
    const int lbw = blockIdx.x >> 3, nlbw = gridDim.x >> 3;
    const int nW = upd ? 144 : 128;
    for (int it = lbw; it < nW; it += nlbw) {
      const bool isA = (it < 64) || (it >= 128 && it < 136);
      int b, hd, q0, k0, nk;
      if (it < 128) { const int i2 = it & 63; b = 2 * xcd + (i2 >> 5); hd = (i2 >> 3) & 3; q0 = (i2 & 7) * 256; k0 = 0; nk = T; }
      else { const int i2 = (it - 128) & 7; b = 2 * xcd + (i2 >> 2); hd = i2 & 3; q0 = SEQ; k0 = SEQ; nk = CL; }
      const size_t r0 = (size_t)b * T + q0; const size_t bh = (size_t)b * 4 + hd, bk = (size_t)b * 2 + (hd >> 1);
      if (isA) {
        if (sbA <= 30.f) attn_item8<96, true>(QA + (bh * T + q0) * 96, KA + (bh * T + k0) * 96, VAT + bh * 64 * T + k0, nk, lds, P + r0 * NIN + O_GA + 64 * hd, Y + r0 * 1024 + 64 * hd, sbA);
        else attn_item8<96, false>(QA + (bh * T + q0) * 96, KA + (bh * T + k0) * 96, VAT + bh * 64 * T + k0, nk, lds, P + r0 * NIN + O_GA + 64 * hd, Y + r0 * 1024 + 64 * hd, 0.f);
      } else {
        if (sbB <= 30.f) attn_item8<64, true>(QB + (bh * T + q0) * 64, KB + (bk * T + k0) * 64, VBT + bk * 64 * T + k0, nk, lds, P + r0 * NIN + O_GB + 64 * hd, Y + r0 * 1024 + 256 + 64 * hd, sbB);
        else attn_item8<64, false>(QB + (bh * T + q0) * 64, KB + (bk * T + k0) * 64, VBT + bk * 64 * T + k0, nk, lds, P + r0 * NIN + O_GB + 64 * hd, Y + r0 * 1024 + 256 + 64 * hd, 0.f);
      }
    }
    __syncthreads();
  }
  const int tid0 = otid() & 255;
  for (int it = lb; it < e7; it += nlb) {
    if (it >= e6) {
      const int i2 = it - e6; const int mpb = upd ? 18 : 16; const int mloc = i2 >> 1, nt = i2 & 1;
      const int mt = (2 * xcd + mloc / mpb) * 18 + (mloc % mpb);
      if (tid0 == 0) {
        unsigned sp = 0;
        while (__hip_atomic_load(&cnt[mt], __ATOMIC_RELAXED, __HIP_MEMORY_SCOPE_AGENT) < 2u) { __builtin_amdgcn_s_sleep(2); if (++sp > (1u << 24)) break; }
        __builtin_amdgcn_fence(__ATOMIC_ACQUIRE, "agent");
        asm volatile("s_waitcnt vmcnt(0)" ::: "memory");
      }
      __syncthreads();
      const int m0 = mt * 128, n0 = nt * 128;
      gemm_tile(YD + (size_t)m0 * 256, 256, wf + (size_t)n0 * 256, 256, 256, lds, [&](int m, int n, f32x4 v) {
        const size_t r = (size_t)m0 + m;
        f32x4 gd = unpack4(*(const u32x2*)(P + r * NIN + O_GD + n0 + n));
        f32x4 o = {v[0] * silu(gd[0]), v[1] * silu(gd[1]), v[2] * silu(gd[2]), v[3] * silu(gd[3])};
        *(u32x2*)(Y + r * 1024 + 768 + n0 + n) = pack4(o); });
      continue;
    }
    if (it < e0 || (it >= e2 && it < e3)) {
      const bool isl = it < e0; const int i2 = isl ? it : it - e2;
      int b, mt, nt, K; const bf16_t* Ap; const bf16_t* Bp; float sc; size_t rbase;
      if (isl) { b = 2 * xcd + (i2 >> 5); mt = (i2 >> 1) & 15; nt = i2 & 1; K = 2048; Ap = DL + (size_t)mt * 128 * 2048; Bp = FTF + ((size_t)b * 256 + nt * 128) * 2048; sc = 0.00276213586f; rbase = (size_t)b * T + mt * 128; }
      else { b = 2 * xcd + (i2 >> 2); mt = (i2 >> 1) & 1; nt = i2 & 1; K = 512; Ap = DC + (size_t)mt * 128 * 512; Bp = FTC + ((size_t)b * 256 + nt * 128) * 512; sc = 0.0078125f; rbase = (size_t)b * T + SEQ + mt * 128; }
      bf16_t* yo = YD + rbase * 256 + nt * 128;
      gemm_tile(Ap, K, Bp, K, K, lds, [&](int m, int n, f32x4 v) {
        f32x4 o = {v[0] * sc, v[1] * sc, v[2] * sc, v[3] * sc};
        *(u32x2*)(yo + (size_t)m * 256 + n) = pack4(o); });
      asm volatile("s_waitcnt vmcnt(0)" ::: "memory");
      __syncthreads();
      if (tid0 == 0) {
        __builtin_amdgcn_fence(__ATOMIC_RELEASE, "agent");
        asm volatile("s_waitcnt vmcnt(0)" ::: "memory");
        __hip_atomic_fetch_add(&cnt[b * 18 + (isl ? mt : 16 + mt)], 1u, __ATOMIC_RELAXED, __HIP_MEMORY_SCOPE_AGENT);
      }
    } else {
      const int i2 = it - e5; const int bl = i2 / 72, rem = i2 % 72; const int chl = rem >> 2, g = rem & 3;
      const int ch = (2 * xcd + bl) * 18 + chl;
      if (!upd && chl >= 16) continue;
      const float* bs = p->cm_b_s + ((size_t)l * 4 + g) * 128;
      const bf16_t* Pr = P + (size_t)ch * 128 * NIN + 64 * g; bf16_t* Yr = Y + (size_t)ch * 128 * 1024 + 512 + 64 * g;
      gemm_tile(wsb + (size_t)g * 128 * 128, 128, vnT + ((size_t)ch * 256 + 64 * g) * 128, 128, 128, lds, [&](int m, int n, f32x4 v) {
        if (n < 64) {
          const float bias = bs[m];
          f32x4 uu = unpack4(*(const u32x2*)(Pr + (size_t)m * NIN + O_U + n)), gc = unpack4(*(const u32x2*)(Pr + (size_t)m * NIN + O_GC + n));
          f32x4 o;
#pragma unroll
          for (int e = 0; e < 4; ++e) o[e] = uu[e] * (v[e] + bias) * silu(gc[e]);
          *(u32x2*)(Yr + (size_t)m * 1024 + n) = pack4(o);
        } });
    }
  }
}

DI void phase_outproj(KP p, int l, char* lds) {
  unsigned char* ws = p->ws; asm volatile("" : "+s"(ws));
  const bf16_t* Y = (const bf16_t*)(ws + WS_R1);
  const bf16_t* wo = (const bf16_t*)(ws + WS_WOUT) + (size_t)l * 1024 * 1024;
  const float* mod = (const float*)(ws + WS_MOD) + (size_t)l * 17 * 3072;
  const float* xl = (l == 0) ? p->x : p->out;
  float* ctx1 = (float*)(ws + WS_CTX1);
  const int xcd = blockIdx.x & 7, lb = blockIdx.x >> 3, nlb = gridDim.x >> 3, hb = __builtin_amdgcn_readfirstlane(otid() >> 8);
  const int nsm = (l == 0) ? 16 : 0;
  for (int j = lb; j < 64; j += nlb) {
    {
      const int mi = j >> 2, nt = j & 3;
      const int bb = 2 * xcd + (mi >> 3), tt = mi & 7;
      const int m0 = (bb * 9 + tt) * 256, n0 = nt * 256;
      const float* src = xl + ((size_t)bb * SEQ + tt * 256) * 1024;
      float* dst = p->out + ((size_t)bb * SEQ + tt * 256) * 1024;
      const float* gt = mod + (size_t)bb * 3072 + 2048;
      gemm256(Y + (size_t)m0 * 1024, 1024, wo + (size_t)n0 * 1024, 1024, 1024, lds, [&](int m, int n, f32x4 v) {
        const size_t o = (size_t)m * 1024 + n0 + n;
        f32x4 xv = __builtin_nontemporal_load((const f32x4*)(src + o)), g = *(const f32x4*)(gt + n0 + n);
        f32x4 r = {xv[0] + g[0] * v[0], xv[1] + g[1] * v[1], xv[2] + g[2] * v[2], xv[3] + g[3] * v[3]};
        __builtin_nontemporal_store(r, (f32x4*)(dst + o)); });
    }
  }
  for (int j = lb; j < nsm; j += nlb) {
    {
      const int item = 2 * j + hb; const int bb = 2 * xcd + (item >> 4), m128 = (item >> 3) & 1, nt = item & 7;
      const int m0 = (bb * 18 + 16 + m128) * 128, n0 = nt * 128;
      const float* src = p->ctx + ((size_t)bb * CL + m128 * 128) * 1024;
      float* dst = ctx1 + ((size_t)bb * CL + m128 * 128) * 1024;
      const float* gt = mod + (size_t)16 * 3072 + 2048;
      gemm_tile(Y + (size_t)m0 * 1024, 1024, wo + (size_t)n0 * 1024, 1024, 1024, lds, [&](int m, int n, f32x4 v) {
        const size_t o = (size_t)m * 1024 + n0 + n;
        f32x4 xv = *(const f32x4*)(src + o), g = *(const f32x4*)(gt + n0 + n);
        f32x4 r = {xv[0] + g[0] * v[0], xv[1] + g[1] * v[1], xv[2] + g[2] * v[2], xv[3] + g[3] * v[3]};
        *(f32x4*)(dst + o) = r; });
    }
  }
}

__global__ void __launch_bounds__(NTHR, 2) fwd_megakernel(Params p_byval) {
  KP p = (KP)__builtin_amdgcn_kernarg_segment_ptr();
  extern __shared__ __attribute__((aligned(16))) char lds[];
  cg::grid_group grid = cg::this_grid();
  uint4* xbw = (uint4*)(lds + LDS_MAIN);
  if (threadIdx.x == 0) *xbw = make_uint4(0u, 0u, 0u, 0u);
  __syncthreads();
  XcdBarrier xb = xcd_barrier_post((unsigned*)(p->ws + WS_BAR), (volatile LAS unsigned*)xbw);
  if (p->ph_hi < p->ph_lo) grid.sync();
  (void)p_byval;
  for (int ph = p->ph_lo; ph < p->ph_hi; ++ph) {
    asm volatile("" : "+s"(p));
    if (ph == 0) phase0(p, lds);
    else {
      const int l = (ph - 1) / 7, s = (ph - 1) % 7;
      switch (s) {
        case 0: phase_norm(p, l); break;
        case 1: phase_inproj(p, l, lds); break;
        case 2: phase_feat_a(p, l, lds); break;
        case 3: phase_feat_b(p, l, lds); break;
        case 4: phase_feat_c(p, l); break;
        case 5: phase_mix(p, l, lds); break;
        default: phase_outproj(p, l, lds); break;
      }
    }
    if (ph + 1 < p->ph_hi) xcd_barrier(xb);
  }
}

extern "C" void kernel_launch(void* const* d_in, const int* in_sizes, int n_in, void* d_out, int out_size, void* d_ws, size_t ws_size, hipStream_t stream) {
  static int grid_blocks = 0;
  if (!grid_blocks) {
    int dev = 0, cus = 0, per_cu = 0;
    hipGetDevice(&dev);
    hipDeviceGetAttribute(&cus, hipDeviceAttributeMultiprocessorCount, dev);
    hipFuncSetAttribute((const void*)fwd_megakernel, hipFuncAttributeMaxDynamicSharedMemorySize, LDS_BYTES);
    hipOccupancyMaxActiveBlocksPerMultiprocessor(&per_cu, fwd_megakernel, NTHR, LDS_BYTES);
    if (per_cu > 1) per_cu = 1;
    if (per_cu < 1) per_cu = 1;
    grid_blocks = cus * per_cu;
    if (ws_size < WS_END) fprintf(stderr, "kernel_launch: workspace too small: %zu < %zu\n", ws_size, (size_t)WS_END);
  }
  hipMemsetAsync((unsigned char*)d_ws + WS_BAR, 0, WS_ZERO_BYTES, stream);
  Params p{};
  const float** pp = (const float**)&p;
  for (int i = 0; i < 22; ++i) pp[i] = (const float*)d_in[i];
  p.out = (float*)d_out; p.ws = (unsigned char*)d_ws;
  constexpr int NPH = 15;
#if PER_PHASE_LAUNCH
  for (int ph = 0; ph < NPH; ++ph) {
    p.ph_lo = ph; p.ph_hi = ph + 1;
    hipLaunchKernelGGL(fwd_megakernel, dim3(grid_blocks), dim3(NTHR), LDS_BYTES, stream, p);
  }
#else
  p.ph_lo = 0; p.ph_hi = NPH;
  void* args[] = {&p};
  hipError_t e = hipLaunchCooperativeKernel((void*)fwd_megakernel, dim3(grid_blocks), dim3(NTHR), args, LDS_BYTES, stream);
  if (e != hipSuccess) fprintf(stderr, "cooperative launch failed: %s (grid %d)\n", hipGetErrorString(e), grid_blocks);
#endif
}
```

```cpp
#include <hip/hip_runtime.h>
#include <hip/hip_cooperative_groups.h>
#include <stdint.h>
#include <stdio.h>
namespace cg = cooperative_groups;

#ifndef PER_PHASE_LAUNCH
#define PER_PHASE_LAUNCH 0
#endif

#define DI __device__ __forceinline__
DI int otid() { int t = threadIdx.x; asm volatile("" : "+v"(t)); return t; }
typedef unsigned short bf16_t;
using bf16x8 = __attribute__((ext_vector_type(8))) short;
using f32x16 = __attribute__((ext_vector_type(16))) float;
using f32x4  = __attribute__((ext_vector_type(4))) float;
using f32x2  = __attribute__((ext_vector_type(2))) float;
using u32x4  = __attribute__((ext_vector_type(4))) unsigned;
using u32x2  = __attribute__((ext_vector_type(2))) unsigned;
typedef __bf16 bf16x2_t __attribute__((ext_vector_type(2)));

constexpr int NB = 16, SEQ = 2048, CL = 256, T = 2304, D = 1024, M = NB * T, NIN = 2656, NINP = 2816;
constexpr int O_CQ = 0, O_CKV = 192, O_KR = 320, O_GA = 352, O_Q2 = 608, O_K2 = 864, O_V2 = 992, O_GB = 1120,
              O_U = 1376, O_V = 1632, O_GC = 1888, O_F = 2144, O_GD = 2400;
constexpr int NTHR = 512;
constexpr int HALF_LDS = 69632, LDS_MAIN = 2 * HALF_LDS, LDS_BYTES = LDS_MAIN + 256;

constexpr size_t al256(size_t x) { return (x + 255) & ~(size_t)255; }
constexpr size_t WS_MOD  = 0;
constexpr size_t WS_ROPG = al256(WS_MOD + 2 * 17 * 3072 * 4);
constexpr size_t WS_ROPM = al256(WS_ROPG + 64 * 16 * 2 * 4);
constexpr size_t WS_SBND = al256(WS_ROPM + 64 * 8 * 2 * 4);
constexpr size_t WS_WIN  = al256(WS_SBND + 256);
constexpr size_t WS_WUQ  = al256(WS_WIN + (size_t)2 * NINP * 1024 * 2);
constexpr size_t WS_WUKV = al256(WS_WUQ + 2 * 384 * 192 * 2);
constexpr size_t WS_WF   = al256(WS_WUKV + 2 * 512 * 128 * 2);
constexpr size_t WS_WOUT = al256(WS_WF + 2 * 256 * 256 * 2);
constexpr size_t WS_WS   = al256(WS_WOUT + (size_t)2 * 1024 * 1024 * 2);
constexpr size_t WS_CM   = al256(WS_WS + 2 * 4 * 128 * 128 * 2);
constexpr size_t WS_DLAT = al256(WS_CM + 128 * 64 * 2);
constexpr size_t WS_DCTX = al256(WS_DLAT + (size_t)2048 * 2048 * 2);
constexpr size_t WS_R1   = al256(WS_DCTX + 256 * 512 * 2);
constexpr size_t R1_CQN = 0, R1_CKVN = (size_t)M * 192 * 2, R1_Q1R = R1_CKVN + (size_t)M * 128 * 2, R1_KR = R1_Q1R + (size_t)M * 384 * 2;
constexpr size_t WS_P    = al256(WS_R1 + (size_t)M * 1024 * 2);
constexpr size_t WS_FT   = al256(WS_P + (size_t)M * NIN * 2);
constexpr size_t WS_FTF  = al256(WS_FT + (size_t)NB * 256 * 4096 * 2);
constexpr size_t WS_FTC  = al256(WS_FTF + (size_t)NB * 256 * 2048 * 2);
constexpr size_t WS_YD   = al256(WS_FTC + (size_t)NB * 256 * 512 * 2);
constexpr size_t WS_QA   = al256(WS_YD + (size_t)M * 256 * 2);
constexpr size_t WS_KA   = al256(WS_QA + (size_t)M * 384 * 2);
constexpr size_t WS_VAT  = al256(WS_KA + (size_t)M * 384 * 2);
constexpr size_t WS_QB   = al256(WS_VAT + (size_t)M * 256 * 2);
constexpr size_t WS_KB   = al256(WS_QB + (size_t)M * 256 * 2);
constexpr size_t WS_VBT  = al256(WS_KB + (size_t)M * 128 * 2);
constexpr size_t WS_VNT  = al256(WS_VBT + (size_t)M * 128 * 2);
constexpr size_t WS_CTX1 = al256(WS_VNT + (size_t)M * 256 * 2 + 65536);
constexpr size_t WS_BAR  = al256(WS_CTX1 + (size_t)NB * CL * 1024 * 4);
constexpr size_t WS_CNT  = al256(WS_BAR + 3456 * 4);
constexpr size_t WS_END  = al256(WS_CNT + 2 * 288 * 4);
constexpr size_t WS_ZERO_BYTES = WS_END - WS_BAR;
static_assert(R1_KR + (size_t)M * 256 * 2 <= (size_t)M * 1024 * 2, "temp region");
static_assert(WS_END <= (size_t)512 * 1024 * 1024, "workspace");

struct Params {
  const float *x, *c, *ctx, *c_ctx, *norm_g, *w_mod, *b_mod, *w_in, *mla_q_norm, *mla_w_uq, *mla_kv_norm, *mla_w_ukv,
              *mla_qn, *mla_kn, *gqa_qn, *gqa_kn, *cm_ln_g, *cm_ln_b, *cm_w_s, *cm_b_s, *fnet_w, *w_out;
  float* out; unsigned char* ws; int ph_lo, ph_hi;
};
typedef const __attribute__((address_space(4))) Params* KP;

DI unsigned cvtpk(float lo, float hi) { f32x2 v = {lo, hi}; bf16x2_t b = __builtin_convertvector(v, bf16x2_t); return __builtin_bit_cast(unsigned, b); }
DI float bflo(unsigned u) { return __uint_as_float(u << 16); }
DI float bfhi(unsigned u) { return __uint_as_float(u & 0xffff0000u); }
DI bf16_t f2bf(float f) { return (bf16_t)(cvtpk(f, 0.f) & 0xffffu); }
DI float silu(float x) { return x / (1.f + __expf(-x)); }
DI f32x4 unpack4(u32x2 v) { f32x4 r = {bflo(v.x), bfhi(v.x), bflo(v.y), bfhi(v.y)}; return r; }
DI u32x2 pack4(f32x4 v) { u32x2 r = {cvtpk(v[0], v[1]), cvtpk(v[2], v[3])}; return r; }
DI float dpp_f(float v, const int ctrl_sel) {
  const int i = __float_as_int(v); int r;
  if (ctrl_sel == 0) r = __builtin_amdgcn_update_dpp(0, i, 0xB1, 0xF, 0xF, true);
  else if (ctrl_sel == 1) r = __builtin_amdgcn_update_dpp(0, i, 0x4E, 0xF, 0xF, true);
  else if (ctrl_sel == 2) r = __builtin_amdgcn_update_dpp(0, i, 0x124, 0xF, 0xF, true);
  else r = __builtin_amdgcn_update_dpp(0, i, 0x128, 0xF, 0xF, true);
  return __int_as_float(r);
}
DI float red16(float v) { v += dpp_f(v, 0); v += dpp_f(v, 1); v += dpp_f(v, 2); v += dpp_f(v, 3); return v; }
DI float red64(float v) { v = red16(v); v += __shfl_xor(v, 16); v += __shfl_xor(v, 32); return v; }
#define MFMA32(a, b, c) __builtin_amdgcn_mfma_f32_32x32x16_bf16((a), (b), (c), 0, 0, 0)


#define XB_TMO      128
#define XB_XCNT(j)  (256  + 64 * (j))
#define XB_XSUB(j)  (1280 + 64 * (j))
#define XB_XGEN(j)  (2304 + 64 * (j))
#define XB_TOP      3328
#define XB_TOPGEN   3392
#define XCD_BAR_WORDS 3456
#define XB_SPIN_CAP (1u << 22)
#define LAS __attribute__((address_space(3)))
DI unsigned xb_ld(unsigned* p)              { return __hip_atomic_load(p, __ATOMIC_RELAXED, __HIP_MEMORY_SCOPE_AGENT); }
DI unsigned xb_add(unsigned* p, unsigned v) { return __hip_atomic_fetch_add(p, v, __ATOMIC_RELAXED, __HIP_MEMORY_SCOPE_AGENT); }
DI unsigned xb_xcc_id() { return (unsigned)__builtin_amdgcn_s_getreg((3 << 11) | 20) & 0xFu; }
#define XB_SPIN(cond, bar) do { unsigned _sp = 0; while (cond) { __builtin_amdgcn_s_sleep(1); \
    if ((++_sp & 255u) == 0u) { if (xb_ld(&(bar)[XB_TMO])) break; if (_sp > XB_SPIN_CAP) { atomicAdd(&(bar)[XB_TMO], 1u); break; } } } } while (0)
struct XcdBarrier { unsigned* bar; unsigned x; volatile LAS unsigned* st; };
DI XcdBarrier xcd_barrier_post(unsigned* bar, volatile LAS unsigned* st) {
  XcdBarrier b; b.bar = bar; b.x = xb_xcc_id(); b.st = st;
  if (threadIdx.x == 0) (void)xb_add(&bar[XB_XCNT(b.x)], 1u);
  return b;
}
DI void xcd_barrier_complete(unsigned* bar, unsigned x, unsigned& nloc, unsigned& nx) {
  const unsigned G = gridDim.x * gridDim.y * gridDim.z;
  unsigned sum, cnt, mine, sp = 0u;
  for (;;) {
    sum = 0u; cnt = 0u; mine = 0u;
#pragma unroll
    for (unsigned j = 0; j < 16; ++j) { const unsigned c = xb_ld(&bar[XB_XCNT(j)]); sum += c; cnt += (c > 0u) ? 1u : 0u; mine = (j == x) ? c : mine; }
    if (sum == G) break;
    __builtin_amdgcn_s_sleep(1);
    if ((++sp & 255u) == 0u) { if (xb_ld(&bar[XB_TMO])) break; if (sp > XB_SPIN_CAP) { atomicAdd(&bar[XB_TMO], 1u); break; } }
  }
  nloc = mine > 0u ? mine : 1u; nx = cnt > 0u ? cnt : 1u;
}
DI void xcd_barrier(const XcdBarrier& b) {
  asm volatile("s_waitcnt vmcnt(0)" ::: "memory");
  __syncthreads();
  if (threadIdx.x == 0) {
    unsigned* bar = b.bar;
    __builtin_amdgcn_s_waitcnt(0);
    unsigned nloc = b.st[0], nx = b.st[1];
    if (nloc == 0u) { xcd_barrier_complete(bar, b.x, nloc, nx); b.st[0] = nloc; b.st[1] = nx; }
    const unsigned old = xb_add(&bar[XB_XSUB(b.x)], 1u);
    const unsigned gen = old / nloc;
    if (old + 1u == (gen + 1u) * nloc) {
      __builtin_amdgcn_fence(__ATOMIC_RELEASE, "agent");
      asm volatile("s_waitcnt vmcnt(0)" ::: "memory");
      const unsigned og = xb_add(&bar[XB_TOP], 1u);
      const unsigned tg = og / nx;
      if (og + 1u == (tg + 1u) * nx) xb_add(&bar[XB_TOPGEN], 1u);
      else XB_SPIN(xb_ld(&bar[XB_TOPGEN]) == tg, bar);
      __builtin_amdgcn_fence(__ATOMIC_ACQUIRE, "agent");
      xb_add(&bar[XB_XGEN(b.x)], 1u);
      asm volatile("s_waitcnt vmcnt(0)" ::: "memory");
    } else {
      XB_SPIN(xb_ld(&bar[XB_XGEN(b.x)]) == gen, bar);
      __builtin_amdgcn_fence(__ATOMIC_ACQUIRE, "agent");
      asm volatile("s_waitcnt vmcnt(0)" ::: "memory");
    }
  }
  __syncthreads();
}

template <class Epi>
DI void gemm_tile(const bf16_t* __restrict__ A, int lda, const bf16_t* __restrict__ Bt, int ldb, int K, char* lds, Epi epi) {
  const int tid_full = otid(); const int tid = tid_full & 255; lds += (tid_full >> 8) * HALF_LDS;
  const int lane = tid & 63, w = tid >> 6, l31 = lane & 31, h = lane >> 5;
  const int wr = w >> 1, wc = w & 1;
  const int lrow = tid >> 3, lch = (tid & 7) ^ ((tid >> 4) & 7);
  const bf16_t* ag = A + (size_t)lrow * lda + lch * 8;
  const bf16_t* bg = Bt + (size_t)lrow * ldb + lch * 8;
  const size_t a32 = (size_t)32 * lda, b32 = (size_t)32 * ldb;
  f32x16 acc[2][2];
#pragma unroll
  for (int i = 0; i < 2; ++i)
#pragma unroll
    for (int j = 0; j < 2; ++j)
#pragma unroll
      for (int e = 0; e < 16; ++e) acc[i][j][e] = 0.f;
  const int nk = K >> 6;
  const int rsw = (l31 >> 1) & 7;
  const int aoff = (wr * 64 + l31) * 128, boff = 16384 + (wc * 64 + l31) * 128;
  char* ldst = lds + tid * 16;
#define G_DMA(BUF, KT) { const int ko_ = (KT) * 64; char* nb_ = ldst + (BUF) * 32768; _Pragma("unroll") for (int i = 0; i < 4; ++i) { \
    __builtin_amdgcn_global_load_lds((const unsigned*)(ag + i * a32 + ko_), (__attribute__((address_space(3))) unsigned*)(nb_ + i * 4096), 16, 0, 0); \
    __builtin_amdgcn_global_load_lds((const unsigned*)(bg + i * b32 + ko_), (__attribute__((address_space(3))) unsigned*)(nb_ + 16384 + i * 4096), 16, 0, 0); } }
#define G_COMPUTE(BUF) { const char* cur = lds + (BUF) * 32768; bf16x8 af[2][2], bf[2][2]; \
    { const int off = ((0 + h) ^ rsw) << 4; _Pragma("unroll") for (int i = 0; i < 2; ++i) { af[0][i] = *(const bf16x8*)(cur + aoff + i * 4096 + off); bf[0][i] = *(const bf16x8*)(cur + boff + i * 4096 + off); } } \
    _Pragma("unroll") for (int ks = 0; ks < 4; ++ks) { \
      if (ks < 3) { const int off = ((2 * (ks + 1) + h) ^ rsw) << 4; _Pragma("unroll") for (int i = 0; i < 2; ++i) { af[(ks + 1) & 1][i] = *(const bf16x8*)(cur + aoff + i * 4096 + off); bf[(ks + 1) & 1][i] = *(const bf16x8*)(cur + boff + i * 4096 + off); } } \
      _Pragma("unroll") for (int i = 0; i < 2; ++i) _Pragma("unroll") for (int j = 0; j < 2; ++j) acc[i][j] = MFMA32(bf[ks & 1][j], af[ks & 1][i], acc[i][j]); } }
#define G_WAIT() { asm volatile("s_waitcnt vmcnt(0)" ::: "memory"); __syncthreads(); }
  G_DMA(0, 0);
  G_WAIT();
  for (int kt = 0; kt < nk; kt += 2) {
    if (kt + 1 < nk) G_DMA(1, kt + 1);
    G_COMPUTE(0);
    G_WAIT();
    if (kt + 1 < nk) {
      if (kt + 2 < nk) G_DMA(0, kt + 2);
      G_COMPUTE(1);
      G_WAIT();
    }
  }
#undef G_DMA
#undef G_COMPUTE
#undef G_WAIT
  float* ct = (float*)lds;
#pragma unroll
  for (int i = 0; i < 2; ++i)
#pragma unroll
    for (int j = 0; j < 2; ++j)
#pragma unroll
      for (int q = 0; q < 4; ++q) {
        f32x4 v = {acc[i][j][4 * q], acc[i][j][4 * q + 1], acc[i][j][4 * q + 2], acc[i][j][4 * q + 3]};
        *(f32x4*)(ct + (wr * 64 + i * 32 + l31) * 132 + wc * 64 + j * 32 + 8 * q + 4 * h) = v;
      }
  __syncthreads();
#pragma unroll 4
  for (int it = 0; it < 16; ++it) {
    const int idx = it * 256 + tid; const int row = idx >> 5, c4 = (idx & 31) * 4;
    f32x4 v = *(const f32x4*)(ct + row * 132 + c4);
    epi(row, c4, v);
  }
  __syncthreads();
}


DI int g8_lds_byte(int r, int c) { int st = (r >> 4) * 2 + (c >> 5), rr = r & 15, cc = c & 31, ob = rr * 64 + cc * 2; return st * 1024 + (ob ^ (((ob >> 9) & 1) << 5)); }
DI void g8_stage_rc(int b, int& R, int& C) { int st = b / 1024, sb = b % 1024, swz = sb ^ (((sb >> 9) & 1) << 5); R = (st >> 1) * 16 + swz / 64; C = (st & 1) * 32 + (swz % 64) / 2; }
template <class Epi>
DI void gemm256(const bf16_t* __restrict__ A, int lda, const bf16_t* __restrict__ Bt, int ldb, int K, char* lds, Epi epi) {
  constexpr int BK = 64, HALFR = 128, HTB = HALFR * BK * 2;
  const int tid = otid();
  const int wid = tid >> 6, lane = tid & 63, wr = wid >> 2, wc = wid & 3, fr = lane & 15, fq = lane >> 4;
  const int obs = (fr * 64 + fq * 16) ^ ((((fr * 64 + fq * 16) >> 9) & 1) << 5);
  const char* lrda = lds + wr * 8192 + obs; const char* lrdb = lds + 4 * HTB + wc * 4096 + obs;
  int sr0, sc0, sr1, sc1; g8_stage_rc(tid * 16, sr0, sc0); g8_stage_rc(tid * 16 + 8192, sr1, sc1);
  const unsigned oa0 = (unsigned)(sr0 * lda + sc0) * 2u, oa1 = (unsigned)(sr1 * lda + sc1) * 2u;
#define ob0 oa0
#define ob1 oa1
#define SA8(b, h) (lds + ((b) * 2 + (h)) * HTB)
#define SB8(b, h) (lds + (4 + (b) * 2 + (h)) * HTB)
#define STAGE_A(Pp, br, kt) { const char* g_ = (const char*)(A + (size_t)(br) * lda + (size_t)(kt) * BK); \
    __builtin_amdgcn_global_load_lds((const unsigned*)(g_ + oa0), (LAS unsigned*)((Pp) + tid * 16), 16, 0, 0); \
    __builtin_amdgcn_global_load_lds((const unsigned*)(g_ + oa1), (LAS unsigned*)((Pp) + tid * 16 + 8192), 16, 0, 0); }
#define STAGE_B(Pp, br, kt) { const char* g_ = (const char*)(Bt + (size_t)(br) * ldb + (size_t)(kt) * BK); \
    __builtin_amdgcn_global_load_lds((const unsigned*)(g_ + ob0), (LAS unsigned*)((Pp) + tid * 16), 16, 0, 0); \
    __builtin_amdgcn_global_load_lds((const unsigned*)(g_ + ob1), (LAS unsigned*)((Pp) + tid * 16 + 8192), 16, 0, 0); }
#define LDA8(dst, b, h) _Pragma("unroll") for (int m = 0; m < 4; ++m) _Pragma("unroll") for (int k = 0; k < 2; ++k) \
    dst[m][k] = *(const bf16x8*)(lrda + ((b) * 2 + (h)) * HTB + (2 * m + k) * 1024)
#define LDB8(dst, b, h) _Pragma("unroll") for (int n = 0; n < 2; ++n) _Pragma("unroll") for (int k = 0; k < 2; ++k) \
    dst[n][k] = *(const bf16x8*)(lrdb + ((b) * 2 + (h)) * HTB + (2 * n + k) * 1024)
#define MMA8(ai, bj, AT, BT) { __builtin_amdgcn_s_setprio(1); \
    _Pragma("unroll") for (int m = 0; m < 4; ++m) _Pragma("unroll") for (int n = 0; n < 2; ++n) _Pragma("unroll") for (int k = 0; k < 2; ++k) \
      acc[ai][bj][m][n] = __builtin_amdgcn_mfma_f32_16x16x32_bf16(AT[m][k], BT[n][k], acc[ai][bj][m][n], 0, 0, 0); \
    __builtin_amdgcn_s_setprio(0); }
#define WAIT_V(n) asm volatile("s_waitcnt vmcnt(" #n ")" ::: "memory")
#define WAIT_L(n) asm volatile("s_waitcnt lgkmcnt(" #n ")" ::: "memory")
#define BAR8 __builtin_amdgcn_s_barrier()
#define SCHED8 __builtin_amdgcn_sched_barrier(0)
  f32x4 acc[2][2][4][2];
#pragma unroll
  for (int a = 0; a < 2; ++a)
#pragma unroll
    for (int b = 0; b < 2; ++b)
#pragma unroll
      for (int m = 0; m < 4; ++m)
#pragma unroll
        for (int n = 0; n < 2; ++n) { f32x4 z = {0.f, 0.f, 0.f, 0.f}; acc[a][b][m][n] = z; }
  bf16x8 At[4][2], B0[2][2], B1[2][2];
  const int nt = K / BK;
  WAIT_V(0);
  __syncthreads();
  STAGE_B(SB8(0, 0), 0, 0); STAGE_A(SA8(0, 0), 0, 0);
  STAGE_B(SB8(0, 1), HALFR, 0); STAGE_A(SA8(0, 1), HALFR, 0);
  if (wr == 1) BAR8;
  WAIT_V(4); BAR8;
  STAGE_B(SB8(1, 0), 0, 1); STAGE_A(SA8(1, 0), 0, 1); STAGE_B(SB8(1, 1), HALFR, 1);
  WAIT_V(6); BAR8;
  for (int t = 0; t < nt - 2; t += 2) {
    LDB8(B0, 0, 0); SCHED8; LDA8(At, 0, 0); STAGE_A(SA8(1, 1), HALFR, t + 1);
    WAIT_L(8); BAR8; WAIT_L(0); MMA8(0, 0, At, B0); BAR8; SCHED8;
    LDB8(B1, 0, 1); STAGE_B(SB8(0, 0), 0, t + 2);
    BAR8; WAIT_L(0); MMA8(0, 1, At, B1); BAR8;
    LDA8(At, 0, 1); STAGE_A(SA8(0, 0), 0, t + 2);
    BAR8; WAIT_L(0); MMA8(1, 0, At, B0); BAR8; SCHED8;
    STAGE_B(SB8(0, 1), HALFR, t + 2);
    WAIT_V(6); BAR8; MMA8(1, 1, At, B1); BAR8;
    LDB8(B0, 1, 0); SCHED8; LDA8(At, 1, 0); STAGE_A(SA8(0, 1), HALFR, t + 2);
    WAIT_L(8); BAR8; WAIT_L(0); MMA8(0, 0, At, B0); BAR8; SCHED8;
    LDB8(B1, 1, 1); STAGE_B(SB8(1, 0), 0, t + 3);
    BAR8; WAIT_L(0); MMA8(0, 1, At, B1); BAR8;
    LDA8(At, 1, 1); STAGE_A(SA8(1, 0), 0, t + 3);
    BAR8; WAIT_L(0); MMA8(1, 0, At, B0); BAR8; SCHED8;
    STAGE_B(SB8(1, 1), HALFR, t + 3);
    WAIT_V(6); BAR8; MMA8(1, 1, At, B1); BAR8;
  }
  { LDB8(B0, 0, 0); LDA8(At, 0, 0); STAGE_A(SA8(1, 1), HALFR, nt - 1);
    BAR8; WAIT_L(0); MMA8(0, 0, At, B0); BAR8;
    LDB8(B1, 0, 1); BAR8; WAIT_L(0); MMA8(0, 1, At, B1); BAR8;
    LDA8(At, 0, 1); WAIT_V(4); BAR8; WAIT_L(0); MMA8(1, 0, At, B0); MMA8(1, 1, At, B1); BAR8; }
  { LDB8(B0, 1, 0); LDA8(At, 1, 0); WAIT_V(2); BAR8; WAIT_L(0); MMA8(0, 0, At, B0); BAR8;
    LDB8(B1, 1, 1); WAIT_V(0); BAR8; WAIT_L(0); MMA8(0, 1, At, B1); BAR8;
    LDA8(At, 1, 1); BAR8; WAIT_L(0); MMA8(1, 0, At, B0); MMA8(1, 1, At, B1); BAR8; }
  if (wr == 0) BAR8;
  float* ct = (float*)lds;
#pragma unroll
  for (int ai = 0; ai < 2; ++ai) {
    __syncthreads();
#pragma unroll
    for (int bj = 0; bj < 2; ++bj)
#pragma unroll
      for (int m = 0; m < 4; ++m)
#pragma unroll
        for (int n = 0; n < 2; ++n)
#pragma unroll
          for (int j = 0; j < 4; ++j) ct[(wr * 64 + m * 16 + fq * 4 + j) * 260 + bj * 128 + wc * 32 + n * 16 + fr] = acc[ai][bj][m][n][j];
    __syncthreads();
#pragma unroll 2
    for (int it = 0; it < 16; ++it) {
      const int idx = it * NTHR + tid; const int row = idx >> 6, c4 = (idx & 63) * 4;
      f32x4 v = *(const f32x4*)(ct + row * 260 + c4);
      epi(ai * 128 + row, c4, v);
    }
  }
  __syncthreads();
#undef ob0
#undef ob1
#undef SA8
#undef SB8
#undef STAGE_A
#undef STAGE_B
#undef LDA8
#undef LDB8
#undef MMA8
#undef WAIT_V
#undef WAIT_L
#undef BAR8
#undef SCHED8
}

template <int DQK, bool STATIC>
DI void attn_item(const bf16_t* __restrict__ Q, const bf16_t* __restrict__ Kp, const bf16_t* __restrict__ Vt, int nkeys, char* lds,
                  const bf16_t* __restrict__ Pg, bf16_t* __restrict__ Yg  , float mfix) {
  constexpr int KSTR = DQK * 2 + 16, VSTR = 136, KCH = DQK / 8, NKC = (64 * KCH) / 256, NQS = DQK / 16;
  constexpr int KBUF = 64 * KSTR, BUF = KBUF + 64 * VSTR;
  const int tid_full = otid(); const int tid = tid_full & 255; lds += (tid_full >> 8) * HALF_LDS;
  const int lane = tid & 63, w = tid >> 6, l31 = lane & 31, h = lane >> 5;
  bf16x8 qf[NQS];
#pragma unroll
  for (int ks = 0; ks < NQS; ++ks) qf[ks] = *(const bf16x8*)(Q + (size_t)(32 * w + l31) * DQK + 16 * ks + 8 * h);
  f32x16 o[2];
#pragma unroll
  for (int d = 0; d < 2; ++d)
#pragma unroll
    for (int e = 0; e < 16; ++e) o[d][e] = 0.f;
  float m_run = STATIC ? mfix : -1e30f, l_run = 0.f;
  u32x4 rk[NKC], rv[2];
  int koffg[NKC], koffl[NKC];
#pragma unroll
  for (int i = 0; i < NKC; ++i) { const int c = tid + 256 * i; const int key = c / KCH, part = c % KCH; koffg[i] = c * 8; koffl[i] = key * KSTR + part * 16; }
  const int vdv0 = tid >> 3, vpart = tid & 7;
  const bf16_t* vg = Vt + (size_t)vdv0 * T + vpart * 8;
  const int voffl = KBUF + vdv0 * VSTR + vpart * 16;
  const int nt = nkeys >> 6;
#pragma unroll
  for (int i = 0; i < NKC; ++i) rk[i] = *(const u32x4*)(Kp + koffg[i]);
#pragma unroll
  for (int i = 0; i < 2; ++i) rv[i] = *(const u32x4*)(vg + (size_t)i * 32 * T);
#pragma unroll
  for (int i = 0; i < NKC; ++i) *(u32x4*)(lds + koffl[i]) = rk[i];
#pragma unroll
  for (int i = 0; i < 2; ++i) { u32x2 a = {rv[i].x, rv[i].y}, b = {rv[i].z, rv[i].w}; *(u32x2*)(lds + voffl + i * 32 * VSTR) = a; *(u32x2*)(lds + voffl + i * 32 * VSTR + 8) = b; }
  __syncthreads();
  for (int j = 0; j < nt; ++j) {
    char* cur = lds + (j & 1) * BUF;
    const bool more = (j + 1 < nt);
    if (more) {
#pragma unroll
      for (int i = 0; i < NKC; ++i) rk[i] = *(const u32x4*)(Kp + (size_t)(j + 1) * 64 * DQK + koffg[i]);
#pragma unroll
      for (int i = 0; i < 2; ++i) rv[i] = *(const u32x4*)(vg + (size_t)i * 32 * T + (j + 1) * 64);
    }
    f32x16 s0, s1;
    bf16x8 kf[2][NQS];
#pragma unroll
    for (int kb = 0; kb < 2; ++kb)
#pragma unroll
      for (int ks = 0; ks < NQS; ++ks) kf[kb][ks] = *(const bf16x8*)(cur + (32 * kb + l31) * KSTR + (2 * ks + h) * 16);
    u32x4 vw[2][2][2];
#pragma unroll
    for (int kb = 0; kb < 2; ++kb)
#pragma unroll
      for (int s2 = 0; s2 < 2; ++s2)
#pragma unroll
        for (int d = 0; d < 2; ++d) {
          const char* vp = cur + KBUF + (32 * d + l31) * VSTR + (32 * kb + 16 * s2 + 4 * h) * 2;
          u32x2 v0 = *(const u32x2*)vp, v1 = *(const u32x2*)(vp + 16);
          u32x4 t4 = {v0.x, v0.y, v1.x, v1.y}; vw[kb][s2][d] = t4;
        }
#pragma unroll
    for (int e = 0; e < 16; ++e) { s0[e] = STATIC ? -mfix : 0.f; s1[e] = STATIC ? -mfix : 0.f; }
#pragma unroll
    for (int ks = 0; ks < NQS; ++ks) s0 = MFMA32(kf[0][ks], qf[ks], s0);
    if (!STATIC) {
      float mx = s0[0];
#pragma unroll
      for (int e = 1; e < 16; ++e) mx = fmaxf(mx, s0[e]);
      mx = fmaxf(mx, __shfl_xor(mx, 32));
      if (!__all(mx <= m_run + 8.f)) {
        const float m_new = fmaxf(m_run, mx);
        const float alpha = __builtin_amdgcn_exp2f(m_run - m_new);
        m_run = m_new; l_run *= alpha;
#pragma unroll
        for (int d = 0; d < 2; ++d)
#pragma unroll
          for (int e = 0; e < 16; ++e) o[d][e] *= alpha;
      }
    }
#pragma unroll
    for (int ks = 0; ks < NQS; ++ks) s1 = MFMA32(kf[1][ks], qf[ks], s1);
    {
      float ps = 0.f;
#pragma unroll
      for (int e = 0; e < 16; ++e) { float p = STATIC ? __builtin_amdgcn_exp2f(s0[e]) : __builtin_amdgcn_exp2f(s0[e] - m_run); s0[e] = p; ps += p; }
      l_run += ps;
    }
    if (!STATIC) {
      float mx = s1[0];
#pragma unroll
      for (int e = 1; e < 16; ++e) mx = fmaxf(mx, s1[e]);
      mx = fmaxf(mx, __shfl_xor(mx, 32));
      if (!__all(mx <= m_run + 8.f)) {
        const float m_new = fmaxf(m_run, mx);
        const float alpha = __builtin_amdgcn_exp2f(m_run - m_new);
        m_run = m_new; l_run *= alpha;
#pragma unroll
        for (int e = 0; e < 16; ++e) s0[e] *= alpha;
#pragma unroll
        for (int d = 0; d < 2; ++d)
#pragma unroll
          for (int e = 0; e < 16; ++e) o[d][e] *= alpha;
      }
    }
#pragma unroll
    for (int s2 = 0; s2 < 2; ++s2) {
      u32x4 pw = {cvtpk(s0[8 * s2], s0[8 * s2 + 1]), cvtpk(s0[8 * s2 + 2], s0[8 * s2 + 3]), cvtpk(s0[8 * s2 + 4], s0[8 * s2 + 5]), cvtpk(s0[8 * s2 + 6], s0[8 * s2 + 7])};
      bf16x8 pf = __builtin_bit_cast(bf16x8, pw);
#pragma unroll
      for (int d = 0; d < 2; ++d) o[d] = MFMA32(__builtin_bit_cast(bf16x8, vw[0][s2][d]), pf, o[d]);
    }
    {
      float ps = 0.f;
#pragma unroll
      for (int e = 0; e < 16; ++e) { float p = STATIC ? __builtin_amdgcn_exp2f(s1[e]) : __builtin_amdgcn_exp2f(s1[e] - m_run); s1[e] = p; ps += p; }
      l_run += ps;
    }
#pragma unroll
    for (int s2 = 0; s2 < 2; ++s2) {
      u32x4 pw = {cvtpk(s1[8 * s2], s1[8 * s2 + 1]), cvtpk(s1[8 * s2 + 2], s1[8 * s2 + 3]), cvtpk(s1[8 * s2 + 4], s1[8 * s2 + 5]), cvtpk(s1[8 * s2 + 6], s1[8 * s2 + 7])};
      bf16x8 pf = __builtin_bit_cast(bf16x8, pw);
#pragma unroll
      for (int d = 0; d < 2; ++d) o[d] = MFMA32(__builtin_bit_cast(bf16x8, vw[1][s2][d]), pf, o[d]);
    }
    if (more) {
      char* nxt = lds + ((j + 1) & 1) * BUF;
#pragma unroll
      for (int i = 0; i < NKC; ++i) *(u32x4*)(nxt + koffl[i]) = rk[i];
#pragma unroll
      for (int i = 0; i < 2; ++i) { u32x2 a = {rv[i].x, rv[i].y}, b = {rv[i].z, rv[i].w}; *(u32x2*)(nxt + voffl + i * 32 * VSTR) = a; *(u32x2*)(nxt + voffl + i * 32 * VSTR + 8) = b; }
    }
    __syncthreads();
  }
  const float lt = l_run + __shfl_xor(l_run, 32);
  const float inv = 1.f / lt;
  const size_t rq = (size_t)(32 * w + l31);
#pragma unroll
  for (int d = 0; d < 2; ++d)
#pragma unroll
    for (int q = 0; q < 4; ++q) {
      const int dv = 32 * d + 8 * q + 4 * h;
      f32x4 g = unpack4(*(const u32x2*)(Pg + rq * NIN + dv));
      f32x4 v = {o[d][4 * q] * inv * silu(g[0]), o[d][4 * q + 1] * inv * silu(g[1]), o[d][4 * q + 2] * inv * silu(g[2]), o[d][4 * q + 3] * inv * silu(g[3])};
      *(u32x2*)(Yg + rq * 1024 + dv) = pack4(v);
    }
}

template <int DQK, bool STATIC>
DI void attn_item8(const bf16_t* __restrict__ Q, const bf16_t* __restrict__ Kp, const bf16_t* __restrict__ Vt, int nkeys, char* lds,
                  const bf16_t* __restrict__ Pg, bf16_t* __restrict__ Yg  , float mfix) {
  constexpr int KSTR = DQK * 2 + 16, VSTR = 136, KCH = DQK / 8, NKC = (64 * KCH + 511) / 512, NQS = DQK / 16;
  constexpr int KBUF = 64 * KSTR, BUF = KBUF + 64 * VSTR;
  const int tid = otid();
  const int lane = tid & 63, w = tid >> 6, l31 = lane & 31, h = lane >> 5;
  bf16x8 qf[NQS];
#pragma unroll
  for (int ks = 0; ks < NQS; ++ks) qf[ks] = *(const bf16x8*)(Q + (size_t)(32 * w + l31) * DQK + 16 * ks + 8 * h);
  f32x16 o[2];
#pragma unroll
  for (int d = 0; d < 2; ++d)
#pragma unroll
    for (int e = 0; e < 16; ++e) o[d][e] = 0.f;
  float m_run = STATIC ? mfix : -1e30f, l_run = 0.f;
  u32x4 rk[NKC], rv[1];
  int koffg[NKC], koffl[NKC];
#pragma unroll
  for (int i = 0; i < NKC; ++i) { const int c = tid + 512 * i; const int key = c / KCH, part = c % KCH; koffg[i] = (c < 64 * KCH) ? c * 8 : 0; koffl[i] = (c < 64 * KCH) ? key * KSTR + part * 16 : -1; }
  const int vdv0 = tid >> 3, vpart = tid & 7;
  const bf16_t* vg = Vt + (size_t)vdv0 * T + vpart * 8;
  const int voffl = KBUF + vdv0 * VSTR + vpart * 16;
  const int nt = nkeys >> 6;
#pragma unroll
  for (int i = 0; i < NKC; ++i) rk[i] = *(const u32x4*)(Kp + koffg[i]);
#pragma unroll
  for (int i = 0; i < 1; ++i) rv[i] = *(const u32x4*)(vg + (size_t)i * 32 * T);
#pragma unroll
  for (int i = 0; i < NKC; ++i) if (koffl[i] >= 0) *(u32x4*)(lds + koffl[i]) = rk[i];
#pragma unroll
  for (int i = 0; i < 1; ++i) { u32x2 a = {rv[i].x, rv[i].y}, b = {rv[i].z, rv[i].w}; *(u32x2*)(lds + voffl + i * 32 * VSTR) = a; *(u32x2*)(lds + voffl + i * 32 * VSTR + 8) = b; }
  {
#pragma unroll
    for (int i = 0; i < NKC; ++i) rk[i] = *(const u32x4*)(Kp + (size_t)64 * DQK + koffg[i]);
    rv[0] = *(const u32x4*)(vg + 64);
#pragma unroll
    for (int i = 0; i < NKC; ++i) if (koffl[i] >= 0) *(u32x4*)(lds + BUF + koffl[i]) = rk[i];
    { u32x2 a = {rv[0].x, rv[0].y}, b = {rv[0].z, rv[0].w}; *(u32x2*)(lds + BUF + voffl) = a; *(u32x2*)(lds + BUF + voffl + 8) = b; }
  }
  __syncthreads();
  const int np = nt >> 1;
  for (int jj = 0; jj < np; ++jj) {
   char* curp = lds + (jj & 1) * 2 * BUF; char* nxtp = lds + ((jj + 1) & 1) * 2 * BUF;
   const bool more = (jj + 1 < np);
#pragma nounroll
   for (int sub = 0; sub < 2; ++sub) {
    const char* cur = curp + sub * BUF;
    const int j = 2 * jj + sub + 1;
    if (more) {
#pragma unroll
      for (int i = 0; i < NKC; ++i) rk[i] = *(const u32x4*)(Kp + (size_t)(j + 1) * 64 * DQK + koffg[i]);
#pragma unroll
      for (int i = 0; i < 1; ++i) rv[i] = *(const u32x4*)(vg + (size_t)i * 32 * T + (j + 1) * 64);
    }
    f32x16 s0, s1;
    bf16x8 kf[2][NQS];
#pragma unroll
    for (int kb = 0; kb < 2; ++kb)
#pragma unroll
      for (int ks = 0; ks < NQS; ++ks) kf[kb][ks] = *(const bf16x8*)(cur + (32 * kb + l31) * KSTR + (2 * ks + h) * 16);
    u32x4 vw[2][2][2];
#pragma unroll
    for (int kb = 0; kb < 2; ++kb)
#pragma unroll
      for (int s2 = 0; s2 < 2; ++s2)
#pragma unroll
        for (int d = 0; d < 2; ++d) {
          const char* vp = cur + KBUF + (32 * d + l31) * VSTR + (32 * kb + 16 * s2 + 4 * h) * 2;
          u32x2 v0 = *(const u32x2*)vp, v1 = *(const u32x2*)(vp + 16);
          u32x4 t4 = {v0.x, v0.y, v1.x, v1.y}; vw[kb][s2][d] = t4;
        }
#pragma unroll
    for (int e = 0; e < 16; ++e) { s0[e] = STATIC ? -mfix : 0.f; s1[e] = STATIC ? -mfix : 0.f; }
#pragma unroll
    for (int ks = 0; ks < NQS; ++ks) s0 = MFMA32(kf[0][ks], qf[ks], s0);
    if (!STATIC) {
      float mx = s0[0];
#pragma unroll
      for (int e = 1; e < 16; ++e) mx = fmaxf(mx, s0[e]);
      mx = fmaxf(mx, __shfl_xor(mx, 32));
      if (!__all(mx <= m_run + 8.f)) {
        const float m_new = fmaxf(m_run, mx);
        const float alpha = __builtin_amdgcn_exp2f(m_run - m_new);
        m_run = m_new; l_run *= alpha;
#pragma unroll
        for (int d = 0; d < 2; ++d)
#pragma unroll
          for (int e = 0; e < 16; ++e) o[d][e] *= alpha;
      }
    }
#pragma unroll
    for (int ks = 0; ks < NQS; ++ks) s1 = MFMA32(kf[1][ks], qf[ks], s1);
    {
      float ps = 0.f;
#pragma unroll
      for (int e = 0; e < 16; ++e) { float p = STATIC ? __builtin_amdgcn_exp2f(s0[e]) : __builtin_amdgcn_exp2f(s0[e] - m_run); s0[e] = p; ps += p; }
      l_run += ps;
    }
    if (!STATIC) {
      float mx = s1[0];
#pragma unroll
      for (int e = 1; e < 16; ++e) mx = fmaxf(mx, s1[e]);
      mx = fmaxf(mx, __shfl_xor(mx, 32));
      if (!__all(mx <= m_run + 8.f)) {
        const float m_new = fmaxf(m_run, mx);
        const float alpha = __builtin_amdgcn_exp2f(m_run - m_new);
        m_run = m_new; l_run *= alpha;
#pragma unroll
        for (int e = 0; e < 16; ++e) s0[e] *= alpha;
#pragma unroll
        for (int d = 0; d < 2; ++d)
#pragma unroll
          for (int e = 0; e < 16; ++e) o[d][e] *= alpha;
      }
    }
#pragma unroll
    for (int s2 = 0; s2 < 2; ++s2) {
      u32x4 pw = {cvtpk(s0[8 * s2], s0[8 * s2 + 1]), cvtpk(s0[8 * s2 + 2], s0[8 * s2 + 3]), cvtpk(s0[8 * s2 + 4], s0[8 * s2 + 5]), cvtpk(s0[8 * s2 + 6], s0[8 * s2 + 7])};
      bf16x8 pf = __builtin_bit_cast(bf16x8, pw);
#pragma unroll
      for (int d = 0; d < 2; ++d) o[d] = MFMA32(__builtin_bit_cast(bf16x8, vw[0][s2][d]), pf, o[d]);
    }
    {
      float ps = 0.f;
#pragma unroll
      for (int e = 0; e < 16; ++e) { float p = STATIC ? __builtin_amdgcn_exp2f(s1[e]) : __builtin_amdgcn_exp2f(s1[e] - m_run); s1[e] = p; ps += p; }
      l_run += ps;
    }
#pragma unroll
    for (int s2 = 0; s2 < 2; ++s2) {
      u32x4 pw = {cvtpk(s1[8 * s2], s1[8 * s2 + 1]), cvtpk(s1[8 * s2 + 2], s1[8 * s2 + 3]), cvtpk(s1[8 * s2 + 4], s1[8 * s2 + 5]), cvtpk(s1[8 * s2 + 6], s1[8 * s2 + 7])};
      bf16x8 pf = __builtin_bit_cast(bf16x8, pw);
#pragma unroll
      for (int d = 0; d < 2; ++d) o[d] = MFMA32(__builtin_bit_cast(bf16x8, vw[1][s2][d]), pf, o[d]);
    }
    if (more) {
      char* nxt = nxtp + sub * BUF;
#pragma unroll
      for (int i = 0; i < NKC; ++i) if (koffl[i] >= 0) *(u32x4*)(nxt + koffl[i]) = rk[i];
#pragma unroll
      for (int i = 0; i < 1; ++i) { u32x2 a = {rv[i].x, rv[i].y}, b = {rv[i].z, rv[i].w}; *(u32x2*)(nxt + voffl + i * 32 * VSTR) = a; *(u32x2*)(nxt + voffl + i * 32 * VSTR + 8) = b; }
    }
   }
   __syncthreads();
  }
  const float lt = l_run + __shfl_xor(l_run, 32);
  const float inv = 1.f / lt;
  const size_t rq = (size_t)(32 * w + l31);
#pragma unroll
  for (int d = 0; d < 2; ++d)
#pragma unroll
    for (int q = 0; q < 4; ++q) {
      const int dv = 32 * d + 8 * q + 4 * h;
      f32x4 g = unpack4(*(const u32x2*)(Pg + rq * NIN + dv));
      f32x4 v = {o[d][4 * q] * inv * silu(g[0]), o[d][4 * q + 1] * inv * silu(g[1]), o[d][4 * q + 2] * inv * silu(g[2]), o[d][4 * q + 3] * inv * silu(g[3])};
      *(u32x2*)(Yg + rq * 1024 + dv) = pack4(v);
    }
}

DI void xpose_cvt(const float* __restrict__ src, bf16_t* __restrict__ dst, int K, int N, int Npad, bool perm_kv, size_t gtid, size_t gstride) {
  const size_t total = (size_t)Npad * (K >> 3);
#pragma nounroll
  for (size_t i = gtid; i < total; i += gstride) {
    const int n = (int)(i % Npad), kb = (int)(i / Npad);
    float v[8];
#pragma unroll
    for (int e = 0; e < 8; ++e) v[e] = (n < N) ? src[(size_t)(8 * kb + e) * N + n] : 0.f;
    int row = n;
    if (perm_kv) { const int hh = n >> 7, wv = n & 127; row = (wv < 64) ? (64 * hh + wv) : (256 + 64 * hh + (wv - 64)); }
    u32x4 o = {cvtpk(v[0], v[1]), cvtpk(v[2], v[3]), cvtpk(v[4], v[5]), cvtpk(v[6], v[7])};
    *(u32x4*)(dst + (size_t)row * K + 8 * kb) = o;
  }
}

DI void phase0(KP p, char* lds) {
  unsigned char* ws = p->ws; asm volatile("" : "+s"(ws));
  const int tid = otid();
  const size_t gtid = (size_t)blockIdx.x * NTHR + tid, gstride = (size_t)gridDim.x * NTHR;
  for (int l = 0; l < 2; ++l) {
    xpose_cvt(p->w_in + (size_t)l * 1024 * NIN, (bf16_t*)(ws + WS_WIN) + (size_t)l * NINP * 1024, 1024, NIN, NINP, false, gtid, gstride);
    xpose_cvt(p->mla_w_uq + (size_t)l * 192 * 384, (bf16_t*)(ws + WS_WUQ) + (size_t)l * 384 * 192, 192, 384, 384, false, gtid, gstride);
    xpose_cvt(p->mla_w_ukv + (size_t)l * 128 * 512, (bf16_t*)(ws + WS_WUKV) + (size_t)l * 512 * 128, 128, 512, 512, true, gtid, gstride);
    xpose_cvt(p->fnet_w + (size_t)l * 256 * 256, (bf16_t*)(ws + WS_WF) + (size_t)l * 256 * 256, 256, 256, 256, false, gtid, gstride);
    xpose_cvt(p->w_out + (size_t)l * 1024 * 1024, (bf16_t*)(ws + WS_WOUT) + (size_t)l * 1024 * 1024, 1024, 1024, 1024, false, gtid, gstride);
  }
  {
    const float* src = p->cm_w_s; bf16_t* dst = (bf16_t*)(ws + WS_WS);
    for (size_t i = gtid; i < (size_t)2 * 4 * 128 * 128 / 8; i += gstride) {
      f32x4 a = *(const f32x4*)(src + i * 8), b = *(const f32x4*)(src + i * 8 + 4);
      u32x4 o = {cvtpk(a[0], a[1]), cvtpk(a[2], a[3]), cvtpk(b[0], b[1]), cvtpk(b[2], b[3])};
      *(u32x4*)(dst + i * 8) = o;
    }
  }
  {
    bf16_t* dl = (bf16_t*)(ws + WS_DLAT);
#pragma nounroll
    for (size_t i = gtid; i < (size_t)2048 * 256; i += gstride) {
      const int sp = (int)(i >> 8), k8 = (int)(i & 255) * 8;
      float v[8];
#pragma unroll
      for (int e = 0; e < 8; ++e) { const int k = k8 + e, s = (k <= 1024) ? k : k - 1024; const int ph = (sp * s) & 2047; const float a = (float)ph * (1.f / 1024.f); v[e] = (k <= 1024) ? cospif(a) : -sinpif(a); }
      u32x4 o = {cvtpk(v[0], v[1]), cvtpk(v[2], v[3]), cvtpk(v[4], v[5]), cvtpk(v[6], v[7])};
      *(u32x4*)(dl + (size_t)sp * 2048 + k8) = o;
    }
    bf16_t* dc = (bf16_t*)(ws + WS_DCTX);
    for (size_t i = gtid; i < (size_t)256 * 64; i += gstride) {
      const int sp = (int)(i >> 6), k8 = (int)(i & 63) * 8;
      float v[8];
#pragma unroll
      for (int e = 0; e < 8; ++e) { const int k = k8 + e, s = k & 255; const int ph = (sp * s) & 255; const float a = (float)ph * (1.f / 128.f); v[e] = (k < 256) ? cospif(a) : -sinpif(a); }
      u32x4 o = {cvtpk(v[0], v[1]), cvtpk(v[2], v[3]), cvtpk(v[4], v[5]), cvtpk(v[6], v[7])};
      *(u32x4*)(dc + (size_t)sp * 512 + k8) = o;
    }
    bf16_t* cm = (bf16_t*)(ws + WS_CM);
    for (size_t i = gtid; i < (size_t)128 * 64; i += gstride) {
      const int n = (int)(i >> 6), c = (int)(i & 63);
      const int ph = (c * (n & 63)) & 63; const float a = (float)ph * (1.f / 32.f);
      cm[i] = f2bf((n < 64) ? cospif(a) : sinpif(a));
    }
    float* rg = (float*)(ws + WS_ROPG);
    for (size_t i = gtid; i < 64 * 16; i += gstride) {
      const int pos = (int)(i >> 4), j = (int)(i & 15);
      const float inv = powf(10000.f, -(float)j / 16.f); float sn, cs; sincosf((float)pos * inv, &sn, &cs);
      rg[2 * i] = cs; rg[2 * i + 1] = sn;
    }
    if (blockIdx.x == 0 && tid < 4) {
      const int l = tid >> 1, isb = tid & 1; const int d = isb ? 64 : 96;
      const float* gq = (isb ? p->gqa_qn : p->mla_qn) + l * d; const float* gk = (isb ? p->gqa_kn : p->mla_kn) + l * d;
      float mq = 0.f, mk = 0.f;
      for (int i = 0; i < d; ++i) { mq = fmaxf(mq, fabsf(gq[i])); mk = fmaxf(mk, fabsf(gk[i])); }
      ((float*)(ws + WS_SBND))[l * 2 + isb] = sqrtf((float)d) * mq * mk * 1.4426950408889634f;
    }
    float* rm = (float*)(ws + WS_ROPM);
    for (size_t i = gtid; i < 64 * 8; i += gstride) {
      const int pos = (int)(i >> 3), j = (int)(i & 7);
      const float inv = powf(10000.f, -(float)j / 8.f); float sn, cs; sincosf((float)pos * inv, &sn, &cs);
      rm[2 * i] = cs; rm[2 * i + 1] = sn;
    }
  }
  const int hb = tid >> 8, tq = tid & 255;
  float* sl = (float*)(lds + hb * HALF_LDS);
  float* mod = (float*)(ws + WS_MOD);
  const int kg = tq >> 5, cn = tq & 31;
  for (int it = 2 * blockIdx.x + hb; it < 192; it += 2 * gridDim.x) {
    const int l = it / 96, n = (it % 96) * 32 + cn;
    float acc[17];
#pragma unroll
    for (int i = 0; i < 17; ++i) acc[i] = 0.f;
    for (int half = 0; half < 2; ++half) {
      __syncthreads();
      for (int e = tq; e < 17 * 512; e += 256) {
        const int i = e >> 9, k = (e & 511) + 512 * half;
        const float cv = (i < 16) ? p->c[i * 1024 + k] : p->c_ctx[k];
        sl[e] = silu(cv);
      }
      __syncthreads();
      const float* wp = p->w_mod + ((size_t)l * 1024 + 512 * half + kg * 64) * 3072 + n;
#pragma unroll 4
      for (int kk = 0; kk < 64; ++kk) {
        const float wv = wp[(size_t)kk * 3072];
#pragma unroll
        for (int i = 0; i < 17; ++i) acc[i] = fmaf(sl[i * 512 + kg * 64 + kk], wv, acc[i]);
      }
    }
    __syncthreads();
#pragma unroll
    for (int i = 0; i < 17; ++i) sl[(kg * 17 + i) * 32 + cn] = acc[i];
    __syncthreads();
    for (int e = tq; e < 17 * 32; e += 256) {
      const int i = e >> 5, c2 = e & 31;
      float s = 0.f;
#pragma unroll
      for (int g = 0; g < 8; ++g) s += sl[(g * 17 + i) * 32 + c2];
      const int nn = (it % 96) * 32 + c2;
      mod[((size_t)l * 17 + i) * 3072 + nn] = s + p->b_mod[l * 3072 + nn];
    }
    __syncthreads();
  }
}

DI void phase_norm(KP p, int l) {
  unsigned char* ws = p->ws; asm volatile("" : "+s"(ws));
  const float* xl = (l == 0) ? p->x : p->out;
  const float* xc = (l == 0) ? p->ctx : (const float*)(ws + WS_CTX1);
  const float* g = p->norm_g + l * 1024;
  const float* mod = (const float*)(ws + WS_MOD) + (size_t)l * 17 * 3072;
  bf16_t* hx = (bf16_t*)(ws + WS_R1);
  const int tid = otid(); const int lane = tid & 63;
  const int gw = blockIdx.x * (NTHR / 64) + (tid >> 6), nw = gridDim.x * (NTHR / 64);
#pragma unroll 2
  for (int r = gw; r < M; r += nw) {
    const int b = r / T, t = r % T;
    const float* src = (t < SEQ) ? xl + ((size_t)b * SEQ + t) * 1024 : xc + ((size_t)b * CL + (t - SEQ)) * 1024;
    const float* mr = mod + (size_t)((t < SEQ) ? b : 16) * 3072;
    f32x4 v[4]; float ss = 0.f;
#pragma unroll
    for (int i = 0; i < 4; ++i) { v[i] = *(const f32x4*)(src + i * 256 + lane * 4); ss += v[i][0] * v[i][0] + v[i][1] * v[i][1] + v[i][2] * v[i][2] + v[i][3] * v[i][3]; }
    ss = red64(ss);
    const float rstd = rsqrtf(ss * (1.f / 1024.f) + 1e-6f);
#pragma unroll
    for (int i = 0; i < 4; ++i) {
      const int k = i * 256 + lane * 4;
      f32x4 gg = *(const f32x4*)(g + k), sh = *(const f32x4*)(mr + k), sc = *(const f32x4*)(mr + 1024 + k);
      f32x4 o;
#pragma unroll
      for (int e = 0; e < 4; ++e) o[e] = v[i][e] * rstd * gg[e] * (1.f + sc[e]) + sh[e];
      *(u32x2*)(hx + (size_t)r * 1024 + k) = pack4(o);
    }
  }
}

DI void phase_inproj(KP p, int l, char* lds) {
  unsigned char* ws = p->ws; asm volatile("" : "+s"(ws));
  const bf16_t* hx = (const bf16_t*)(ws + WS_R1);
  const bf16_t* wt = (const bf16_t*)(ws + WS_WIN) + (size_t)l * NINP * 1024;
  bf16_t* P = (bf16_t*)(ws + WS_P);
  const int xcd = blockIdx.x & 7, lb = blockIdx.x >> 3, nlb = gridDim.x >> 3, hb = __builtin_amdgcn_readfirstlane(otid() >> 8);
  constexpr int NBIG = 18 * 10;
  for (int j = lb; j < NBIG + 18; j += nlb) {
    if (j < NBIG) {
      int mloc, ntile;
      if (j < 144) { mloc = (j % 72) >> 2; ntile = (j / 72) * 4 + (j & 3); } else { const int j2 = j - 144; mloc = j2 >> 1; ntile = 8 + (j2 & 1); }
      const int mt = 18 * xcd + mloc;
      if (l == 1 && (mt % 9) == 8 && !(ntile == 0 || ntile == 1 || ntile == 3 || ntile == 4)) continue;
      const int m0 = mt * 256, n0 = ntile * 256;
      gemm256(hx + (size_t)m0 * 1024, 1024, wt + (size_t)n0 * 1024, 1024, 1024, lds, [&](int m, int n, f32x4 v) {
        __builtin_nontemporal_store(pack4(v), (u32x2*)(P + (size_t)(m0 + m) * NIN + n0 + n));
      });
    } else {
      const int mt = 36 * xcd + 2 * (j - NBIG) + hb;
      if (l == 1 && (mt % 18) >= 16) continue;
      const int m0 = mt * 128;
      gemm_tile(hx + (size_t)m0 * 1024, 1024, wt + (size_t)2560 * 1024, 1024, 1024, lds, [&](int m, int n, f32x4 v) {
        if (2560 + n < NIN) __builtin_nontemporal_store(pack4(v), (u32x2*)(P + (size_t)(m0 + m) * NIN + 2560 + n));
      });
    }
  }
}

DI void rope4(f32x4& v, int u, int t, const float* __restrict__ rg) {
  const int pos = (u & 8) ? (t & 63) : (t >> 6);
  const float sg = (u & 4) ? 1.f : -1.f;
#pragma unroll
  for (int e = 0; e < 4; ++e) {
    const float xp = __shfl_xor(v[e], 4);
    const f32x2 cs = *(const f32x2*)(rg + (pos * 16 + 4 * (u & 3) + e) * 2);
    v[e] = v[e] * cs[0] + sg * xp * cs[1];
  }
}
DI void rope2(float& a, float& b, int u, int t, const float* __restrict__ rm) {
  const int pos = (u & 8) ? (t & 63) : (t >> 6);
  const float sg = (u & 4) ? 1.f : -1.f;
  const float ap = __shfl_xor(a, 4), bp = __shfl_xor(b, 4);
  const f32x4 cs = *(const f32x4*)(rm + (pos * 8 + 2 * (u & 3)) * 2);
  a = a * cs[0] + sg * ap * cs[1];
  b = b * cs[2] + sg * bp * cs[3];
}

DI void phase_feat_a(KP p, int l, char* lds) {
  unsigned char* ws = p->ws; asm volatile("" : "+s"(ws));
  const bf16_t* P = (const bf16_t*)(ws + WS_P);
  bf16_t* cqn = (bf16_t*)(ws + WS_R1 + R1_CQN);
  bf16_t* ckvn = (bf16_t*)(ws + WS_R1 + R1_CKVN);
  bf16_t* QB = (bf16_t*)(ws + WS_QB); bf16_t* KB = (bf16_t*)(ws + WS_KB); bf16_t* VBT = (bf16_t*)(ws + WS_VBT);
  bf16_t* vnT = (bf16_t*)(ws + WS_VNT);
  const float* rg = (const float*)(ws + WS_ROPG);
  const int tid = otid(); const int lane = tid & 63, u = lane & 15, sub = lane >> 4;
  const int gw = blockIdx.x * (NTHR / 64) + (tid >> 6), nw = gridDim.x * (NTHR / 64);
  const int hb = tid >> 8, tq = tid & 255; char* ldh = lds + hb * HALF_LDS;
  {
    constexpr int STR = 144;
    const float* lg = p->cm_ln_g + l * 256; const float* lbp = p->cm_ln_b + l * 256;
    for (int unit = 2 * blockIdx.x + hb; unit < (M / 64) * 2; unit += 2 * gridDim.x) {
      const int grp = unit >> 1; const bool isv2 = unit & 1;
      const int r0 = grp * 64; const int b = r0 / T, t0 = r0 % T;
      if (!isv2) {
        const int c = tq & 31, rb = 2 * (tq >> 5);
        f32x4 g0 = *(const f32x4*)(lg + 8 * c), g1 = *(const f32x4*)(lg + 8 * c + 4), b0 = *(const f32x4*)(lbp + 8 * c), b1 = *(const f32x4*)(lbp + 8 * c + 4);
        const float gg[8] = {g0[0], g0[1], g0[2], g0[3], g1[0], g1[1], g1[2], g1[3]};
        const float bb[8] = {b0[0], b0[1], b0[2], b0[3], b1[0], b1[1], b1[2], b1[3]};
#pragma unroll
        for (int i = 0; i < 4; ++i) {
          float vn[2][8];
#pragma unroll
          for (int rr = 0; rr < 2; ++rr) {
            const int row = rb + 16 * i + rr;
            u32x4 q = *(const u32x4*)(P + (size_t)(r0 + row) * NIN + O_V + 8 * c);
            float f[8] = {bflo(q.x), bfhi(q.x), bflo(q.y), bfhi(q.y), bflo(q.z), bfhi(q.z), bflo(q.w), bfhi(q.w)};
            float s1 = 0.f, s2 = 0.f;
#pragma unroll
            for (int e = 0; e < 8; ++e) { s1 += f[e]; s2 += f[e] * f[e]; }
#pragma unroll
            for (int m = 1; m < 32; m <<= 1) { s1 += __shfl_xor(s1, m); s2 += __shfl_xor(s2, m); }
            const float mu = s1 * (1.f / 256.f); const float var = fmaxf(s2 * (1.f / 256.f) - mu * mu, 0.f); const float rs = rsqrtf(var + 1e-6f);
#pragma unroll
            for (int e = 0; e < 8; ++e) vn[rr][e] = (f[e] - mu) * rs * gg[e] + bb[e];
          }
#pragma unroll
          for (int e = 0; e < 8; ++e) *(unsigned*)(ldh + (8 * c + e) * STR + (rb + 16 * i) * 2) = cvtpk(vn[0][e], vn[1][e]);
        }
        __syncthreads();
        bf16_t* vo = vnT + (size_t)(r0 >> 7) * 256 * 128 + (r0 & 127);
#pragma unroll
        for (int i = 0; i < 8; ++i) {
          const int ch = (tq >> 3) + 32 * i, part = tq & 7;
          *(u32x4*)(vo + (size_t)ch * 128 + part * 8) = *(const u32x4*)(ldh + ch * STR + part * 16);
        }
      } else {
        const int c = tq & 15, rb = 2 * (tq >> 4);
#pragma unroll
        for (int i = 0; i < 2; ++i) {
          u32x4 q0 = *(const u32x4*)(P + (size_t)(r0 + rb + 32 * i) * NIN + O_V2 + 8 * c);
          u32x4 q1 = *(const u32x4*)(P + (size_t)(r0 + rb + 32 * i + 1) * NIN + O_V2 + 8 * c);
          const unsigned a[4] = {q0.x, q0.y, q0.z, q0.w}, d[4] = {q1.x, q1.y, q1.z, q1.w};
#pragma unroll
          for (int e = 0; e < 4; ++e) {
            *(unsigned*)(ldh + (8 * c + 2 * e) * STR + (rb + 32 * i) * 2) = (a[e] & 0xffffu) | (d[e] << 16);
            *(unsigned*)(ldh + (8 * c + 2 * e + 1) * STR + (rb + 32 * i) * 2) = (a[e] >> 16) | (d[e] & 0xffff0000u);
          }
        }
        __syncthreads();
        bf16_t* vb = VBT + (size_t)b * 2 * 64 * T + t0;
#pragma unroll
        for (int i = 0; i < 4; ++i) {
          const int ch = (tq >> 3) + 32 * i, part = tq & 7;
          *(u32x4*)(vb + (size_t)ch * T + part * 8) = *(const u32x4*)(ldh + ch * STR + part * 16);
        }
      }
      __syncthreads();
    }
  }
  constexpr int NTA = M / 4;
#pragma unroll 4
  for (int task = gw; task < NTA; task += nw) {
    {
      const int r = task * 4 + sub; const int b = r / T, t = r % T;
      const bf16_t* pr = P + (size_t)r * NIN;
      {
        f32x4 v[3]; float ss = 0.f;
#pragma unroll
        for (int e = 0; e < 3; ++e) { v[e] = unpack4(*(const u32x2*)(pr + O_CQ + 12 * u + 4 * e)); ss += v[e][0] * v[e][0] + v[e][1] * v[e][1] + v[e][2] * v[e][2] + v[e][3] * v[e][3]; }
        ss = red16(ss); const float rs = rsqrtf(ss * (1.f / 192.f) + 1e-6f);
#pragma unroll
        for (int e = 0; e < 3; ++e) {
          f32x4 g = *(const f32x4*)(p->mla_q_norm + l * 192 + 12 * u + 4 * e);
          f32x4 o = {v[e][0] * rs * g[0], v[e][1] * rs * g[1], v[e][2] * rs * g[2], v[e][3] * rs * g[3]};
          *(u32x2*)(cqn + (size_t)r * 192 + 12 * u + 4 * e) = pack4(o);
        }
      }
      {
        f32x4 v[2]; float ss = 0.f;
#pragma unroll
        for (int e = 0; e < 2; ++e) { v[e] = unpack4(*(const u32x2*)(pr + O_CKV + 8 * u + 4 * e)); ss += v[e][0] * v[e][0] + v[e][1] * v[e][1] + v[e][2] * v[e][2] + v[e][3] * v[e][3]; }
        ss = red16(ss); const float rs = rsqrtf(ss * (1.f / 128.f) + 1e-6f);
#pragma unroll
        for (int e = 0; e < 2; ++e) {
          f32x4 g = *(const f32x4*)(p->mla_kv_norm + l * 128 + 8 * u + 4 * e);
          f32x4 o = {v[e][0] * rs * g[0], v[e][1] * rs * g[1], v[e][2] * rs * g[2], v[e][3] * rs * g[3]};
          *(u32x2*)(ckvn + (size_t)r * 128 + 8 * u + 4 * e) = pack4(o);
        }
      }
#pragma unroll
      for (int hh = 0; hh < 6; ++hh) {
        const bool isq = hh < 4; const int hd = isq ? hh : hh - 4;
        f32x4 v = unpack4(*(const u32x2*)(pr + (isq ? O_Q2 : O_K2) + 64 * hd + 4 * u));
        float ss = red16(v[0] * v[0] + v[1] * v[1] + v[2] * v[2] + v[3] * v[3]);
        const float rs = rsqrtf(ss * (1.f / 64.f) + 1e-6f);
        f32x4 g = *(const f32x4*)((isq ? p->gqa_qn : p->gqa_kn) + l * 64 + 4 * u);
#pragma unroll
        for (int e = 0; e < 4; ++e) v[e] = v[e] * rs * g[e];
        if (t < SEQ) rope4(v, u, t, rg);
        if (isq) {
#pragma unroll
          for (int e = 0; e < 4; ++e) v[e] *= 0.18033688011112042f;
        }
        bf16_t* dst = isq ? QB + (((size_t)b * 4 + hd) * T + t) * 64 + 4 * u : KB + (((size_t)b * 2 + hd) * T + t) * 64 + 4 * u;
        *(u32x2*)dst = pack4(v);
      }
    }
  }
}

DI void phase_feat_b(KP p, int l, char* lds) {
  unsigned char* ws = p->ws; asm volatile("" : "+s"(ws));
  const bf16_t* P = (const bf16_t*)(ws + WS_P);
  const bf16_t* cqn = (const bf16_t*)(ws + WS_R1 + R1_CQN);
  const bf16_t* ckvn = (const bf16_t*)(ws + WS_R1 + R1_CKVN);
  bf16_t* q1r = (bf16_t*)(ws + WS_R1 + R1_Q1R);
  bf16_t* kr = (bf16_t*)(ws + WS_R1 + R1_KR);
  const bf16_t* wuq = (const bf16_t*)(ws + WS_WUQ) + (size_t)l * 384 * 192;
  const bf16_t* wukv = (const bf16_t*)(ws + WS_WUKV) + (size_t)l * 512 * 128;
  const bf16_t* cm = (const bf16_t*)(ws + WS_CM);
  bf16_t* VAT = (bf16_t*)(ws + WS_VAT); bf16_t* FT = (bf16_t*)(ws + WS_FT); bf16_t* FTC = (bf16_t*)(ws + WS_FTC);
  constexpr int N1 = 288 * 3, N2 = 288 * 2, N3 = 288 * 2, N4 = 288 * 4;
  const int hbb = __builtin_amdgcn_readfirstlane(otid() >> 8);
  for (int it = 2 * blockIdx.x + hbb; it < N1 + N2 + N3 + N4; it += 2 * gridDim.x) {
    if (it < N1) {
      const int mt = it / 3, nt = it % 3; const int m0 = mt * 128, n0 = nt * 128;
      gemm_tile(cqn + (size_t)m0 * 192, 192, wuq + (size_t)n0 * 192, 192, 192, lds, [&](int m, int n, f32x4 v) {
        *(u32x2*)(q1r + (size_t)(m0 + m) * 384 + n0 + n) = pack4(v); });
    } else if (it < N1 + N2) {
      const int i2 = it - N1; const int mt = i2 >> 1, nt = i2 & 1; const int m0 = mt * 128, n0 = nt * 128;
      gemm_tile(ckvn + (size_t)m0 * 128, 128, wukv + (size_t)n0 * 128, 128, 128, lds, [&](int m, int n, f32x4 v) {
        *(u32x2*)(kr + (size_t)(m0 + m) * 256 + n0 + n) = pack4(v); });
    } else if (it < N1 + N2 + N3) {
      const int i2 = it - N1 - N2; const int tt = i2 >> 1, mt2 = i2 & 1;
      gemm_tile(wukv + (size_t)(256 + 128 * mt2) * 128, 128, ckvn + (size_t)tt * 128 * 128, 128, 128, lds, [&](int m, int n, f32x4 v) {
        const int mm = 128 * mt2 + m, head = mm >> 6, dv = mm & 63; const int r = tt * 128 + n; const int b = r / T, t = r % T;
        *(u32x2*)(VAT + (((size_t)b * 4 + head) * 64 + dv) * T + t) = pack4(v); });
    } else {
      const int i2 = it - N1 - N2 - N3; const int tt = i2 >> 2, g = i2 & 3;
      gemm_tile(cm, 64, P + (size_t)tt * 128 * NIN + O_F + 64 * g, NIN, 64, lds, [&](int m, int n, f32x4 v) {
        const int col = 64 * g + (m & 63), part = m >> 6; const int r = tt * 128 + n; const int b = r / T, t = r % T;
        if (t < SEQ) *(u32x2*)(FT + ((size_t)b * 256 + col) * 4096 + part * 2048 + t) = pack4(v);
        else *(u32x2*)(FTC + ((size_t)b * 256 + col) * 512 + part * 256 + (t - SEQ)) = pack4(v); });
    }
  }
}

DI void phase_feat_c(KP p, int l) {
  unsigned char* ws = p->ws; asm volatile("" : "+s"(ws));
  const bf16_t* P = (const bf16_t*)(ws + WS_P);
  const bf16_t* q1r = (const bf16_t*)(ws + WS_R1 + R1_Q1R);
  const bf16_t* krw = (const bf16_t*)(ws + WS_R1 + R1_KR);
  bf16_t* QA = (bf16_t*)(ws + WS_QA); bf16_t* KA = (bf16_t*)(ws + WS_KA);
  const float* rm = (const float*)(ws + WS_ROPM);
  const int tid = otid(); const int lane = tid & 63, u = lane & 15, sub = lane >> 4;
  const int gw = blockIdx.x * (NTHR / 64) + (tid >> 6), nw = gridDim.x * (NTHR / 64);
  {
    const bf16_t* FT = (const bf16_t*)(ws + WS_FT); bf16_t* FTF = (bf16_t*)(ws + WS_FTF);
    for (int task = gw; task < NB * 256 * 4; task += nw) {
      const int row = task >> 2, k8 = (task & 3) * 512 + lane * 8;
      const bf16_t* fr = FT + (size_t)row * 4096;
      const bool cosp = k8 < 1024;
      const int f0 = cosp ? k8 : 2048 + (k8 - 1024);
      const int mi = cosp ? 2048 - k8 : 4096 - (k8 - 1024);
      const u32x4 fw = *(const u32x4*)(fr + f0), ml = *(const u32x4*)(fr + mi - 8);
      const float m0v = bflo((unsigned)fr[(mi < 4096) ? mi : 4095]);
      const float f[8] = {bflo(fw.x), bfhi(fw.x), bflo(fw.y), bfhi(fw.y), bflo(fw.z), bfhi(fw.z), bflo(fw.w), bfhi(fw.w)};
      const float mr[8] = {m0v, bfhi(ml.w), bflo(ml.w), bfhi(ml.z), bflo(ml.z), bfhi(ml.y), bflo(ml.y), bfhi(ml.x)};
      float v[8];
#pragma unroll
      for (int e = 0; e < 8; ++e) {
        const int k = k8 + e;
        if (k < 1024) v[e] = f[e] + ((k == 0) ? 0.f : mr[e]);
        else if (k == 1024) v[e] = bflo((unsigned)fr[1024]);
        else v[e] = f[e] - mr[e];
      }
      u32x4 o = {cvtpk(v[0], v[1]), cvtpk(v[2], v[3]), cvtpk(v[4], v[5]), cvtpk(v[6], v[7])};
      *(u32x4*)(FTF + (size_t)row * 2048 + k8) = o;
    }
  }
#pragma unroll 4
  for (int task = gw; task < M / 4; task += nw) {
    const int r = task * 4 + sub; const int b = r / T, t = r % T;
    const unsigned krp = *(const unsigned*)(P + (size_t)r * NIN + O_KR + 2 * u);
#pragma unroll
    for (int hh = 0; hh < 8; ++hh) {
      const bool isq = hh < 4; const int hd = hh & 3;
      f32x4 v; float ra, rb;
      if (isq) {
        v = unpack4(*(const u32x2*)(q1r + (size_t)r * 384 + 96 * hd + 4 * u));
        const unsigned rr = *(const unsigned*)(q1r + (size_t)r * 384 + 96 * hd + 64 + 2 * u); ra = bflo(rr); rb = bfhi(rr);
      } else {
        v = unpack4(*(const u32x2*)(krw + (size_t)r * 256 + 64 * hd + 4 * u));
        ra = bflo(krp); rb = bfhi(krp);
      }
      float ss = red16(v[0] * v[0] + v[1] * v[1] + v[2] * v[2] + v[3] * v[3] + ra * ra + rb * rb);
      const float rs = rsqrtf(ss * (1.f / 96.f) + 1e-6f);
      const float* gn = (isq ? p->mla_qn : p->mla_kn) + l * 96;
      f32x4 g = *(const f32x4*)(gn + 4 * u); f32x2 g2 = *(const f32x2*)(gn + 64 + 2 * u);
#pragma unroll
      for (int e = 0; e < 4; ++e) v[e] = v[e] * rs * g[e];
      ra = ra * rs * g2[0]; rb = rb * rs * g2[1];
      if (t < SEQ) rope2(ra, rb, u, t, rm);
      if (isq) {
        const float cq = 1.4426950408889634f / __builtin_sqrtf(96.f);
#pragma unroll
        for (int e = 0; e < 4; ++e) v[e] *= cq;
        ra *= cq; rb *= cq;
      }
      bf16_t* dst = (isq ? QA : KA) + (((size_t)b * 4 + hd) * T + t) * 96;
      *(u32x2*)(dst + 4 * u) = pack4(v);
      *(unsigned*)(dst + 64 + 2 * u) = cvtpk(ra, rb);
    }
  }
}

DI void phase_mix(KP p, int l, char* lds) {
  unsigned char* ws = p->ws; asm volatile("" : "+s"(ws));
  const bf16_t* P = (const bf16_t*)(ws + WS_P);
  bf16_t* Y = (bf16_t*)(ws + WS_R1);
  bf16_t* YD = (bf16_t*)(ws + WS_YD);
  const bf16_t* QA = (const bf16_t*)(ws + WS_QA); const bf16_t* KA = (const bf16_t*)(ws + WS_KA); const bf16_t* VAT = (const bf16_t*)(ws + WS_VAT);
  const bf16_t* QB = (const bf16_t*)(ws + WS_QB); const bf16_t* KB = (const bf16_t*)(ws + WS_KB); const bf16_t* VBT = (const bf16_t*)(ws + WS_VBT);
  const bf16_t* FTF = (const bf16_t*)(ws + WS_FTF); const bf16_t* FTC = (const bf16_t*)(ws + WS_FTC);
  const bf16_t* DL = (const bf16_t*)(ws + WS_DLAT); const bf16_t* DC = (const bf16_t*)(ws + WS_DCTX);
  const bf16_t* vnT = (const bf16_t*)(ws + WS_VNT);
  const bf16_t* wsb = (const bf16_t*)(ws + WS_WS) + (size_t)l * 4 * 128 * 128;
  const bool upd = (l == 0);
  const float sbA = ((const float*)(ws + WS_SBND))[l * 2], sbB = ((const float*)(ws + WS_SBND))[l * 2 + 1];
  const int xcd = blockIdx.x & 7, lb = 2 * (blockIdx.x >> 3) + __builtin_amdgcn_readfirstlane(otid() >> 8), nlb = 2 * (gridDim.x >> 3);
  const int nDL = 64, nA = 0, nB = 0, nDC = upd ? 8 : 0, nAc = 0, nBc = 0, nCM = 144, nFN = upd ? 72 : 64;
  const int e0 = nDL, e1 = e0 + nA, e2 = e1 + nB, e3 = e2 + nDC, e4 = e3 + nAc, e5 = e4 + nBc, e6 = e5 + nCM, e7 = e6 + nFN;
  unsigned* cnt = (unsigned*)(ws + WS_CNT) + l * 288;
  const bf16_t* wf = (const bf16_t*)(ws + WS_WF) + (size_t)l * 256 * 256;
  {
    const int lbw = blockIdx.x >> 3, nlbw = gridDim.x >> 3;
    const int nW = upd ? 144 : 128;
    for (int it = lbw; it < nW; it += nlbw) {
      const bool isA = (it < 64) || (it >= 128 && it < 136);
      int b, hd, q0, k0, nk;
      if (it < 128) { const int i2 = it & 63; b = 2 * xcd + (i2 >> 5); hd = (i2 >> 3) & 3; q0 = (i2 & 7) * 256; k0 = 0; nk = T; }
      else { const int i2 = (it - 128) & 7; b = 2 * xcd + (i2 >> 2); hd = i2 & 3; q0 = SEQ; k0 = SEQ; nk = CL; }
      const size_t r0 = (size_t)b * T + q0; const size_t bh = (size_t)b * 4 + hd, bk = (size_t)b * 2 + (hd >> 1);
      if (isA) {
        if (sbA <= 30.f) attn_item8<96, true>(QA + (bh * T + q0) * 96, KA + (bh * T + k0) * 96, VAT + bh * 64 * T + k0, nk, lds, P + r0 * NIN + O_GA + 64 * hd, Y + r0 * 1024 + 64 * hd, sbA);
        else attn_item8<96, false>(QA + (bh * T + q0) * 96, KA + (bh * T + k0) * 96, VAT + bh * 64 * T + k0, nk, lds, P + r0 * NIN + O_GA + 64 * hd, Y + r0 * 1024 + 64 * hd, 0.f);
      } else {
        if (sbB <= 30.f) attn_item8<64, true>(QB + (bh * T + q0) * 64, KB + (bk * T + k0) * 64, VBT + bk * 64 * T + k0, nk, lds, P + r0 * NIN + O_GB + 64 * hd, Y + r0 * 1024 + 256 + 64 * hd, sbB);
        else attn_item8<64, false>(QB + (bh * T + q0) * 64, KB + (bk * T + k0) * 64, VBT + bk * 64 * T + k0, nk, lds, P + r0 * NIN + O_GB + 64 * hd, Y + r0 * 1024 + 256 + 64 * hd, 0.f);
      }
    }
    __syncthreads();
  }
  const int tid0 = otid() & 255;
  for (int it = lb; it < e7; it += nlb) {
    if (it >= e6) {
      const int i2 = it - e6; const int mpb = upd ? 18 : 16; const int mloc = i2 >> 1, nt = i2 & 1;
      const int mt = (2 * xcd + mloc / mpb) * 18 + (mloc % mpb);
      if (tid0 == 0) {
        unsigned sp = 0;
        while (__hip_atomic_load(&cnt[mt], __ATOMIC_RELAXED, __HIP_MEMORY_SCOPE_AGENT) < 2u) { __builtin_amdgcn_s_sleep(2); if (++sp > (1u << 24)) break; }
        __builtin_amdgcn_fence(__ATOMIC_ACQUIRE, "agent");
        asm volatile("s_waitcnt vmcnt(0)" ::: "memory");
      }
      __syncthreads();
      const int m0 = mt * 128, n0 = nt * 128;
      gemm_tile(YD + (size_t)m0 * 256, 256, wf + (size_t)n0 * 256, 256, 256, lds, [&](int m, int n, f32x4 v) {
        const size_t r = (size_t)m0 + m;
        f32x4 gd = unpack4(*(const u32x2*)(P + r * NIN + O_GD + n0 + n));
        f32x4 o = {v[0] * silu(gd[0]), v[1] * silu(gd[1]), v[2] * silu(gd[2]), v[3] * silu(gd[3])};
        *(u32x2*)(Y + r * 1024 + 768 + n0 + n) = pack4(o); });
      continue;
    }
    if (it < e0 || (it >= e2 && it < e3)) {
      const bool isl = it < e0; const int i2 = isl ? it : it - e2;
      int b, mt, nt, K; const bf16_t* Ap; const bf16_t* Bp; float sc; size_t rbase;
      if (isl) { b = 2 * xcd + (i2 >> 5); mt = (i2 >> 1) & 15; nt = i2 & 1; K = 2048; Ap = DL + (size_t)mt * 128 * 2048; Bp = FTF + ((size_t)b * 256 + nt * 128) * 2048; sc = 0.00276213586f; rbase = (size_t)b * T + mt * 128; }
      else { b = 2 * xcd + (i2 >> 2); mt = (i2 >> 1) & 1; nt = i2 & 1; K = 512; Ap = DC + (size_t)mt * 128 * 512; Bp = FTC + ((size_t)b * 256 + nt * 128) * 512; sc = 0.0078125f; rbase = (size_t)b * T + SEQ + mt * 128; }
      bf16_t* yo = YD + rbase * 256 + nt * 128;
      gemm_tile(Ap, K, Bp, K, K, lds, [&](int m, int n, f32x4 v) {
        f32x4 o = {v[0] * sc, v[1] * sc, v[2] * sc, v[3] * sc};
        *(u32x2*)(yo + (size_t)m * 256 + n) = pack4(o); });
      asm volatile("s_waitcnt vmcnt(0)" ::: "memory");
      __syncthreads();
      if (tid0 == 0) {
        __builtin_amdgcn_fence(__ATOMIC_RELEASE, "agent");
        asm volatile("s_waitcnt vmcnt(0)" ::: "memory");
        __hip_atomic_fetch_add(&cnt[b * 18 + (isl ? mt : 16 + mt)], 1u, __ATOMIC_RELAXED, __HIP_MEMORY_SCOPE_AGENT);
      }
    } else {
      const int i2 = it - e5; const int bl = i2 / 72, rem = i2 % 72; const int chl = rem >> 2, g = rem & 3;
      const int ch = (2 * xcd + bl) * 18 + chl;
      if (!upd && chl >= 16) continue;
      const float* bs = p->cm_b_s + ((size_t)l * 4 + g) * 128;
      const bf16_t* Pr = P + (size_t)ch * 128 * NIN + 64 * g; bf16_t* Yr = Y + (size_t)ch * 128 * 1024 + 512 + 64 * g;
      gemm_tile(wsb + (size_t)g * 128 * 128, 128, vnT + ((size_t)ch * 256 + 64 * g) * 128, 128, 128, lds, [&](int m, int n, f32x4 v) {
        if (n < 64) {
          const float bias = bs[m];
          f32x4 uu = unpack4(*(const u32x2*)(Pr + (size_t)m * NIN + O_U + n)), gc = unpack4(*(const u32x2*)(Pr + (size_t)m * NIN + O_GC + n));
          f32x4 o;
#pragma unroll
          for (int e = 0; e < 4; ++e) o[e] = uu[e] * (v[e] + bias) * silu(gc[e]);
          *(u32x2*)(Yr + (size_t)m * 1024 + n) = pack4(o);
        } });
    }
  }
}

DI void phase_outproj(KP p, int l, char* lds) {
  unsigned char* ws = p->ws; asm volatile("" : "+s"(ws));
  const bf16_t* Y = (const bf16_t*)(ws + WS_R1);
  const bf16_t* wo = (const bf16_t*)(ws + WS_WOUT) + (size_t)l * 1024 * 1024;
  const float* mod = (const float*)(ws + WS_MOD) + (size_t)l * 17 * 3072;
  const float* xl = (l == 0) ? p->x : p->out;
  float* ctx1 = (float*)(ws + WS_CTX1);
  const int xcd = blockIdx.x & 7, lb = blockIdx.x >> 3, nlb = gridDim.x >> 3, hb = __builtin_amdgcn_readfirstlane(otid() >> 8);
  const int nsm = (l == 0) ? 16 : 0;
  for (int j = lb; j < 64; j += nlb) {
    {
      const int mi = j >> 2, nt = j & 3;
      const int bb = 2 * xcd + (mi >> 3), tt = mi & 7;
      const int m0 = (bb * 9 + tt) * 256, n0 = nt * 256;
      const float* src = xl + ((size_t)bb * SEQ + tt * 256) * 1024;
      float* dst = p->out + ((size_t)bb * SEQ + tt * 256) * 1024;
      const float* gt = mod + (size_t)bb * 3072 + 2048;
      gemm256(Y + (size_t)m0 * 1024, 1024, wo + (size_t)n0 * 1024, 1024, 1024, lds, [&](int m, int n, f32x4 v) {
        const size_t o = (size_t)m * 1024 + n0 + n;
        f32x4 xv = __builtin_nontemporal_load((const f32x4*)(src + o)), g = *(const f32x4*)(gt + n0 + n);
        f32x4 r = {xv[0] + g[0] * v[0], xv[1] + g[1] * v[1], xv[2] + g[2] * v[2], xv[3] + g[3] * v[3]};
        __builtin_nontemporal_store(r, (f32x4*)(dst + o)); });
    }
  }
  for (int j = lb; j < nsm; j += nlb) {
    {
      const int item = 2 * j + hb; const int bb = 2 * xcd + (item >> 4), m128 = (item >> 3) & 1, nt = item & 7;
      const int m0 = (bb * 18 + 16 + m128) * 128, n0 = nt * 128;
      const float* src = p->ctx + ((size_t)bb * CL + m128 * 128) * 1024;
      float* dst = ctx1 + ((size_t)bb * CL + m128 * 128) * 1024;
      const float* gt = mod + (size_t)16 * 3072 + 2048;
      gemm_tile(Y + (size_t)m0 * 1024, 1024, wo + (size_t)n0 * 1024, 1024, 1024, lds, [&](int m, int n, f32x4 v) {
        const size_t o = (size_t)m * 1024 + n0 + n;
        f32x4 xv = *(const f32x4*)(src + o), g = *(const f32x4*)(gt + n0 + n);
        f32x4 r = {xv[0] + g[0] * v[0], xv[1] + g[1] * v[1], xv[2] + g[2] * v[2], xv[3] + g[3] * v[3]};
        *(f32x4*)(dst + o) = r; });
    }
  }
}

__global__ void __launch_bounds__(NTHR, 2) fwd_megakernel(Params p_byval) {
  KP p = (KP)__builtin_amdgcn_kernarg_segment_ptr();
  extern __shared__ __attribute__((aligned(16))) char lds[];
  cg::grid_group grid = cg::this_grid();
  uint4* xbw = (uint4*)(lds + LDS_MAIN);
  if (threadIdx.x == 0) *xbw = make_uint4(0u, 0u, 0u, 0u);
  __syncthreads();
  XcdBarrier xb = xcd_barrier_post((unsigned*)(p->ws + WS_BAR), (volatile LAS unsigned*)xbw);
  if (p->ph_hi < p->ph_lo) grid.sync();
  (void)p_byval;
  for (int ph = p->ph_lo; ph < p->ph_hi; ++ph) {
    asm volatile("" : "+s"(p));
    if (ph == 0) phase0(p, lds);
    else {
      const int l = (ph - 1) / 7, s = (ph - 1) % 7;
      switch (s) {
        case 0: phase_norm(p, l); break;
        case 1: phase_inproj(p, l, lds); break;
        case 2: phase_feat_a(p, l, lds); break;
        case 3: phase_feat_b(p, l, lds); break;
        case 4: phase_feat_c(p, l); break;
        case 5: phase_mix(p, l, lds); break;
        default: phase_outproj(p, l, lds); break;
      }
    }
    if (ph + 1 < p->ph_hi) xcd_barrier(xb);
  }
}

extern "C" void kernel_launch(void* const* d_in, const int* in_sizes, int n_in, void* d_out, int out_size, void* d_ws, size_t ws_size, hipStream_t stream) {
  static int grid_blocks = 0;
  if (!grid_blocks) {
    int dev = 0, cus = 0, per_cu = 0;
    hipGetDevice(&dev);
    hipDeviceGetAttribute(&cus, hipDeviceAttributeMultiprocessorCount, dev);
    hipFuncSetAttribute((const void*)fwd_megakernel, hipFuncAttributeMaxDynamicSharedMemorySize, LDS_BYTES);
    hipOccupancyMaxActiveBlocksPerMultiprocessor(&per_cu, fwd_megakernel, NTHR, LDS_BYTES);
    if (per_cu > 1) per_cu = 1;
    if (per_cu < 1) per_cu = 1;
    grid_blocks = cus * per_cu;
    if (ws_size < WS_END) fprintf(stderr, "kernel_launch: workspace too small: %zu < %zu\n", ws_size, (size_t)WS_END);
  }
  hipMemsetAsync((unsigned char*)d_ws + WS_BAR, 0, WS_ZERO_BYTES, stream);
  Params p{};
  const float** pp = (const float**)&p;
  for (int i = 0; i < 22; ++i) pp[i] = (const float*)d_in[i];
  p.out = (float*)d_out; p.ws = (unsigned char*)d_ws;
  constexpr int NPH = 15;
#if PER_PHASE_LAUNCH
  for (int ph = 0; ph < NPH; ++ph) {
    p.ph_lo = ph; p.ph_hi = ph + 1;
    hipLaunchKernelGGL(fwd_megakernel, dim3(grid_blocks), dim3(NTHR), LDS_BYTES, stream, p);
  }
#else
  p.ph_lo = 0; p.ph_hi = NPH;
  void* args[] = {&p};
  hipError_t e = hipLaunchCooperativeKernel((void*)fwd_megakernel, dim3(grid_blocks), dim3(NTHR), args, LDS_BYTES, stream);
  if (e != hipSuccess) fprintf(stderr, "cooperative launch failed: %s (grid %d)\n", hipGetErrorString(e), grid_blocks);
#endif
}
```

```cpp
#include <hip/hip_runtime.h>
#include <hip/hip_cooperative_groups.h>
#include <stdint.h>
#include <stdio.h>
namespace cg = cooperative_groups;

#ifndef PER_PHASE_LAUNCH
#define PER_PHASE_LAUNCH 0
#endif

#define DI __device__ __forceinline__
DI int otid() { int t = threadIdx.x; asm volatile("" : "+v"(t)); return t; }
typedef unsigned short bf16_t;
using bf16x8 = __attribute__((ext_vector_type(8))) short;
using f32x16 = __attribute__((ext_vector_type(16))) float;
using f32x4  = __attribute__((ext_vector_type(4))) float;
using f32x2  = __attribute__((ext_vector_type(2))) float;
using u32x4  = __attribute__((ext_vector_type(4))) unsigned;
using u32x2  = __attribute__((ext_vector_type(2))) unsigned;
typedef __bf16 bf16x2_t __attribute__((ext_vector_type(2)));

constexpr int NB = 16, SEQ = 2048, CL = 256, T = 2304, D = 1024, M = NB * T, NIN = 2656, NINP = 2816;
constexpr int O_CQ = 0, O_CKV = 192, O_KR = 320, O_GA = 352, O_Q2 = 608, O_K2 = 864, O_V2 = 992, O_GB = 1120,
              O_U = 1376, O_V = 1632, O_GC = 1888, O_F = 2144, O_GD = 2400;
constexpr int NTHR = 512;
constexpr int HALF_LDS = 69632, LDS_MAIN = 2 * HALF_LDS, LDS_BYTES = LDS_MAIN + 256;

constexpr size_t al256(size_t x) { return (x + 255) & ~(size_t)255; }
constexpr size_t WS_MOD  = 0;
constexpr size_t WS_ROPG = al256(WS_MOD + 2 * 17 * 3072 * 4);
constexpr size_t WS_ROPM = al256(WS_ROPG + 64 * 16 * 2 * 4);
constexpr size_t WS_SBND = al256(WS_ROPM + 64 * 8 * 2 * 4);
constexpr size_t WS_WIN  = al256(WS_SBND + 256);
constexpr size_t WS_WUQ  = al256(WS_WIN + (size_t)2 * NINP * 1024 * 2);
constexpr size_t WS_WUKV = al256(WS_WUQ + 2 * 384 * 192 * 2);
constexpr size_t WS_WF   = al256(WS_WUKV + 2 * 512 * 128 * 2);
constexpr size_t WS_WOUT = al256(WS_WF + 2 * 256 * 256 * 2);
constexpr size_t WS_WS   = al256(WS_WOUT + (size_t)2 * 1024 * 1024 * 2);
constexpr size_t WS_CM   = al256(WS_WS + 2 * 4 * 128 * 128 * 2);
constexpr size_t WS_DLAT = al256(WS_CM + 128 * 64 * 2);
constexpr size_t WS_DCTX = al256(WS_DLAT + (size_t)2048 * 2048 * 2);
constexpr size_t WS_R1   = al256(WS_DCTX + 256 * 512 * 2);
constexpr size_t R1_CQN = 0, R1_CKVN = (size_t)M * 192 * 2, R1_Q1R = R1_CKVN + (size_t)M * 128 * 2, R1_KR = R1_Q1R + (size_t)M * 384 * 2;
constexpr size_t WS_P    = al256(WS_R1 + (size_t)M * 1024 * 2);
constexpr size_t WS_FT   = al256(WS_P + (size_t)M * NIN * 2);
constexpr size_t WS_FTF  = al256(WS_FT + (size_t)NB * 256 * 4096 * 2);
constexpr size_t WS_FTC  = al256(WS_FTF + (size_t)NB * 256 * 2048 * 2);
constexpr size_t WS_YD   = al256(WS_FTC + (size_t)NB * 256 * 512 * 2);
constexpr size_t WS_QA   = al256(WS_YD + (size_t)M * 256 * 2);
constexpr size_t WS_KA   = al256(WS_QA + (size_t)M * 384 * 2);
constexpr size_t WS_VAT  = al256(WS_KA + (size_t)M * 384 * 2);
constexpr size_t WS_QB   = al256(WS_VAT + (size_t)M * 256 * 2);
constexpr size_t WS_KB   = al256(WS_QB + (size_t)M * 256 * 2);
constexpr size_t WS_VBT  = al256(WS_KB + (size_t)M * 128 * 2);
constexpr size_t WS_VNT  = al256(WS_VBT + (size_t)M * 128 * 2);
constexpr size_t WS_CTX1 = al256(WS_VNT + (size_t)M * 256 * 2 + 65536);
constexpr size_t WS_BAR  = al256(WS_CTX1 + (size_t)NB * CL * 1024 * 4);
constexpr size_t WS_CNT  = al256(WS_BAR + 3456 * 4);
constexpr size_t WS_END  = al256(WS_CNT + 2 * 288 * 4);
constexpr size_t WS_ZERO_BYTES = WS_END - WS_BAR;
static_assert(R1_KR + (size_t)M * 256 * 2 <= (size_t)M * 1024 * 2, "temp region");
static_assert(WS_END <= (size_t)512 * 1024 * 1024, "workspace");

struct Params {
  const float *x, *c, *ctx, *c_ctx, *norm_g, *w_mod, *b_mod, *w_in, *mla_q_norm, *mla_w_uq, *mla_kv_norm, *mla_w_ukv,
              *mla_qn, *mla_kn, *gqa_qn, *gqa_kn, *cm_ln_g, *cm_ln_b, *cm_w_s, *cm_b_s, *fnet_w, *w_out;
  float* out; unsigned char* ws; int ph_lo, ph_hi;
};
typedef const __attribute__((address_space(4))) Params* KP;

DI unsigned cvtpk(float lo, float hi) { f32x2 v = {lo, hi}; bf16x2_t b = __builtin_convertvector(v, bf16x2_t); return __builtin_bit_cast(unsigned, b); }
DI float bflo(unsigned u) { return __uint_as_float(u << 16); }
DI float bfhi(unsigned u) { return __uint_as_float(u & 0xffff0000u); }
DI bf16_t f2bf(float f) { return (bf16_t)(cvtpk(f, 0.f) & 0xffffu); }
DI float silu(float x) { return x / (1.f + __expf(-x)); }
DI f32x4 unpack4(u32x2 v) { f32x4 r = {bflo(v.x), bfhi(v.x), bflo(v.y), bfhi(v.y)}; return r; }
DI u32x2 pack4(f32x4 v) { u32x2 r = {cvtpk(v[0], v[1]), cvtpk(v[2], v[3])}; return r; }
DI float dpp_f(float v, const int ctrl_sel) {
  const int i = __float_as_int(v); int r;
  if (ctrl_sel == 0) r = __builtin_amdgcn_update_dpp(0, i, 0xB1, 0xF, 0xF, true);
  else if (ctrl_sel == 1) r = __builtin_amdgcn_update_dpp(0, i, 0x4E, 0xF, 0xF, true);
  else if (ctrl_sel == 2) r = __builtin_amdgcn_update_dpp(0, i, 0x124, 0xF, 0xF, true);
  else r = __builtin_amdgcn_update_dpp(0, i, 0x128, 0xF, 0xF, true);
  return __int_as_float(r);
}
DI float red16(float v) { v += dpp_f(v, 0); v += dpp_f(v, 1); v += dpp_f(v, 2); v += dpp_f(v, 3); return v; }
DI float red64(float v) { v = red16(v); v += __shfl_xor(v, 16); v += __shfl_xor(v, 32); return v; }
#define MFMA32(a, b, c) __builtin_amdgcn_mfma_f32_32x32x16_bf16((a), (b), (c), 0, 0, 0)


#define XB_TMO      128
#define XB_XCNT(j)  (256  + 64 * (j))
#define XB_XSUB(j)  (1280 + 64 * (j))
#define XB_XGEN(j)  (2304 + 64 * (j))
#define XB_TOP      3328
#define XB_TOPGEN   3392
#define XCD_BAR_WORDS 3456
#define XB_SPIN_CAP (1u << 22)
#define LAS __attribute__((address_space(3)))
DI unsigned xb_ld(unsigned* p)              { return __hip_atomic_load(p, __ATOMIC_RELAXED, __HIP_MEMORY_SCOPE_AGENT); }
DI unsigned xb_add(unsigned* p, unsigned v) { return __hip_atomic_fetch_add(p, v, __ATOMIC_RELAXED, __HIP_MEMORY_SCOPE_AGENT); }
DI unsigned xb_xcc_id() { return (unsigned)__builtin_amdgcn_s_getreg((3 << 11) | 20) & 0xFu; }
#define XB_SPIN(cond, bar) do { unsigned _sp = 0; while (cond) { __builtin_amdgcn_s_sleep(1); \
    if ((++_sp & 255u) == 0u) { if (xb_ld(&(bar)[XB_TMO])) break; if (_sp > XB_SPIN_CAP) { atomicAdd(&(bar)[XB_TMO], 1u); break; } } } } while (0)
struct XcdBarrier { unsigned* bar; unsigned x; volatile LAS unsigned* st; };
DI XcdBarrier xcd_barrier_post(unsigned* bar, volatile LAS unsigned* st) {
  XcdBarrier b; b.bar = bar; b.x = xb_xcc_id(); b.st = st;
  if (threadIdx.x == 0) (void)xb_add(&bar[XB_XCNT(b.x)], 1u);
  return b;
}
DI void xcd_barrier_complete(unsigned* bar, unsigned x, unsigned& nloc, unsigned& nx) {
  const unsigned G = gridDim.x * gridDim.y * gridDim.z;
  unsigned sum, cnt, mine, sp = 0u;
  for (;;) {
    sum = 0u; cnt = 0u; mine = 0u;
#pragma unroll
    for (unsigned j = 0; j < 16; ++j) { const unsigned c = xb_ld(&bar[XB_XCNT(j)]); sum += c; cnt += (c > 0u) ? 1u : 0u; mine = (j == x) ? c : mine; }
    if (sum == G) break;
    __builtin_amdgcn_s_sleep(1);
    if ((++sp & 255u) == 0u) { if (xb_ld(&bar[XB_TMO])) break; if (sp > XB_SPIN_CAP) { atomicAdd(&bar[XB_TMO], 1u); break; } }
  }
  nloc = mine > 0u ? mine : 1u; nx = cnt > 0u ? cnt : 1u;
}
DI void xcd_barrier(const XcdBarrier& b) {
  asm volatile("s_waitcnt vmcnt(0)" ::: "memory");
  __syncthreads();
  if (threadIdx.x == 0) {
    unsigned* bar = b.bar;
    __builtin_amdgcn_s_waitcnt(0);
    unsigned nloc = b.st[0], nx = b.st[1];
    if (nloc == 0u) { xcd_barrier_complete(bar, b.x, nloc, nx); b.st[0] = nloc; b.st[1] = nx; }
    const unsigned old = xb_add(&bar[XB_XSUB(b.x)], 1u);
    const unsigned gen = old / nloc;
    if (old + 1u == (gen + 1u) * nloc) {
      __builtin_amdgcn_fence(__ATOMIC_RELEASE, "agent");
      asm volatile("s_waitcnt vmcnt(0)" ::: "memory");
      const unsigned og = xb_add(&bar[XB_TOP], 1u);
      const unsigned tg = og / nx;
      if (og + 1u == (tg + 1u) * nx) xb_add(&bar[XB_TOPGEN], 1u);
      else XB_SPIN(xb_ld(&bar[XB_TOPGEN]) == tg, bar);
      __builtin_amdgcn_fence(__ATOMIC_ACQUIRE, "agent");
      xb_add(&bar[XB_XGEN(b.x)], 1u);
      asm volatile("s_waitcnt vmcnt(0)" ::: "memory");
    } else {
      XB_SPIN(xb_ld(&bar[XB_XGEN(b.x)]) == gen, bar);
      __builtin_amdgcn_fence(__ATOMIC_ACQUIRE, "agent");
      asm volatile("s_waitcnt vmcnt(0)" ::: "memory");
    }
  }
  __syncthreads();
}

template <class Epi>
DI void gemm_tile(const bf16_t* __restrict__ A, int lda, const bf16_t* __restrict__ Bt, int ldb, int K, char* lds, Epi epi) {
  const int tid_full = otid(); const int tid = tid_full & 255; lds += (tid_full >> 8) * HALF_LDS;
  const int lane = tid & 63, w = tid >> 6, l31 = lane & 31, h = lane >> 5;
  const int wr = w >> 1, wc = w & 1;
  const int lrow = tid >> 3, lch = (tid & 7) ^ ((tid >> 4) & 7);
  const bf16_t* ag = A + (size_t)lrow * lda + lch * 8;
  const bf16_t* bg = Bt + (size_t)lrow * ldb + lch * 8;
  const size_t a32 = (size_t)32 * lda, b32 = (size_t)32 * ldb;
  f32x16 acc[2][2];
#pragma unroll
  for (int i = 0; i < 2; ++i)
#pragma unroll
    for (int j = 0; j < 2; ++j)
#pragma unroll
      for (int e = 0; e < 16; ++e) acc[i][j][e] = 0.f;
  const int nk = K >> 6;
  const int rsw = (l31 >> 1) & 7;
  const int aoff = (wr * 64 + l31) * 128, boff = 16384 + (wc * 64 + l31) * 128;
  char* ldst = lds + tid * 16;
#define G_DMA(BUF, KT) { const int ko_ = (KT) * 64; char* nb_ = ldst + (BUF) * 32768; _Pragma("unroll") for (int i = 0; i < 4; ++i) { \
    __builtin_amdgcn_global_load_lds((const unsigned*)(ag + i * a32 + ko_), (__attribute__((address_space(3))) unsigned*)(nb_ + i * 4096), 16, 0, 0); \
    __builtin_amdgcn_global_load_lds((const unsigned*)(bg + i * b32 + ko_), (__attribute__((address_space(3))) unsigned*)(nb_ + 16384 + i * 4096), 16, 0, 0); } }
#define G_COMPUTE(BUF) { const char* cur = lds + (BUF) * 32768; bf16x8 af[2][2], bf[2][2]; \
    { const int off = ((0 + h) ^ rsw) << 4; _Pragma("unroll") for (int i = 0; i < 2; ++i) { af[0][i] = *(const bf16x8*)(cur + aoff + i * 4096 + off); bf[0][i] = *(const bf16x8*)(cur + boff + i * 4096 + off); } } \
    _Pragma("unroll") for (int ks = 0; ks < 4; ++ks) { \
      if (ks < 3) { const int off = ((2 * (ks + 1) + h) ^ rsw) << 4; _Pragma("unroll") for (int i = 0; i < 2; ++i) { af[(ks + 1) & 1][i] = *(const bf16x8*)(cur + aoff + i * 4096 + off); bf[(ks + 1) & 1][i] = *(const bf16x8*)(cur + boff + i * 4096 + off); } } \
      _Pragma("unroll") for (int i = 0; i < 2; ++i) _Pragma("unroll") for (int j = 0; j < 2; ++j) acc[i][j] = MFMA32(bf[ks & 1][j], af[ks & 1][i], acc[i][j]); } }
#define G_WAIT() { asm volatile("s_waitcnt vmcnt(0)" ::: "memory"); __syncthreads(); }
  G_DMA(0, 0);
  G_WAIT();
  for (int kt = 0; kt < nk; kt += 2) {
    if (kt + 1 < nk) G_DMA(1, kt + 1);
    G_COMPUTE(0);
    G_WAIT();
    if (kt + 1 < nk) {
      if (kt + 2 < nk) G_DMA(0, kt + 2);
      G_COMPUTE(1);
      G_WAIT();
    }
  }
#undef G_DMA
#undef G_COMPUTE
#undef G_WAIT
  float* ct = (float*)lds;
#pragma unroll
  for (int i = 0; i < 2; ++i)
#pragma unroll
    for (int j = 0; j < 2; ++j)
#pragma unroll
      for (int q = 0; q < 4; ++q) {
        f32x4 v = {acc[i][j][4 * q], acc[i][j][4 * q + 1], acc[i][j][4 * q + 2], acc[i][j][4 * q + 3]};
        *(f32x4*)(ct + (wr * 64 + i * 32 + l31) * 132 + wc * 64 + j * 32 + 8 * q + 4 * h) = v;
      }
  __syncthreads();
#pragma unroll 4
  for (int it = 0; it < 16; ++it) {
    const int idx = it * 256 + tid; const int row = idx >> 5, c4 = (idx & 31) * 4;
    f32x4 v = *(const f32x4*)(ct + row * 132 + c4);
    epi(row, c4, v);
  }
  __syncthreads();
}


DI int g8_lds_byte(int r, int c) { int st = (r >> 4) * 2 + (c >> 5), rr = r & 15, cc = c & 31, ob = rr * 64 + cc * 2; return st * 1024 + (ob ^ (((ob >> 9) & 1) << 5)); }
DI void g8_stage_rc(int b, int& R, int& C) { int st = b / 1024, sb = b % 1024, swz = sb ^ (((sb >> 9) & 1) << 5); R = (st >> 1) * 16 + swz / 64; C = (st & 1) * 32 + (swz % 64) / 2; }
template <class Epi>
DI void gemm256(const bf16_t* __restrict__ A, int lda, const bf16_t* __restrict__ Bt, int ldb, int K, char* lds, Epi epi) {
  constexpr int BK = 64, HALFR = 128, HTB = HALFR * BK * 2;
  const int tid = otid();
  const int wid = tid >> 6, lane = tid & 63, wr = wid >> 2, wc = wid & 3, fr = lane & 15, fq = lane >> 4;
  const int obs = (fr * 64 + fq * 16) ^ ((((fr * 64 + fq * 16) >> 9) & 1) << 5);
  const char* lrda = lds + wr * 8192 + obs; const char* lrdb = lds + 4 * HTB + wc * 4096 + obs;
  int sr0, sc0, sr1, sc1; g8_stage_rc(tid * 16, sr0, sc0); g8_stage_rc(tid * 16 + 8192, sr1, sc1);
  const unsigned oa0 = (unsigned)(sr0 * lda + sc0) * 2u, oa1 = (unsigned)(sr1 * lda + sc1) * 2u;
#define ob0 oa0
#define ob1 oa1
#define SA8(b, h) (lds + ((b) * 2 + (h)) * HTB)
#define SB8(b, h) (lds + (4 + (b) * 2 + (h)) * HTB)
#define STAGE_A(Pp, br, kt) { const char* g_ = (const char*)(A + (size_t)(br) * lda + (size_t)(kt) * BK); \
    __builtin_amdgcn_global_load_lds((const unsigned*)(g_ + oa0), (LAS unsigned*)((Pp) + tid * 16), 16, 0, 0); \
    __builtin_amdgcn_global_load_lds((const unsigned*)(g_ + oa1), (LAS unsigned*)((Pp) + tid * 16 + 8192), 16, 0, 0); }
#define STAGE_B(Pp, br, kt) { const char* g_ = (const char*)(Bt + (size_t)(br) * ldb + (size_t)(kt) * BK); \
    __builtin_amdgcn_global_load_lds((const unsigned*)(g_ + ob0), (LAS unsigned*)((Pp) + tid * 16), 16, 0, 0); \
    __builtin_amdgcn_global_load_lds((const unsigned*)(g_ + ob1), (LAS unsigned*)((Pp) + tid * 16 + 8192), 16, 0, 0); }
#define LDA8(dst, b, h) _Pragma("unroll") for (int m = 0; m < 4; ++m) _Pragma("unroll") for (int k = 0; k < 2; ++k) \
    dst[m][k] = *(const bf16x8*)(lrda + ((b) * 2 + (h)) * HTB + (2 * m + k) * 1024)
#define LDB8(dst, b, h) _Pragma("unroll") for (int n = 0; n < 2; ++n) _Pragma("unroll") for (int k = 0; k < 2; ++k) \
    dst[n][k] = *(const bf16x8*)(lrdb + ((b) * 2 + (h)) * HTB + (2 * n + k) * 1024)
#define MMA8(ai, bj, AT, BT) { __builtin_amdgcn_s_setprio(1); \
    _Pragma("unroll") for (int m = 0; m < 4; ++m) _Pragma("unroll") for (int n = 0; n < 2; ++n) _Pragma("unroll") for (int k = 0; k < 2; ++k) \
      acc[ai][bj][m][n] = __builtin_amdgcn_mfma_f32_16x16x32_bf16(AT[m][k], BT[n][k], acc[ai][bj][m][n], 0, 0, 0); \
    __builtin_amdgcn_s_setprio(0); }
#define WAIT_V(n) asm volatile("s_waitcnt vmcnt(" #n ")" ::: "memory")
#define WAIT_L(n) asm volatile("s_waitcnt lgkmcnt(" #n ")" ::: "memory")
#define BAR8 __builtin_amdgcn_s_barrier()
#define SCHED8 __builtin_amdgcn_sched_barrier(0)
  f32x4 acc[2][2][4][2];
#pragma unroll
  for (int a = 0; a < 2; ++a)
#pragma unroll
    for (int b = 0; b < 2; ++b)
#pragma unroll
      for (int m = 0; m < 4; ++m)
#pragma unroll
        for (int n = 0; n < 2; ++n) { f32x4 z = {0.f, 0.f, 0.f, 0.f}; acc[a][b][m][n] = z; }
  bf16x8 At[4][2], B0[2][2], B1[2][2];
  const int nt = K / BK;
  WAIT_V(0);
  __syncthreads();
  STAGE_B(SB8(0, 0), 0, 0); STAGE_A(SA8(0, 0), 0, 0);
  STAGE_B(SB8(0, 1), HALFR, 0); STAGE_A(SA8(0, 1), HALFR, 0);
  if (wr == 1) BAR8;
  WAIT_V(4); BAR8;
  STAGE_B(SB8(1, 0), 0, 1); STAGE_A(SA8(1, 0), 0, 1); STAGE_B(SB8(1, 1), HALFR, 1);
  WAIT_V(6); BAR8;
  for (int t = 0; t < nt - 2; t += 2) {
    LDB8(B0, 0, 0); SCHED8; LDA8(At, 0, 0); STAGE_A(SA8(1, 1), HALFR, t + 1);
    WAIT_L(8); BAR8; WAIT_L(0); MMA8(0, 0, At, B0); BAR8; SCHED8;
    LDB8(B1, 0, 1); STAGE_B(SB8(0, 0), 0, t + 2);
    BAR8; WAIT_L(0); MMA8(0, 1, At, B1); BAR8;
    LDA8(At, 0, 1); STAGE_A(SA8(0, 0), 0, t + 2);
    BAR8; WAIT_L(0); MMA8(1, 0, At, B0); BAR8; SCHED8;
    STAGE_B(SB8(0, 1), HALFR, t + 2);
    WAIT_V(6); BAR8; MMA8(1, 1, At, B1); BAR8;
    LDB8(B0, 1, 0); SCHED8; LDA8(At, 1, 0); STAGE_A(SA8(0, 1), HALFR, t + 2);
    WAIT_L(8); BAR8; WAIT_L(0); MMA8(0, 0, At, B0); BAR8; SCHED8;
    LDB8(B1, 1, 1); STAGE_B(SB8(1, 0), 0, t + 3);
    BAR8; WAIT_L(0); MMA8(0, 1, At, B1); BAR8;
    LDA8(At, 1, 1); STAGE_A(SA8(1, 0), 0, t + 3);
    BAR8; WAIT_L(0); MMA8(1, 0, At, B0); BAR8; SCHED8;
    STAGE_B(SB8(1, 1), HALFR, t + 3);
    WAIT_V(6); BAR8; MMA8(1, 1, At, B1); BAR8;
  }
  { LDB8(B0, 0, 0); LDA8(At, 0, 0); STAGE_A(SA8(1, 1), HALFR, nt - 1);
    BAR8; WAIT_L(0); MMA8(0, 0, At, B0); BAR8;
    LDB8(B1, 0, 1); BAR8; WAIT_L(0); MMA8(0, 1, At, B1); BAR8;
    LDA8(At, 0, 1); WAIT_V(4); BAR8; WAIT_L(0); MMA8(1, 0, At, B0); MMA8(1, 1, At, B1); BAR8; }
  { LDB8(B0, 1, 0); LDA8(At, 1, 0); WAIT_V(2); BAR8; WAIT_L(0); MMA8(0, 0, At, B0); BAR8;
    LDB8(B1, 1, 1); WAIT_V(0); BAR8; WAIT_L(0); MMA8(0, 1, At, B1); BAR8;
    LDA8(At, 1, 1); BAR8; WAIT_L(0); MMA8(1, 0, At, B0); MMA8(1, 1, At, B1); BAR8; }
  if (wr == 0) BAR8;
  float* ct = (float*)lds;
#pragma unroll
  for (int ai = 0; ai < 2; ++ai) {
    __syncthreads();
#pragma unroll
    for (int bj = 0; bj < 2; ++bj)
#pragma unroll
      for (int m = 0; m < 4; ++m)
#pragma unroll
        for (int n = 0; n < 2; ++n)
#pragma unroll
          for (int j = 0; j < 4; ++j) ct[(wr * 64 + m * 16 + fq * 4 + j) * 260 + bj * 128 + wc * 32 + n * 16 + fr] = acc[ai][bj][m][n][j];
    __syncthreads();
#pragma unroll 2
    for (int it = 0; it < 16; ++it) {
      const int idx = it * NTHR + tid; const int row = idx >> 6, c4 = (idx & 63) * 4;
      f32x4 v = *(const f32x4*)(ct + row * 260 + c4);
      epi(ai * 128 + row, c4, v);
    }
  }
  __syncthreads();
#undef ob0
#undef ob1
#undef SA8
#undef SB8
#undef STAGE_A
#undef STAGE_B
#undef LDA8
#undef LDB8
#undef MMA8
#undef WAIT_V
#undef WAIT_L
#undef BAR8
#undef SCHED8
}

template <int DQK, bool STATIC>
DI void attn_item(const bf16_t* __restrict__ Q, const bf16_t* __restrict__ Kp, const bf16_t* __restrict__ Vt, int nkeys, char* lds,
                  const bf16_t* __restrict__ Pg, bf16_t* __restrict__ Yg  , float mfix) {
  constexpr int KSTR = DQK * 2 + 16, VSTR = 136, KCH = DQK / 8, NKC = (64 * KCH) / 256, NQS = DQK / 16;
  constexpr int KBUF = 64 * KSTR, BUF = KBUF + 64 * VSTR;
  const int tid_full = otid(); const int tid = tid_full & 255; lds += (tid_full >> 8) * HALF_LDS;
  const int lane = tid & 63, w = tid >> 6, l31 = lane & 31, h = lane >> 5;
  bf16x8 qf[NQS];
#pragma unroll
  for (int ks = 0; ks < NQS; ++ks) qf[ks] = *(const bf16x8*)(Q + (size_t)(32 * w + l31) * DQK + 16 * ks + 8 * h);
  f32x16 o[2];
#pragma unroll
  for (int d = 0; d < 2; ++d)
#pragma unroll
    for (int e = 0; e < 16; ++e) o[d][e] = 0.f;
  float m_run = STATIC ? mfix : -1e30f, l_run = 0.f;
  u32x4 rk[NKC], rv[2];
  int koffg[NKC], koffl[NKC];
#pragma unroll
  for (int i = 0; i < NKC; ++i) { const int c = tid + 256 * i; const int key = c / KCH, part = c % KCH; koffg[i] = c * 8; koffl[i] = key * KSTR + part * 16; }
  const int vdv0 = tid >> 3, vpart = tid & 7;
  const bf16_t* vg = Vt + (size_t)vdv0 * T + vpart * 8;
  const int voffl = KBUF + vdv0 * VSTR + vpart * 16;
  const int nt = nkeys >> 6;
#pragma unroll
  for (int i = 0; i < NKC; ++i) rk[i] = *(const u32x4*)(Kp + koffg[i]);
#pragma unroll
  for (int i = 0; i < 2; ++i) rv[i] = *(const u32x4*)(vg + (size_t)i * 32 * T);
#pragma unroll
  for (int i = 0; i < NKC; ++i) *(u32x4*)(lds + koffl[i]) = rk[i];
#pragma unroll
  for (int i = 0; i < 2; ++i) { u32x2 a = {rv[i].x, rv[i].y}, b = {rv[i].z, rv[i].w}; *(u32x2*)(lds + voffl + i * 32 * VSTR) = a; *(u32x2*)(lds + voffl + i * 32 * VSTR + 8) = b; }
  __syncthreads();
  for (int j = 0; j < nt; ++j) {
    char* cur = lds + (j & 1) * BUF;
    const bool more = (j + 1 < nt);
    if (more) {
#pragma unroll
      for (int i = 0; i < NKC; ++i) rk[i] = *(const u32x4*)(Kp + (size_t)(j + 1) * 64 * DQK + koffg[i]);
#pragma unroll
      for (int i = 0; i < 2; ++i) rv[i] = *(const u32x4*)(vg + (size_t)i * 32 * T + (j + 1) * 64);
    }
    f32x16 s0, s1;
    bf16x8 kf[2][NQS];
#pragma unroll
    for (int kb = 0; kb < 2; ++kb)
#pragma unroll
      for (int ks = 0; ks < NQS; ++ks) kf[kb][ks] = *(const bf16x8*)(cur + (32 * kb + l31) * KSTR + (2 * ks + h) * 16);
    u32x4 vw[2][2][2];
#pragma unroll
    for (int kb = 0; kb < 2; ++kb)
#pragma unroll
      for (int s2 = 0; s2 < 2; ++s2)
#pragma unroll
        for (int d = 0; d < 2; ++d) {
          const char* vp = cur + KBUF + (32 * d + l31) * VSTR + (32 * kb + 16 * s2 + 4 * h) * 2;
          u32x2 v0 = *(const u32x2*)vp, v1 = *(const u32x2*)(vp + 16);
          u32x4 t4 = {v0.x, v0.y, v1.x, v1.y}; vw[kb][s2][d] = t4;
        }
#pragma unroll
    for (int e = 0; e < 16; ++e) { s0[e] = STATIC ? -mfix : 0.f; s1[e] = STATIC ? -mfix : 0.f; }
#pragma unroll
    for (int ks = 0; ks < NQS; ++ks) s0 = MFMA32(kf[0][ks], qf[ks], s0);
    if (!STATIC) {
      float mx = s0[0];
#pragma unroll
      for (int e = 1; e < 16; ++e) mx = fmaxf(mx, s0[e]);
      mx = fmaxf(mx, __shfl_xor(mx, 32));
      if (!__all(mx <= m_run + 8.f)) {
        const float m_new = fmaxf(m_run, mx);
        const float alpha = __builtin_amdgcn_exp2f(m_run - m_new);
        m_run = m_new; l_run *= alpha;
#pragma unroll
        for (int d = 0; d < 2; ++d)
#pragma unroll
          for (int e = 0; e < 16; ++e) o[d][e] *= alpha;
      }
    }
#pragma unroll
    for (int ks = 0; ks < NQS; ++ks) s1 = MFMA32(kf[1][ks], qf[ks], s1);
    {
      float ps = 0.f;
#pragma unroll
      for (int e = 0; e < 16; ++e) { float p = STATIC ? __builtin_amdgcn_exp2f(s0[e]) : __builtin_amdgcn_exp2f(s0[e] - m_run); s0[e] = p; ps += p; }
      l_run += ps;
    }
    if (!STATIC) {
      float mx = s1[0];
#pragma unroll
      for (int e = 1; e < 16; ++e) mx = fmaxf(mx, s1[e]);
      mx = fmaxf(mx, __shfl_xor(mx, 32));
      if (!__all(mx <= m_run + 8.f)) {
        const float m_new = fmaxf(m_run, mx);
        const float alpha = __builtin_amdgcn_exp2f(m_run - m_new);
        m_run = m_new; l_run *= alpha;
#pragma unroll
        for (int e = 0; e < 16; ++e) s0[e] *= alpha;
#pragma unroll
        for (int d = 0; d < 2; ++d)
#pragma unroll
          for (int e = 0; e < 16; ++e) o[d][e] *= alpha;
      }
    }
#pragma unroll
    for (int s2 = 0; s2 < 2; ++s2) {
      u32x4 pw = {cvtpk(s0[8 * s2], s0[8 * s2 + 1]), cvtpk(s0[8 * s2 + 2], s0[8 * s2 + 3]), cvtpk(s0[8 * s2 + 4], s0[8 * s2 + 5]), cvtpk(s0[8 * s2 + 6], s0[8 * s2 + 7])};
      bf16x8 pf = __builtin_bit_cast(bf16x8, pw);
#pragma unroll
      for (int d = 0; d < 2; ++d) o[d] = MFMA32(__builtin_bit_cast(bf16x8, vw[0][s2][d]), pf, o[d]);
    }
    {
      float ps = 0.f;
#pragma unroll
      for (int e = 0; e < 16; ++e) { float p = STATIC ? __builtin_amdgcn_exp2f(s1[e]) : __builtin_amdgcn_exp2f(s1[e] - m_run); s1[e] = p; ps += p; }
      l_run += ps;
    }
#pragma unroll
    for (int s2 = 0; s2 < 2; ++s2) {
      u32x4 pw = {cvtpk(s1[8 * s2], s1[8 * s2 + 1]), cvtpk(s1[8 * s2 + 2], s1[8 * s2 + 3]), cvtpk(s1[8 * s2 + 4], s1[8 * s2 + 5]), cvtpk(s1[8 * s2 + 6], s1[8 * s2 + 7])};
      bf16x8 pf = __builtin_bit_cast(bf16x8, pw);
#pragma unroll
      for (int d = 0; d < 2; ++d) o[d] = MFMA32(__builtin_bit_cast(bf16x8, vw[1][s2][d]), pf, o[d]);
    }
    if (more) {
      char* nxt = lds + ((j + 1) & 1) * BUF;
#pragma unroll
      for (int i = 0; i < NKC; ++i) *(u32x4*)(nxt + koffl[i]) = rk[i];
#pragma unroll
      for (int i = 0; i < 2; ++i) { u32x2 a = {rv[i].x, rv[i].y}, b = {rv[i].z, rv[i].w}; *(u32x2*)(nxt + voffl + i * 32 * VSTR) = a; *(u32x2*)(nxt + voffl + i * 32 * VSTR + 8) = b; }
    }
    __syncthreads();
  }
  const float lt = l_run + __shfl_xor(l_run, 32);
  const float inv = 1.f / lt;
  const size_t rq = (size_t)(32 * w + l31);
#pragma unroll
  for (int d = 0; d < 2; ++d)
#pragma unroll
    for (int q = 0; q < 4; ++q) {
      const int dv = 32 * d + 8 * q + 4 * h;
      f32x4 g = unpack4(*(const u32x2*)(Pg + rq * NIN + dv));
      f32x4 v = {o[d][4 * q] * inv * silu(g[0]), o[d][4 * q + 1] * inv * silu(g[1]), o[d][4 * q + 2] * inv * silu(g[2]), o[d][4 * q + 3] * inv * silu(g[3])};
      *(u32x2*)(Yg + rq * 1024 + dv) = pack4(v);
    }
}

template <int DQK, bool STATIC>
DI void attn_item8(const bf16_t* __restrict__ Q, const bf16_t* __restrict__ Kp, const bf16_t* __restrict__ Vt, int nkeys, char* lds,
                  const bf16_t* __restrict__ Pg, bf16_t* __restrict__ Yg  , float mfix) {
  constexpr int KSTR = DQK * 2 + 16, VSTR = 136, KCH = DQK / 8, NKC = (64 * KCH + 511) / 512, NQS = DQK / 16;
  constexpr int KBUF = 64 * KSTR, BUF = KBUF + 64 * VSTR;
  const int tid = otid();
  const int lane = tid & 63, w = tid >> 6, l31 = lane & 31, h = lane >> 5;
  bf16x8 qf[NQS];
#pragma unroll
  for (int ks = 0; ks < NQS; ++ks) qf[ks] = *(const bf16x8*)(Q + (size_t)(32 * w + l31) * DQK + 16 * ks + 8 * h);
  f32x16 o[2];
#pragma unroll
  for (int d = 0; d < 2; ++d)
#pragma unroll
    for (int e = 0; e < 16; ++e) o[d][e] = 0.f;
  float m_run = STATIC ? mfix : -1e30f, l_run = 0.f;
  u32x4 rk[NKC], rv[1];
  int koffg[NKC], koffl[NKC];
#pragma unroll
  for (int i = 0; i < NKC; ++i) { const int c = tid + 512 * i; const int key = c / KCH, part = c % KCH; koffg[i] = (c < 64 * KCH) ? c * 8 : 0; koffl[i] = (c < 64 * KCH) ? key * KSTR + part * 16 : -1; }
  const int vdv0 = tid >> 3, vpart = tid & 7;
  const bf16_t* vg = Vt + (size_t)vdv0 * T + vpart * 8;
  const int voffl = KBUF + vdv0 * VSTR + vpart * 16;
  const int nt = nkeys >> 6;
#pragma unroll
  for (int i = 0; i < NKC; ++i) rk[i] = *(const u32x4*)(Kp + koffg[i]);
#pragma unroll
  for (int i = 0; i < 1; ++i) rv[i] = *(const u32x4*)(vg + (size_t)i * 32 * T);
#pragma unroll
  for (int i = 0; i < NKC; ++i) if (koffl[i] >= 0) *(u32x4*)(lds + koffl[i]) = rk[i];
#pragma unroll
  for (int i = 0; i < 1; ++i) { u32x2 a = {rv[i].x, rv[i].y}, b = {rv[i].z, rv[i].w}; *(u32x2*)(lds + voffl + i * 32 * VSTR) = a; *(u32x2*)(lds + voffl + i * 32 * VSTR + 8) = b; }
  {
#pragma unroll
    for (int i = 0; i < NKC; ++i) rk[i] = *(const u32x4*)(Kp + (size_t)64 * DQK + koffg[i]);
    rv[0] = *(const u32x4*)(vg + 64);
#pragma unroll
    for (int i = 0; i < NKC; ++i) if (koffl[i] >= 0) *(u32x4*)(lds + BUF + koffl[i]) = rk[i];
    { u32x2 a = {rv[0].x, rv[0].y}, b = {rv[0].z, rv[0].w}; *(u32x2*)(lds + BUF + voffl) = a; *(u32x2*)(lds + BUF + voffl + 8) = b; }
  }
  __syncthreads();
  const int np = nt >> 1;
  for (int jj = 0; jj < np; ++jj) {
   char* curp = lds + (jj & 1) * 2 * BUF; char* nxtp = lds + ((jj + 1) & 1) * 2 * BUF;
   const bool more = (jj + 1 < np);
#pragma nounroll
   for (int sub = 0; sub < 2; ++sub) {
    const char* cur = curp + sub * BUF;
    const int j = 2 * jj + sub + 1;
    if (more) {
#pragma unroll
      for (int i = 0; i < NKC; ++i) rk[i] = *(const u32x4*)(Kp + (size_t)(j + 1) * 64 * DQK + koffg[i]);
#pragma unroll
      for (int i = 0; i < 1; ++i) rv[i] = *(const u32x4*)(vg + (size_t)i * 32 * T + (j + 1) * 64);
    }
    f32x16 s0, s1;
    bf16x8 kf[2][NQS];
#pragma unroll
    for (int kb = 0; kb < 2; ++kb)
#pragma unroll
      for (int ks = 0; ks < NQS; ++ks) kf[kb][ks] = *(const bf16x8*)(cur + (32 * kb + l31) * KSTR + (2 * ks + h) * 16);
    u32x4 vw[2][2][2];
#pragma unroll
    for (int kb = 0; kb < 2; ++kb)
#pragma unroll
      for (int s2 = 0; s2 < 2; ++s2)
#pragma unroll
        for (int d = 0; d < 2; ++d) {
          const char* vp = cur + KBUF + (32 * d + l31) * VSTR + (32 * kb + 16 * s2 + 4 * h) * 2;
          u32x2 v0 = *(const u32x2*)vp, v1 = *(const u32x2*)(vp + 16);
          u32x4 t4 = {v0.x, v0.y, v1.x, v1.y}; vw[kb][s2][d] = t4;
        }
#pragma unroll
    for (int e = 0; e < 16; ++e) { s0[e] = STATIC ? -mfix : 0.f; s1[e] = STATIC ? -mfix : 0.f; }
#pragma unroll
    for (int ks = 0; ks < NQS; ++ks) s0 = MFMA32(kf[0][ks], qf[ks], s0);
    if (!STATIC) {
      float mx = s0[0];
#pragma unroll
      for (int e = 1; e < 16; ++e) mx = fmaxf(mx, s0[e]);
      mx = fmaxf(mx, __shfl_xor(mx, 32));
      if (!__all(mx <= m_run + 8.f)) {
        const float m_new = fmaxf(m_run, mx);
        const float alpha = __builtin_amdgcn_exp2f(m_run - m_new);
        m_run = m_new; l_run *= alpha;
#pragma unroll
        for (int d = 0; d < 2; ++d)
#pragma unroll
          for (int e = 0; e < 16; ++e) o[d][e] *= alpha;
      }
    }
#pragma unroll
    for (int ks = 0; ks < NQS; ++ks) s1 = MFMA32(kf[1][ks], qf[ks], s1);
    {
      float ps = 0.f;
#pragma unroll
      for (int e = 0; e < 16; ++e) { float p = STATIC ? __builtin_amdgcn_exp2f(s0[e]) : __builtin_amdgcn_exp2f(s0[e] - m_run); s0[e] = p; ps += p; }
      l_run += ps;
    }
    if (!STATIC) {
      float mx = s1[0];
#pragma unroll
      for (int e = 1; e < 16; ++e) mx = fmaxf(mx, s1[e]);
      mx = fmaxf(mx, __shfl_xor(mx, 32));
      if (!__all(mx <= m_run + 8.f)) {
        const float m_new = fmaxf(m_run, mx);
        const float alpha = __builtin_amdgcn_exp2f(m_run - m_new);
        m_run = m_new; l_run *= alpha;
#pragma unroll
        for (int e = 0; e < 16; ++e) s0[e] *= alpha;
#pragma unroll
        for (int d = 0; d < 2; ++d)
#pragma unroll
          for (int e = 0; e < 16; ++e) o[d][e] *= alpha;
      }
    }
#pragma unroll
    for (int s2 = 0; s2 < 2; ++s2) {
      u32x4 pw = {cvtpk(s0[8 * s2], s0[8 * s2 + 1]), cvtpk(s0[8 * s2 + 2], s0[8 * s2 + 3]), cvtpk(s0[8 * s2 + 4], s0[8 * s2 + 5]), cvtpk(s0[8 * s2 + 6], s0[8 * s2 + 7])};
      bf16x8 pf = __builtin_bit_cast(bf16x8, pw);
#pragma unroll
      for (int d = 0; d < 2; ++d) o[d] = MFMA32(__builtin_bit_cast(bf16x8, vw[0][s2][d]), pf, o[d]);
    }
    {
      float ps = 0.f;
#pragma unroll
      for (int e = 0; e < 16; ++e) { float p = STATIC ? __builtin_amdgcn_exp2f(s1[e]) : __builtin_amdgcn_exp2f(s1[e] - m_run); s1[e] = p; ps += p; }
      l_run += ps;
    }
#pragma unroll
    for (int s2 = 0; s2 < 2; ++s2) {
      u32x4 pw = {cvtpk(s1[8 * s2], s1[8 * s2 + 1]), cvtpk(s1[8 * s2 + 2], s1[8 * s2 + 3]), cvtpk(s1[8 * s2 + 4], s1[8 * s2 + 5]), cvtpk(s1[8 * s2 + 6], s1[8 * s2 + 7])};
      bf16x8 pf = __builtin_bit_cast(bf16x8, pw);
#pragma unroll
      for (int d = 0; d < 2; ++d) o[d] = MFMA32(__builtin_bit_cast(bf16x8, vw[1][s2][d]), pf, o[d]);
    }
    if (more) {
      char* nxt = nxtp + sub * BUF;
#pragma unroll
      for (int i = 0; i < NKC; ++i) if (koffl[i] >= 0) *(u32x4*)(nxt + koffl[i]) = rk[i];
#pragma unroll
      for (int i = 0; i < 1; ++i) { u32x2 a = {rv[i].x, rv[i].y}, b = {rv[i].z, rv[i].w}; *(u32x2*)(nxt + voffl + i * 32 * VSTR) = a; *(u32x2*)(nxt + voffl + i * 32 * VSTR + 8) = b; }
    }
   }
   __syncthreads();
  }
  const float lt = l_run + __shfl_xor(l_run, 32);
  const float inv = 1.f / lt;
  const size_t rq = (size_t)(32 * w + l31);
#pragma unroll
  for (int d = 0; d < 2; ++d)
#pragma unroll
    for (int q = 0; q < 4; ++q) {
      const int dv = 32 * d + 8 * q + 4 * h;
      f32x4 g = unpack4(*(const u32x2*)(Pg + rq * NIN + dv));
      f32x4 v = {o[d][4 * q] * inv * silu(g[0]), o[d][4 * q + 1] * inv * silu(g[1]), o[d][4 * q + 2] * inv * silu(g[2]), o[d][4 * q + 3] * inv * silu(g[3])};
      *(u32x2*)(Yg + rq * 1024 + dv) = pack4(v);
    }
}

DI void xpose_cvt(const float* __restrict__ src, bf16_t* __restrict__ dst, int K, int N, int Npad, bool perm_kv, size_t gtid, size_t gstride) {
  const size_t total = (size_t)Npad * (K >> 3);
#pragma nounroll
  for (size_t i = gtid; i < total; i += gstride) {
    const int n = (int)(i % Npad), kb = (int)(i / Npad);
    float v[8];
#pragma unroll
    for (int e = 0; e < 8; ++e) v[e] = (n < N) ? src[(size_t)(8 * kb + e) * N + n] : 0.f;
    int row = n;
    if (perm_kv) { const int hh = n >> 7, wv = n & 127; row = (wv < 64) ? (64 * hh + wv) : (256 + 64 * hh + (wv - 64)); }
    u32x4 o = {cvtpk(v[0], v[1]), cvtpk(v[2], v[3]), cvtpk(v[4], v[5]), cvtpk(v[6], v[7])};
    *(u32x4*)(dst + (size_t)row * K + 8 * kb) = o;
  }
}

DI void phase0(KP p, char* lds) {
  unsigned char* ws = p->ws; asm volatile("" : "+s"(ws));
  const int tid = otid();
  const size_t gtid = (size_t)blockIdx.x * NTHR + tid, gstride = (size_t)gridDim.x * NTHR;
  for (int l = 0; l < 2; ++l) {
    xpose_cvt(p->w_in + (size_t)l * 1024 * NIN, (bf16_t*)(ws + WS_WIN) + (size_t)l * NINP * 1024, 1024, NIN, NINP, false, gtid, gstride);
    xpose_cvt(p->mla_w_uq + (size_t)l * 192 * 384, (bf16_t*)(ws + WS_WUQ) + (size_t)l * 384 * 192, 192, 384, 384, false, gtid, gstride);
    xpose_cvt(p->mla_w_ukv + (size_t)l * 128 * 512, (bf16_t*)(ws + WS_WUKV) + (size_t)l * 512 * 128, 128, 512, 512, true, gtid, gstride);
    xpose_cvt(p->fnet_w + (size_t)l * 256 * 256, (bf16_t*)(ws + WS_WF) + (size_t)l * 256 * 256, 256, 256, 256, false, gtid, gstride);
    xpose_cvt(p->w_out + (size_t)l * 1024 * 1024, (bf16_t*)(ws + WS_WOUT) + (size_t)l * 1024 * 1024, 1024, 1024, 1024, false, gtid, gstride);
  }
  {
    const float* src = p->cm_w_s; bf16_t* dst = (bf16_t*)(ws + WS_WS);
    for (size_t i = gtid; i < (size_t)2 * 4 * 128 * 128 / 8; i += gstride) {
      f32x4 a = *(const f32x4*)(src + i * 8), b = *(const f32x4*)(src + i * 8 + 4);
      u32x4 o = {cvtpk(a[0], a[1]), cvtpk(a[2], a[3]), cvtpk(b[0], b[1]), cvtpk(b[2], b[3])};
      *(u32x4*)(dst + i * 8) = o;
    }
  }
  {
    bf16_t* dl = (bf16_t*)(ws + WS_DLAT);
#pragma nounroll
    for (size_t i = gtid; i < (size_t)2048 * 256; i += gstride) {
      const int sp = (int)(i >> 8), k8 = (int)(i & 255) * 8;
      float v[8];
#pragma unroll
      for (int e = 0; e < 8; ++e) { const int k = k8 + e, s = (k <= 1024) ? k : k - 1024; const int ph = (sp * s) & 2047; const float a = (float)ph * (1.f / 1024.f); v[e] = (k <= 1024) ? cospif(a) : -sinpif(a); }
      u32x4 o = {cvtpk(v[0], v[1]), cvtpk(v[2], v[3]), cvtpk(v[4], v[5]), cvtpk(v[6], v[7])};
      *(u32x4*)(dl + (size_t)sp * 2048 + k8) = o;
    }
    bf16_t* dc = (bf16_t*)(ws + WS_DCTX);
    for (size_t i = gtid; i < (size_t)256 * 64; i += gstride) {
      const int sp = (int)(i >> 6), k8 = (int)(i & 63) * 8;
      float v[8];
#pragma unroll
      for (int e = 0; e < 8; ++e) { const int k = k8 + e, s = k & 255; const int ph = (sp * s) & 255; const float a = (float)ph * (1.f / 128.f); v[e] = (k < 256) ? cospif(a) : -sinpif(a); }
      u32x4 o = {cvtpk(v[0], v[1]), cvtpk(v[2], v[3]), cvtpk(v[4], v[5]), cvtpk(v[6], v[7])};
      *(u32x4*)(dc + (size_t)sp * 512 + k8) = o;
    }
    bf16_t* cm = (bf16_t*)(ws + WS_CM);
    for (size_t i = gtid; i < (size_t)128 * 64; i += gstride) {
      const int n = (int)(i >> 6), c = (int)(i & 63);
      const int ph = (c * (n & 63)) & 63; const float a = (float)ph * (1.f / 32.f);
      cm[i] = f2bf((n < 64) ? cospif(a) : sinpif(a));
    }
    float* rg = (float*)(ws + WS_ROPG);
    for (size_t i = gtid; i < 64 * 16; i += gstride) {
      const int pos = (int)(i >> 4), j = (int)(i & 15);
      const float inv = powf(10000.f, -(float)j / 16.f); float sn, cs; sincosf((float)pos * inv, &sn, &cs);
      rg[2 * i] = cs; rg[2 * i + 1] = sn;
    }
    if (blockIdx.x == 0 && tid < 4) {
      const int l = tid >> 1, isb = tid & 1; const int d = isb ? 64 : 96;
      const float* gq = (isb ? p->gqa_qn : p->mla_qn) + l * d; const float* gk = (isb ? p->gqa_kn : p->mla_kn) + l * d;
      float mq = 0.f, mk = 0.f;
      for (int i = 0; i < d; ++i) { mq = fmaxf(mq, fabsf(gq[i])); mk = fmaxf(mk, fabsf(gk[i])); }
      ((float*)(ws + WS_SBND))[l * 2 + isb] = sqrtf((float)d) * mq * mk * 1.4426950408889634f;
    }
    float* rm = (float*)(ws + WS_ROPM);
    for (size_t i = gtid; i < 64 * 8; i += gstride) {
      const int pos = (int)(i >> 3), j = (int)(i & 7);
      const float inv = powf(10000.f, -(float)j / 8.f); float sn, cs; sincosf((float)pos * inv, &sn, &cs);
      rm[2 * i] = cs; rm[2 * i + 1] = sn;
    }
  }
  const int hb = tid >> 8, tq = tid & 255;
  float* sl = (float*)(lds + hb * HALF_LDS);
  float* mod = (float*)(ws + WS_MOD);
  const int kg = tq >> 5, cn = tq & 31;
  for (int it = 2 * blockIdx.x + hb; it < 192; it += 2 * gridDim.x) {
    const int l = it / 96, n = (it % 96) * 32 + cn;
    float acc[17];
#pragma unroll
    for (int i = 0; i < 17; ++i) acc[i] = 0.f;
    for (int half = 0; half < 2; ++half) {
      __syncthreads();
      for (int e = tq; e < 17 * 512; e += 256) {
        const int i = e >> 9, k = (e & 511) + 512 * half;
        const float cv = (i < 16) ? p->c[i * 1024 + k] : p->c_ctx[k];
        sl[e] = silu(cv);
      }
      __syncthreads();
      const float* wp = p->w_mod + ((size_t)l * 1024 + 512 * half + kg * 64) * 3072 + n;
#pragma unroll 4
      for (int kk = 0; kk < 64; ++kk) {
        const float wv = wp[(size_t)kk * 3072];
#pragma unroll
        for (int i = 0; i < 17; ++i) acc[i] = fmaf(sl[i * 512 + kg * 64 + kk], wv, acc[i]);
      }
    }
    __syncthreads();
#pragma unroll
    for (int i = 0; i < 17; ++i) sl[(kg * 17 + i) * 32 + cn] = acc[i];
    __syncthreads();
    for (int e = tq; e < 17 * 32; e += 256) {
      const int i = e >> 5, c2 = e & 31;
      float s = 0.f;
#pragma unroll
      for (int g = 0; g < 8; ++g) s += sl[(g * 17 + i) * 32 + c2];
      const int nn = (it % 96) * 32 + c2;
      mod[((size_t)l * 17 + i) * 3072 + nn] = s + p->b_mod[l * 3072 + nn];
    }
    __syncthreads();
  }
}

DI void phase_norm(KP p, int l) {
  unsigned char* ws = p->ws; asm volatile("" : "+s"(ws));
  const float* xl = (l == 0) ? p->x : p->out;
  const float* xc = (l == 0) ? p->ctx : (const float*)(ws + WS_CTX1);
  const float* g = p->norm_g + l * 1024;
  const float* mod = (const float*)(ws + WS_MOD) + (size_t)l * 17 * 3072;
  bf16_t* hx = (bf16_t*)(ws + WS_R1);
  const int tid = otid(); const int lane = tid & 63;
  const int gw = blockIdx.x * (NTHR / 64) + (tid >> 6), nw = gridDim.x * (NTHR / 64);
#pragma unroll 2
  for (int r = gw; r < M; r += nw) {
    const int b = r / T, t = r % T;
    const float* src = (t < SEQ) ? xl + ((size_t)b * SEQ + t) * 1024 : xc + ((size_t)b * CL + (t - SEQ)) * 1024;
    const float* mr = mod + (size_t)((t < SEQ) ? b : 16) * 3072;
    f32x4 v[4]; float ss = 0.f;
#pragma unroll
    for (int i = 0; i < 4; ++i) { v[i] = *(const f32x4*)(src + i * 256 + lane * 4); ss += v[i][0] * v[i][0] + v[i][1] * v[i][1] + v[i][2] * v[i][2] + v[i][3] * v[i][3]; }
    ss = red64(ss);
    const float rstd = rsqrtf(ss * (1.f / 1024.f) + 1e-6f);
#pragma unroll
    for (int i = 0; i < 4; ++i) {
      const int k = i * 256 + lane * 4;
      f32x4 gg = *(const f32x4*)(g + k), sh = *(const f32x4*)(mr + k), sc = *(const f32x4*)(mr + 1024 + k);
      f32x4 o;
#pragma unroll
      for (int e = 0; e < 4; ++e) o[e] = v[i][e] * rstd * gg[e] * (1.f + sc[e]) + sh[e];
      *(u32x2*)(hx + (size_t)r * 1024 + k) = pack4(o);
    }
  }
}

DI void phase_inproj(KP p, int l, char* lds) {
  unsigned char* ws = p->ws; asm volatile("" : "+s"(ws));
  const bf16_t* hx = (const bf16_t*)(ws + WS_R1);
  const bf16_t* wt = (const bf16_t*)(ws + WS_WIN) + (size_t)l * NINP * 1024;
  bf16_t* P = (bf16_t*)(ws + WS_P);
  const int xcd = blockIdx.x & 7, lb = blockIdx.x >> 3, nlb = gridDim.x >> 3, hb = __builtin_amdgcn_readfirstlane(otid() >> 8);
  constexpr int NBIG = 18 * 10;
  for (int j = lb; j < NBIG + 18; j += nlb) {
    if (j < NBIG) {
      int mloc, ntile;
      if (j < 144) { mloc = (j % 72) >> 2; ntile = (j / 72) * 4 + (j & 3); } else { const int j2 = j - 144; mloc = j2 >> 1; ntile = 8 + (j2 & 1); }
      const int mt = 18 * xcd + mloc;
      if (l == 1 && (mt % 9) == 8 && !(ntile == 0 || ntile == 1 || ntile == 3 || ntile == 4)) continue;
      const int m0 = mt * 256, n0 = ntile * 256;
      gemm256(hx + (size_t)m0 * 1024, 1024, wt + (size_t)n0 * 1024, 1024, 1024, lds, [&](int m, int n, f32x4 v) {
        __builtin_nontemporal_store(pack4(v), (u32x2*)(P + (size_t)(m0 + m) * NIN + n0 + n));
      });
    } else {
      const int mt = 36 * xcd + 2 * (j - NBIG) + hb;
      if (l == 1 && (mt % 18) >= 16) continue;
      const int m0 = mt * 128;
      gemm_tile(hx + (size_t)m0 * 1024, 1024, wt + (size_t)2560 * 1024, 1024, 1024, lds, [&](int m, int n, f32x4 v) {
        if (2560 + n < NIN) __builtin_nontemporal_store(pack4(v), (u32x2*)(P + (size_t)(m0 + m) * NIN + 2560 + n));
      });
    }
  }
}

DI void rope4(f32x4& v, int u, const float sg, const float* cs) {
#pragma unroll
  for (int e = 0; e < 4; ++e) {
    const float xp = __shfl_xor(v[e], 4);
    v[e] = v[e] * cs[2 * e] + sg * xp * cs[2 * e + 1];
  }
}
DI void rope2(float& a, float& b, const float sg, const f32x4 cs) {
  const float ap = __shfl_xor(a, 4), bp = __shfl_xor(b, 4);
  a = a * cs[0] + sg * ap * cs[1];
  b = b * cs[2] + sg * bp * cs[3];
}

DI void phase_feat_a(KP p, int l, char* lds) {
  unsigned char* ws = p->ws; asm volatile("" : "+s"(ws));
  const bf16_t* P = (const bf16_t*)(ws + WS_P);
  bf16_t* cqn = (bf16_t*)(ws + WS_R1 + R1_CQN);
  bf16_t* ckvn = (bf16_t*)(ws + WS_R1 + R1_CKVN);
  bf16_t* QB = (bf16_t*)(ws + WS_QB); bf16_t* KB = (bf16_t*)(ws + WS_KB); bf16_t* VBT = (bf16_t*)(ws + WS_VBT);
  bf16_t* vnT = (bf16_t*)(ws + WS_VNT);
  const float* rg = (const float*)(ws + WS_ROPG);
  const int tid = otid(); const int lane = tid & 63, u = lane & 15, sub = lane >> 4;
  const int gw = blockIdx.x * (NTHR / 64) + (tid >> 6), nw = gridDim.x * (NTHR / 64);
  const int hb = tid >> 8, tq = tid & 255; char* ldh = lds + hb * HALF_LDS;
  {
    constexpr int STR = 144;
    const float* lg = p->cm_ln_g + l * 256; const float* lbp = p->cm_ln_b + l * 256;
    for (int unit = 2 * blockIdx.x + hb; unit < (M / 64) * 2; unit += 2 * gridDim.x) {
      const int grp = unit >> 1; const bool isv2 = unit & 1;
      const int r0 = grp * 64; const int b = r0 / T, t0 = r0 % T;
      if (!isv2) {
        const int c = tq & 31, rb = 2 * (tq >> 5);
        f32x4 g0 = *(const f32x4*)(lg + 8 * c), g1 = *(const f32x4*)(lg + 8 * c + 4), b0 = *(const f32x4*)(lbp + 8 * c), b1 = *(const f32x4*)(lbp + 8 * c + 4);
        const float gg[8] = {g0[0], g0[1], g0[2], g0[3], g1[0], g1[1], g1[2], g1[3]};
        const float bb[8] = {b0[0], b0[1], b0[2], b0[3], b1[0], b1[1], b1[2], b1[3]};
#pragma unroll
        for (int i = 0; i < 4; ++i) {
          float vn[2][8];
#pragma unroll
          for (int rr = 0; rr < 2; ++rr) {
            const int row = rb + 16 * i + rr;
            u32x4 q = *(const u32x4*)(P + (size_t)(r0 + row) * NIN + O_V + 8 * c);
            float f[8] = {bflo(q.x), bfhi(q.x), bflo(q.y), bfhi(q.y), bflo(q.z), bfhi(q.z), bflo(q.w), bfhi(q.w)};
            float s1 = 0.f, s2 = 0.f;
#pragma unroll
            for (int e = 0; e < 8; ++e) { s1 += f[e]; s2 += f[e] * f[e]; }
#pragma unroll
            for (int m = 1; m < 32; m <<= 1) { s1 += __shfl_xor(s1, m); s2 += __shfl_xor(s2, m); }
            const float mu = s1 * (1.f / 256.f); const float var = fmaxf(s2 * (1.f / 256.f) - mu * mu, 0.f); const float rs = rsqrtf(var + 1e-6f);
#pragma unroll
            for (int e = 0; e < 8; ++e) vn[rr][e] = (f[e] - mu) * rs * gg[e] + bb[e];
          }
#pragma unroll
          for (int e = 0; e < 8; ++e) *(unsigned*)(ldh + (8 * c + e) * STR + (rb + 16 * i) * 2) = cvtpk(vn[0][e], vn[1][e]);
        }
        __syncthreads();
        bf16_t* vo = vnT + (size_t)(r0 >> 7) * 256 * 128 + (r0 & 127);
#pragma unroll
        for (int i = 0; i < 8; ++i) {
          const int ch = (tq >> 3) + 32 * i, part = tq & 7;
          *(u32x4*)(vo + (size_t)ch * 128 + part * 8) = *(const u32x4*)(ldh + ch * STR + part * 16);
        }
      } else {
        const int c = tq & 15, rb = 2 * (tq >> 4);
#pragma unroll
        for (int i = 0; i < 2; ++i) {
          u32x4 q0 = *(const u32x4*)(P + (size_t)(r0 + rb + 32 * i) * NIN + O_V2 + 8 * c);
          u32x4 q1 = *(const u32x4*)(P + (size_t)(r0 + rb + 32 * i + 1) * NIN + O_V2 + 8 * c);
          const unsigned a[4] = {q0.x, q0.y, q0.z, q0.w}, d[4] = {q1.x, q1.y, q1.z, q1.w};
#pragma unroll
          for (int e = 0; e < 4; ++e) {
            *(unsigned*)(ldh + (8 * c + 2 * e) * STR + (rb + 32 * i) * 2) = (a[e] & 0xffffu) | (d[e] << 16);
            *(unsigned*)(ldh + (8 * c + 2 * e + 1) * STR + (rb + 32 * i) * 2) = (a[e] >> 16) | (d[e] & 0xffff0000u);
          }
        }
        __syncthreads();
        bf16_t* vb = VBT + (size_t)b * 2 * 64 * T + t0;
#pragma unroll
        for (int i = 0; i < 4; ++i) {
          const int ch = (tq >> 3) + 32 * i, part = tq & 7;
          *(u32x4*)(vb + (size_t)ch * T + part * 8) = *(const u32x4*)(ldh + ch * STR + part * 16);
        }
      }
      __syncthreads();
    }
  }
  constexpr int NTA = M / 4;
#pragma unroll 4
  for (int task = gw; task < NTA; task += nw) {
    {
      const int r = task * 4 + sub; const int b = r / T, t = r % T;
      const bf16_t* pr = P + (size_t)r * NIN;
      {
        f32x4 v[3]; float ss = 0.f;
#pragma unroll
        for (int e = 0; e < 3; ++e) { v[e] = unpack4(*(const u32x2*)(pr + O_CQ + 12 * u + 4 * e)); ss += v[e][0] * v[e][0] + v[e][1] * v[e][1] + v[e][2] * v[e][2] + v[e][3] * v[e][3]; }
        ss = red16(ss); const float rs = rsqrtf(ss * (1.f / 192.f) + 1e-6f);
#pragma unroll
        for (int e = 0; e < 3; ++e) {
          f32x4 g = *(const f32x4*)(p->mla_q_norm + l * 192 + 12 * u + 4 * e);
          f32x4 o = {v[e][0] * rs * g[0], v[e][1] * rs * g[1], v[e][2] * rs * g[2], v[e][3] * rs * g[3]};
          *(u32x2*)(cqn + (size_t)r * 192 + 12 * u + 4 * e) = pack4(o);
        }
      }
      {
        f32x4 v[2]; float ss = 0.f;
#pragma unroll
        for (int e = 0; e < 2; ++e) { v[e] = unpack4(*(const u32x2*)(pr + O_CKV + 8 * u + 4 * e)); ss += v[e][0] * v[e][0] + v[e][1] * v[e][1] + v[e][2] * v[e][2] + v[e][3] * v[e][3]; }
        ss = red16(ss); const float rs = rsqrtf(ss * (1.f / 128.f) + 1e-6f);
#pragma unroll
        for (int e = 0; e < 2; ++e) {
          f32x4 g = *(const f32x4*)(p->mla_kv_norm + l * 128 + 8 * u + 4 * e);
          f32x4 o = {v[e][0] * rs * g[0], v[e][1] * rs * g[1], v[e][2] * rs * g[2], v[e][3] * rs * g[3]};
          *(u32x2*)(ckvn + (size_t)r * 128 + 8 * u + 4 * e) = pack4(o);
        }
      }
      const int posg = (u & 8) ? (t & 63) : (t >> 6); const float sgg = (u & 4) ? 1.f : -1.f;
      const f32x4 c01 = *(const f32x4*)(rg + (posg * 16 + 4 * (u & 3)) * 2), c23 = *(const f32x4*)(rg + (posg * 16 + 4 * (u & 3) + 2) * 2);
      const float csg[8] = {c01[0], c01[1], c01[2], c01[3], c23[0], c23[1], c23[2], c23[3]};
      const f32x4 gqv = *(const f32x4*)(p->gqa_qn + l * 64 + 4 * u), gkv = *(const f32x4*)(p->gqa_kn + l * 64 + 4 * u);
#pragma unroll
      for (int hh = 0; hh < 6; ++hh) {
        const bool isq = hh < 4; const int hd = isq ? hh : hh - 4;
        f32x4 v = unpack4(*(const u32x2*)(pr + (isq ? O_Q2 : O_K2) + 64 * hd + 4 * u));
        float ss = red16(v[0] * v[0] + v[1] * v[1] + v[2] * v[2] + v[3] * v[3]);
        const float rs = rsqrtf(ss * (1.f / 64.f) + 1e-6f);
        const f32x4 g = isq ? gqv : gkv;
#pragma unroll
        for (int e = 0; e < 4; ++e) v[e] = v[e] * rs * g[e];
        if (t < SEQ) rope4(v, u, sgg, csg);
        if (isq) {
#pragma unroll
          for (int e = 0; e < 4; ++e) v[e] *= 0.18033688011112042f;
        }
        bf16_t* dst = isq ? QB + (((size_t)b * 4 + hd) * T + t) * 64 + 4 * u : KB + (((size_t)b * 2 + hd) * T + t) * 64 + 4 * u;
        *(u32x2*)dst = pack4(v);
      }
    }
  }
}

DI void phase_feat_b(KP p, int l, char* lds) {
  unsigned char* ws = p->ws; asm volatile("" : "+s"(ws));
  const bf16_t* P = (const bf16_t*)(ws + WS_P);
  const bf16_t* cqn = (const bf16_t*)(ws + WS_R1 + R1_CQN);
  const bf16_t* ckvn = (const bf16_t*)(ws + WS_R1 + R1_CKVN);
  bf16_t* q1r = (bf16_t*)(ws + WS_R1 + R1_Q1R);
  bf16_t* kr = (bf16_t*)(ws + WS_R1 + R1_KR);
  const bf16_t* wuq = (const bf16_t*)(ws + WS_WUQ) + (size_t)l * 384 * 192;
  const bf16_t* wukv = (const bf16_t*)(ws + WS_WUKV) + (size_t)l * 512 * 128;
  const bf16_t* cm = (const bf16_t*)(ws + WS_CM);
  bf16_t* VAT = (bf16_t*)(ws + WS_VAT); bf16_t* FT = (bf16_t*)(ws + WS_FT); bf16_t* FTC = (bf16_t*)(ws + WS_FTC);
  constexpr int N1 = 288 * 3, N2 = 288 * 2, N3 = 288 * 2, N4 = 288 * 4;
  const int hbb = __builtin_amdgcn_readfirstlane(otid() >> 8);
  for (int it = 2 * blockIdx.x + hbb; it < N1 + N2 + N3 + N4; it += 2 * gridDim.x) {
    if (it < N1) {
      const int mt = it / 3, nt = it % 3; const int m0 = mt * 128, n0 = nt * 128;
      gemm_tile(cqn + (size_t)m0 * 192, 192, wuq + (size_t)n0 * 192, 192, 192, lds, [&](int m, int n, f32x4 v) {
        *(u32x2*)(q1r + (size_t)(m0 + m) * 384 + n0 + n) = pack4(v); });
    } else if (it < N1 + N2) {
      const int i2 = it - N1; const int mt = i2 >> 1, nt = i2 & 1; const int m0 = mt * 128, n0 = nt * 128;
      gemm_tile(ckvn + (size_t)m0 * 128, 128, wukv + (size_t)n0 * 128, 128, 128, lds, [&](int m, int n, f32x4 v) {
        *(u32x2*)(kr + (size_t)(m0 + m) * 256 + n0 + n) = pack4(v); });
    } else if (it < N1 + N2 + N3) {
      const int i2 = it - N1 - N2; const int tt = i2 >> 1, mt2 = i2 & 1;
      gemm_tile(wukv + (size_t)(256 + 128 * mt2) * 128, 128, ckvn + (size_t)tt * 128 * 128, 128, 128, lds, [&](int m, int n, f32x4 v) {
        const int mm = 128 * mt2 + m, head = mm >> 6, dv = mm & 63; const int r = tt * 128 + n; const int b = r / T, t = r % T;
        *(u32x2*)(VAT + (((size_t)b * 4 + head) * 64 + dv) * T + t) = pack4(v); });
    } else {
      const int i2 = it - N1 - N2 - N3; const int tt = i2 >> 2, g = i2 & 3;
      gemm_tile(cm, 64, P + (size_t)tt * 128 * NIN + O_F + 64 * g, NIN, 64, lds, [&](int m, int n, f32x4 v) {
        const int col = 64 * g + (m & 63), part = m >> 6; const int r = tt * 128 + n; const int b = r / T, t = r % T;
        if (t < SEQ) *(u32x2*)(FT + ((size_t)b * 256 + col) * 4096 + part * 2048 + t) = pack4(v);
        else *(u32x2*)(FTC + ((size_t)b * 256 + col) * 512 + part * 256 + (t - SEQ)) = pack4(v); });
    }
  }
}

DI void phase_feat_c(KP p, int l) {
  unsigned char* ws = p->ws; asm volatile("" : "+s"(ws));
  const bf16_t* P = (const bf16_t*)(ws + WS_P);
  const bf16_t* q1r = (const bf16_t*)(ws + WS_R1 + R1_Q1R);
  const bf16_t* krw = (const bf16_t*)(ws + WS_R1 + R1_KR);
  bf16_t* QA = (bf16_t*)(ws + WS_QA); bf16_t* KA = (bf16_t*)(ws + WS_KA);
  const float* rm = (const float*)(ws + WS_ROPM);
  const int tid = otid(); const int lane = tid & 63, u = lane & 15, sub = lane >> 4;
  const int gw = blockIdx.x * (NTHR / 64) + (tid >> 6), nw = gridDim.x * (NTHR / 64);
  {
    const bf16_t* FT = (const bf16_t*)(ws + WS_FT); bf16_t* FTF = (bf16_t*)(ws + WS_FTF);
    for (int task = gw; task < NB * 256 * 4; task += nw) {
      const int row = task >> 2, k8 = (task & 3) * 512 + lane * 8;
      const bf16_t* fr = FT + (size_t)row * 4096;
      const bool cosp = k8 < 1024;
      const int f0 = cosp ? k8 : 2048 + (k8 - 1024);
      const int mi = cosp ? 2048 - k8 : 4096 - (k8 - 1024);
      const u32x4 fw = *(const u32x4*)(fr + f0), ml = *(const u32x4*)(fr + mi - 8);
      const float m0v = bflo((unsigned)fr[(mi < 4096) ? mi : 4095]);
      const float f[8] = {bflo(fw.x), bfhi(fw.x), bflo(fw.y), bfhi(fw.y), bflo(fw.z), bfhi(fw.z), bflo(fw.w), bfhi(fw.w)};
      const float mr[8] = {m0v, bfhi(ml.w), bflo(ml.w), bfhi(ml.z), bflo(ml.z), bfhi(ml.y), bflo(ml.y), bfhi(ml.x)};
      float v[8];
#pragma unroll
      for (int e = 0; e < 8; ++e) {
        const int k = k8 + e;
        if (k < 1024) v[e] = f[e] + ((k == 0) ? 0.f : mr[e]);
        else if (k == 1024) v[e] = bflo((unsigned)fr[1024]);
        else v[e] = f[e] - mr[e];
      }
      u32x4 o = {cvtpk(v[0], v[1]), cvtpk(v[2], v[3]), cvtpk(v[4], v[5]), cvtpk(v[6], v[7])};
      *(u32x4*)(FTF + (size_t)row * 2048 + k8) = o;
    }
  }
#pragma unroll 4
  for (int task = gw; task < M / 4; task += nw) {
    const int r = task * 4 + sub; const int b = r / T, t = r % T;
    const unsigned krp = *(const unsigned*)(P + (size_t)r * NIN + O_KR + 2 * u);
    const int posm = (u & 8) ? (t & 63) : (t >> 6); const float sgm = (u & 4) ? 1.f : -1.f;
    const f32x4 csm = *(const f32x4*)(rm + (posm * 8 + 2 * (u & 3)) * 2);
    const f32x4 gq4 = *(const f32x4*)(p->mla_qn + l * 96 + 4 * u), gk4 = *(const f32x4*)(p->mla_kn + l * 96 + 4 * u);
    const f32x2 gq2 = *(const f32x2*)(p->mla_qn + l * 96 + 64 + 2 * u), gk2 = *(const f32x2*)(p->mla_kn + l * 96 + 64 + 2 * u);
#pragma unroll
    for (int hh = 0; hh < 8; ++hh) {
      const bool isq = hh < 4; const int hd = hh & 3;
      f32x4 v; float ra, rb;
      if (isq) {
        v = unpack4(*(const u32x2*)(q1r + (size_t)r * 384 + 96 * hd + 4 * u));
        const unsigned rr = *(const unsigned*)(q1r + (size_t)r * 384 + 96 * hd + 64 + 2 * u); ra = bflo(rr); rb = bfhi(rr);
      } else {
        v = unpack4(*(const u32x2*)(krw + (size_t)r * 256 + 64 * hd + 4 * u));
        ra = bflo(krp); rb = bfhi(krp);
      }
      float ss = red16(v[0] * v[0] + v[1] * v[1] + v[2] * v[2] + v[3] * v[3] + ra * ra + rb * rb);
      const float rs = rsqrtf(ss * (1.f / 96.f) + 1e-6f);
      const f32x4 g = isq ? gq4 : gk4; const f32x2 g2 = isq ? gq2 : gk2;
#pragma unroll
      for (int e = 0; e < 4; ++e) v[e] = v[e] * rs * g[e];
      ra = ra * rs * g2[0]; rb = rb * rs * g2[1];
      if (t < SEQ) rope2(ra, rb, sgm, csm);
      if (isq) {
        const float cq = 1.4426950408889634f / __builtin_sqrtf(96.f);
#pragma unroll
        for (int e = 0; e < 4; ++e) v[e] *= cq;
        ra *= cq; rb *= cq;
      }
      bf16_t* dst = (isq ? QA : KA) + (((size_t)b * 4 + hd) * T + t) * 96;
      *(u32x2*)(dst + 4 * u) = pack4(v);
      *(unsigned*)(dst + 64 + 2 * u) = cvtpk(ra, rb);
    }
  }
}

DI void phase_mix(KP p, int l, char* lds) {
  unsigned char* ws = p->ws; asm volatile("" : "+s"(ws));
  const bf16_t* P = (const bf16_t*)(ws + WS_P);
  bf16_t* Y = (bf16_t*)(ws + WS_R1);
  bf16_t* YD = (bf16_t*)(ws + WS_YD);
  const bf16_t* QA = (const bf16_t*)(ws + WS_QA); const bf16_t* KA = (const bf16_t*)(ws + WS_KA); const bf16_t* VAT = (const bf16_t*)(ws + WS_VAT);
  const bf16_t* QB = (const bf16_t*)(ws + WS_QB); const bf16_t* KB = (const bf16_t*)(ws + WS_KB); const bf16_t* VBT = (const bf16_t*)(ws + WS_VBT);
  const bf16_t* FTF = (const bf16_t*)(ws + WS_FTF); const bf16_t* FTC = (const bf16_t*)(ws + WS_FTC);
  const bf16_t* DL = (const bf16_t*)(ws + WS_DLAT); const bf16_t* DC = (const bf16_t*)(ws + WS_DCTX);
  const bf16_t* vnT = (const bf16_t*)(ws + WS_VNT);
  const bf16_t* wsb = (const bf16_t*)(ws + WS_WS) + (size_t)l * 4 * 128 * 128;
  const bool upd = (l == 0);
  const float sbA = ((const float*)(ws + WS_SBND))[l * 2], sbB = ((const float*)(ws + WS_SBND))[l * 2 + 1];
  const int xcd = blockIdx.x & 7, lb = 2 * (blockIdx.x >> 3) + __builtin_amdgcn_readfirstlane(otid() >> 8), nlb = 2 * (gridDim.x >> 3);
  const int nDL = 64, nA = 0, nB = 0, nDC = upd ? 8 : 0, nAc = 0, nBc = 0, nCM = 144, nFN = upd ? 72 : 64;
  const int e0 = nDL, e1 = e0 + nA, e2 = e1 + nB, e3 = e2 + nDC, e4 = e3 + nAc, e5 = e4 + nBc, e6 = e5 + nCM, e7 = e6 + nFN;
  unsigned* cnt = (unsigned*)(ws + WS_CNT) + l * 288;
  const bf16_t* wf = (const bf16_t*)(ws + WS_WF) + (size_t)l * 256 * 256;
  {
    const int lbw = blockIdx.x >> 3, nlbw = gridDim.x >> 3;
    const int nW = upd ? 144 : 128;
    for (int it = lbw; it < nW; it += nlbw) {
      const bool isA = (it < 64) || (it >= 128 && it < 136);
      int b, hd, q0, k0, nk;
      if (it < 128) { const int i2 = it & 63; b = 2 * xcd + (i2 >> 5); hd = (i2 >> 3) & 3; q0 = (i2 & 7) * 256; k0 = 0; nk = T; }
      else { const int i2 = (it - 128) & 7; b = 2 * xcd + (i2 >> 2); hd = i2 & 3; q0 = SEQ; k0 = SEQ; nk = CL; }
      const size_t r0 = (size_t)b * T + q0; const size_t bh = (size_t)b * 4 + hd, bk = (size_t)b * 2 + (hd >> 1);
      if (isA) {
        if (sbA <= 30.f) attn_item8<96, true>(QA + (bh * T + q0) * 96, KA + (bh * T + k0) * 96, VAT + bh * 64 * T + k0, nk, lds, P + r0 * NIN + O_GA + 64 * hd, Y + r0 * 1024 + 64 * hd, sbA);
        else attn_item8<96, false>(QA + (bh * T + q0) * 96, KA + (bh * T + k0) * 96, VAT + bh * 64 * T + k0, nk, lds, P + r0 * NIN + O_GA + 64 * hd, Y + r0 * 1024 + 64 * hd, 0.f);
      } else {
        if (sbB <= 30.f) attn_item8<64, true>(QB + (bh * T + q0) * 64, KB + (bk * T + k0) * 64, VBT + bk * 64 * T + k0, nk, lds, P + r0 * NIN + O_GB + 64 * hd, Y + r0 * 1024 + 256 + 64 * hd, sbB);
        else attn_item8<64, false>(QB + (bh * T + q0) * 64, KB + (bk * T + k0) * 64, VBT + bk * 64 * T + k0, nk, lds, P + r0 * NIN + O_GB + 64 * hd, Y + r0 * 1024 + 256 + 64 * hd, 0.f);
      }
    }
    __syncthreads();
  }
  const int tid0 = otid() & 255;
  for (int it = lb; it < e7; it += nlb) {
    if (it >= e6) {
      const int i2 = it - e6; const int mpb = upd ? 18 : 16; const int mloc = i2 >> 1, nt = i2 & 1;
      const int mt = (2 * xcd + mloc / mpb) * 18 + (mloc % mpb);
      if (tid0 == 0) {
        unsigned sp = 0;
        while (__hip_atomic_load(&cnt[mt], __ATOMIC_RELAXED, __HIP_MEMORY_SCOPE_AGENT) < 2u) { __builtin_amdgcn_s_sleep(2); if (++sp > (1u << 24)) break; }
        __builtin_amdgcn_fence(__ATOMIC_ACQUIRE, "agent");
        asm volatile("s_waitcnt vmcnt(0)" ::: "memory");
      }
      __syncthreads();
      const int m0 = mt * 128, n0 = nt * 128;
      gemm_tile(YD + (size_t)m0 * 256, 256, wf + (size_t)n0 * 256, 256, 256, lds, [&](int m, int n, f32x4 v) {
        const size_t r = (size_t)m0 + m;
        f32x4 gd = unpack4(*(const u32x2*)(P + r * NIN + O_GD + n0 + n));
        f32x4 o = {v[0] * silu(gd[0]), v[1] * silu(gd[1]), v[2] * silu(gd[2]), v[3] * silu(gd[3])};
        *(u32x2*)(Y + r * 1024 + 768 + n0 + n) = pack4(o); });
      continue;
    }
    if (it < e0 || (it >= e2 && it < e3)) {
      const bool isl = it < e0; const int i2 = isl ? it : it - e2;
      int b, mt, nt, K; const bf16_t* Ap; const bf16_t* Bp; float sc; size_t rbase;
      if (isl) { b = 2 * xcd + (i2 >> 5); mt = (i2 >> 1) & 15; nt = i2 & 1; K = 2048; Ap = DL + (size_t)mt * 128 * 2048; Bp = FTF + ((size_t)b * 256 + nt * 128) * 2048; sc = 0.00276213586f; rbase = (size_t)b * T + mt * 128; }
      else { b = 2 * xcd + (i2 >> 2); mt = (i2 >> 1) & 1; nt = i2 & 1; K = 512; Ap = DC + (size_t)mt * 128 * 512; Bp = FTC + ((size_t)b * 256 + nt * 128) * 512; sc = 0.0078125f; rbase = (size_t)b * T + SEQ + mt * 128; }
      bf16_t* yo = YD + rbase * 256 + nt * 128;
      gemm_tile(Ap, K, Bp, K, K, lds, [&](int m, int n, f32x4 v) {
        f32x4 o = {v[0] * sc, v[1] * sc, v[2] * sc, v[3] * sc};
        *(u32x2*)(yo + (size_t)m * 256 + n) = pack4(o); });
      asm volatile("s_waitcnt vmcnt(0)" ::: "memory");
      __syncthreads();
      if (tid0 == 0) {
        __builtin_amdgcn_fence(__ATOMIC_RELEASE, "agent");
        asm volatile("s_waitcnt vmcnt(0)" ::: "memory");
        __hip_atomic_fetch_add(&cnt[b * 18 + (isl ? mt : 16 + mt)], 1u, __ATOMIC_RELAXED, __HIP_MEMORY_SCOPE_AGENT);
      }
    } else {
      const int i2 = it - e5; const int bl = i2 / 72, rem = i2 % 72; const int chl = rem >> 2, g = rem & 3;
      const int ch = (2 * xcd + bl) * 18 + chl;
      if (!upd && chl >= 16) continue;
      const float* bs = p->cm_b_s + ((size_t)l * 4 + g) * 128;
      const bf16_t* Pr = P + (size_t)ch * 128 * NIN + 64 * g; bf16_t* Yr = Y + (size_t)ch * 128 * 1024 + 512 + 64 * g;
      gemm_tile(wsb + (size_t)g * 128 * 128, 128, vnT + ((size_t)ch * 256 + 64 * g) * 128, 128, 128, lds, [&](int m, int n, f32x4 v) {
        if (n < 64) {
          const float bias = bs[m];
          f32x4 uu = unpack4(*(const u32x2*)(Pr + (size_t)m * NIN + O_U + n)), gc = unpack4(*(const u32x2*)(Pr + (size_t)m * NIN + O_GC + n));
          f32x4 o;
#pragma unroll
          for (int e = 0; e < 4; ++e) o[e] = uu[e] * (v[e] + bias) * silu(gc[e]);
          *(u32x2*)(Yr + (size_t)m * 1024 + n) = pack4(o);
        } });
    }
  }
}

DI void phase_outproj(KP p, int l, char* lds) {
  unsigned char* ws = p->ws; asm volatile("" : "+s"(ws));
  const bf16_t* Y = (const bf16_t*)(ws + WS_R1);
  const bf16_t* wo = (const bf16_t*)(ws + WS_WOUT) + (size_t)l * 1024 * 1024;
  const float* mod = (const float*)(ws + WS_MOD) + (size_t)l * 17 * 3072;
  const float* xl = (l == 0) ? p->x : p->out;
  float* ctx1 = (float*)(ws + WS_CTX1);
  const int xcd = blockIdx.x & 7, lb = blockIdx.x >> 3, nlb = gridDim.x >> 3, hb = __builtin_amdgcn_readfirstlane(otid() >> 8);
  const int nsm = (l == 0) ? 16 : 0;
  for (int j = lb; j < 64; j += nlb) {
    {
      const int mi = j >> 2, nt = j & 3;
      const int bb = 2 * xcd + (mi >> 3), tt = mi & 7;
      const int m0 = (bb * 9 + tt) * 256, n0 = nt * 256;
      const float* src = xl + ((size_t)bb * SEQ + tt * 256) * 1024;
      float* dst = p->out + ((size_t)bb * SEQ + tt * 256) * 1024;
      const float* gt = mod + (size_t)bb * 3072 + 2048;
      gemm256(Y + (size_t)m0 * 1024, 1024, wo + (size_t)n0 * 1024, 1024, 1024, lds, [&](int m, int n, f32x4 v) {
        const size_t o = (size_t)m * 1024 + n0 + n;
        f32x4 xv = __builtin_nontemporal_load((const f32x4*)(src + o)), g = *(const f32x4*)(gt + n0 + n);
        f32x4 r = {xv[0] + g[0] * v[0], xv[1] + g[1] * v[1], xv[2] + g[2] * v[2], xv[3] + g[3] * v[3]};
        __builtin_nontemporal_store(r, (f32x4*)(dst + o)); });
    }
  }
  for (int j = lb; j < nsm; j += nlb) {
    {
      const int item = 2 * j + hb; const int bb = 2 * xcd + (item >> 4), m128 = (item >> 3) & 1, nt = item & 7;
      const int m0 = (bb * 18 + 16 + m128) * 128, n0 = nt * 128;
      const float* src = p->ctx + ((size_t)bb * CL + m128 * 128) * 1024;
      float* dst = ctx1 + ((size_t)bb * CL + m128 * 128) * 1024;
      const float* gt = mod + (size_t)16 * 3072 + 2048;
      gemm_tile(Y + (size_t)m0 * 1024, 1024, wo + (size_t)n0 * 1024, 1024, 1024, lds, [&](int m, int n, f32x4 v) {
        const size_t o = (size_t)m * 1024 + n0 + n;
        f32x4 xv = *(const f32x4*)(src + o), g = *(const f32x4*)(gt + n0 + n);
        f32x4 r = {xv[0] + g[0] * v[0], xv[1] + g[1] * v[1], xv[2] + g[2] * v[2], xv[3] + g[3] * v[3]};
        *(f32x4*)(dst + o) = r; });
    }
  }
}

__global__ void __launch_bounds__(NTHR, 2) fwd_megakernel(Params p_byval) {
  KP p = (KP)__builtin_amdgcn_kernarg_segment_ptr();
  extern __shared__ __attribute__((aligned(16))) char lds[];
  cg::grid_group grid = cg::this_grid();
  uint4* xbw = (uint4*)(lds + LDS_MAIN);
  if (threadIdx.x == 0) *xbw = make_uint4(0u, 0u, 0u, 0u);
  __syncthreads();
  XcdBarrier xb = xcd_barrier_post((unsigned*)(p->ws + WS_BAR), (volatile LAS unsigned*)xbw);
  if (p->ph_hi < p->ph_lo) grid.sync();
  (void)p_byval;
  for (int ph = p->ph_lo; ph < p->ph_hi; ++ph) {
    asm volatile("" : "+s"(p));
    if (ph == 0) phase0(p, lds);
    else {
      const int l = (ph - 1) / 7, s = (ph - 1) % 7;
      switch (s) {
        case 0: phase_norm(p, l); break;
        case 1: phase_inproj(p, l, lds); break;
        case 2: phase_feat_a(p, l, lds); break;
        case 3: phase_feat_b(p, l, lds); break;
        case 4: phase_feat_c(p, l); break;
        case 5: phase_mix(p, l, lds); break;
        default: phase_outproj(p, l, lds); break;
      }
    }
    if (ph + 1 < p->ph_hi) xcd_barrier(xb);
  }
}

extern "C" void kernel_launch(void* const* d_in, const int* in_sizes, int n_in, void* d_out, int out_size, void* d_ws, size_t ws_size, hipStream_t stream) {
  static int grid_blocks = 0;
  if (!grid_blocks) {
    int dev = 0, cus = 0, per_cu = 0;
    hipGetDevice(&dev);
    hipDeviceGetAttribute(&cus, hipDeviceAttributeMultiprocessorCount, dev);
    hipFuncSetAttribute((const void*)fwd_megakernel, hipFuncAttributeMaxDynamicSharedMemorySize, LDS_BYTES);
    hipOccupancyMaxActiveBlocksPerMultiprocessor(&per_cu, fwd_megakernel, NTHR, LDS_BYTES);
    if (per_cu > 1) per_cu = 1;
    if (per_cu < 1) per_cu = 1;
    grid_blocks = cus * per_cu;
    if (ws_size < WS_END) fprintf(stderr, "kernel_launch: workspace too small: %zu < %zu\n", ws_size, (size_t)WS_END);
  }
  hipMemsetAsync((unsigned char*)d_ws + WS_BAR, 0, WS_ZERO_BYTES, stream);
  Params p{};
  const float** pp = (const float**)&p;
  for (int i = 0; i < 22; ++i) pp[i] = (const float*)d_in[i];
  p.out = (float*)d_out; p.ws = (unsigned char*)d_ws;
  constexpr int NPH = 15;
#if PER_PHASE_LAUNCH
  for (int ph = 0; ph < NPH; ++ph) {
    p.ph_lo = ph; p.ph_hi = ph + 1;
    hipLaunchKernelGGL(fwd_megakernel, dim3(grid_blocks), dim3(NTHR), LDS_BYTES, stream, p);
  }
#else
  p.ph_lo = 0; p.ph_hi = NPH;
  void* args[] = {&p};
  hipError_t e = hipLaunchCooperativeKernel((void*)fwd_megakernel, dim3(grid_blocks), dim3(NTHR), args, LDS_BYTES, stream);
  if (e != hipSuccess) fprintf(stderr, "cooperative launch failed: %s (grid %d)\n", hipGetErrorString(e), grid_blocks);
#endif
}
```

```cpp
#include <hip/hip_runtime.h>
#include <hip/hip_cooperative_groups.h>
#include <stdint.h>
#include <stdio.h>
namespace cg = cooperative_groups;

#ifndef PER_PHASE_LAUNCH
#define PER_PHASE_LAUNCH 0
#endif

#define DI __device__ __forceinline__
DI int otid() { int t = threadIdx.x; asm volatile("" : "+v"(t)); return t; }
typedef unsigned short bf16_t;
using bf16x8 = __attribute__((ext_vector_type(8))) short;
using f32x16 = __attribute__((ext_vector_type(16))) float;
using f32x4  = __attribute__((ext_vector_type(4))) float;
using f32x2  = __attribute__((ext_vector_type(2))) float;
using u32x4  = __attribute__((ext_vector_type(4))) unsigned;
using u32x2  = __attribute__((ext_vector_type(2))) unsigned;
typedef __bf16 bf16x2_t __attribute__((ext_vector_type(2)));

constexpr int NB = 16, SEQ = 2048, CL = 256, T = 2304, D = 1024, M = NB * T, NIN = 2656, NINP = 2816;
constexpr int O_CQ = 0, O_CKV = 192, O_KR = 320, O_GA = 352, O_Q2 = 608, O_K2 = 864, O_V2 = 992, O_GB = 1120,
              O_U = 1376, O_V = 1632, O_GC = 1888, O_F = 2144, O_GD = 2400;
constexpr int NTHR = 512;
constexpr int HALF_LDS = 69632, LDS_MAIN = 2 * HALF_LDS, LDS_BYTES = LDS_MAIN + 256;

constexpr size_t al256(size_t x) { return (x + 255) & ~(size_t)255; }
constexpr size_t WS_MOD  = 0;
constexpr size_t WS_ROPG = al256(WS_MOD + 2 * 17 * 3072 * 4);
constexpr size_t WS_ROPM = al256(WS_ROPG + 64 * 16 * 2 * 4);
constexpr size_t WS_SBND = al256(WS_ROPM + 64 * 8 * 2 * 4);
constexpr size_t WS_WIN  = al256(WS_SBND + 256);
constexpr size_t WS_WUQ  = al256(WS_WIN + (size_t)2 * NINP * 1024 * 2);
constexpr size_t WS_WUKV = al256(WS_WUQ + 2 * 384 * 192 * 2);
constexpr size_t WS_WF   = al256(WS_WUKV + 2 * 512 * 128 * 2);
constexpr size_t WS_WOUT = al256(WS_WF + 2 * 256 * 256 * 2);
constexpr size_t WS_WS   = al256(WS_WOUT + (size_t)2 * 1024 * 1024 * 2);
constexpr size_t WS_CM   = al256(WS_WS + 2 * 4 * 128 * 128 * 2);
constexpr size_t WS_DLAT = al256(WS_CM + 128 * 64 * 2);
constexpr size_t WS_DCTX = al256(WS_DLAT + (size_t)2048 * 2048 * 2);
constexpr size_t WS_R1   = al256(WS_DCTX + 256 * 512 * 2);
constexpr size_t R1_CQN = 0, R1_CKVN = (size_t)M * 192 * 2, R1_Q1R = R1_CKVN + (size_t)M * 128 * 2, R1_KR = R1_Q1R + (size_t)M * 384 * 2;
constexpr size_t WS_P    = al256(WS_R1 + (size_t)M * 1024 * 2);
constexpr size_t WS_FT   = al256(WS_P + (size_t)M * NIN * 2);
constexpr size_t WS_FTF  = al256(WS_FT + (size_t)NB * 256 * 4096 * 2);
constexpr size_t WS_FTC  = al256(WS_FTF + (size_t)NB * 256 * 2048 * 2);
constexpr size_t WS_YD   = al256(WS_FTC + (size_t)NB * 256 * 512 * 2);
constexpr size_t WS_QA   = al256(WS_YD + (size_t)M * 256 * 2);
constexpr size_t WS_KA   = al256(WS_QA + (size_t)M * 384 * 2);
constexpr size_t WS_VAT  = al256(WS_KA + (size_t)M * 384 * 2);
constexpr size_t WS_QB   = al256(WS_VAT + (size_t)M * 256 * 2);
constexpr size_t WS_KB   = al256(WS_QB + (size_t)M * 256 * 2);
constexpr size_t WS_VBT  = al256(WS_KB + (size_t)M * 128 * 2);
constexpr size_t WS_VNT  = al256(WS_VBT + (size_t)M * 128 * 2);
constexpr size_t WS_CTX1 = al256(WS_VNT + (size_t)M * 256 * 2 + 65536);
constexpr size_t WS_BAR  = al256(WS_CTX1 + (size_t)NB * CL * 1024 * 4);
constexpr size_t WS_CNT  = al256(WS_BAR + 3456 * 4);
constexpr size_t WS_END  = al256(WS_CNT + 2 * 288 * 4);
constexpr size_t WS_ZERO_BYTES = WS_END - WS_BAR;
static_assert(R1_KR + (size_t)M * 256 * 2 <= (size_t)M * 1024 * 2, "temp region");
static_assert(WS_END <= (size_t)512 * 1024 * 1024, "workspace");

struct Params {
  const float *x, *c, *ctx, *c_ctx, *norm_g, *w_mod, *b_mod, *w_in, *mla_q_norm, *mla_w_uq, *mla_kv_norm, *mla_w_ukv,
              *mla_qn, *mla_kn, *gqa_qn, *gqa_kn, *cm_ln_g, *cm_ln_b, *cm_w_s, *cm_b_s, *fnet_w, *w_out;
  float* out; unsigned char* ws; int ph_lo, ph_hi;
};
typedef const __attribute__((address_space(4))) Params* KP;

DI unsigned cvtpk(float lo, float hi) { f32x2 v = {lo, hi}; bf16x2_t b = __builtin_convertvector(v, bf16x2_t); return __builtin_bit_cast(unsigned, b); }
DI float bflo(unsigned u) { return __uint_as_float(u << 16); }
DI float bfhi(unsigned u) { return __uint_as_float(u & 0xffff0000u); }
DI bf16_t f2bf(float f) { return (bf16_t)(cvtpk(f, 0.f) & 0xffffu); }
DI float silu(float x) { return x / (1.f + __expf(-x)); }
DI f32x4 unpack4(u32x2 v) { f32x4 r = {bflo(v.x), bfhi(v.x), bflo(v.y), bfhi(v.y)}; return r; }
DI u32x2 pack4(f32x4 v) { u32x2 r = {cvtpk(v[0], v[1]), cvtpk(v[2], v[3])}; return r; }
DI float dpp_f(float v, const int ctrl_sel) {
  const int i = __float_as_int(v); int r;
  if (ctrl_sel == 0) r = __builtin_amdgcn_update_dpp(0, i, 0xB1, 0xF, 0xF, true);
  else if (ctrl_sel == 1) r = __builtin_amdgcn_update_dpp(0, i, 0x4E, 0xF, 0xF, true);
  else if (ctrl_sel == 2) r = __builtin_amdgcn_update_dpp(0, i, 0x124, 0xF, 0xF, true);
  else r = __builtin_amdgcn_update_dpp(0, i, 0x128, 0xF, 0xF, true);
  return __int_as_float(r);
}
DI float red16(float v) { v += dpp_f(v, 0); v += dpp_f(v, 1); v += dpp_f(v, 2); v += dpp_f(v, 3); return v; }
DI float red64(float v) { v = red16(v); v += __shfl_xor(v, 16); v += __shfl_xor(v, 32); return v; }
#define MFMA32(a, b, c) __builtin_amdgcn_mfma_f32_32x32x16_bf16((a), (b), (c), 0, 0, 0)


#define XB_TMO      128
#define XB_XCNT(j)  (256  + 64 * (j))
#define XB_XSUB(j)  (1280 + 64 * (j))
#define XB_XGEN(j)  (2304 + 64 * (j))
#define XB_TOP      3328
#define XB_TOPGEN   3392
#define XCD_BAR_WORDS 3456
#define XB_SPIN_CAP (1u << 22)
#define LAS __attribute__((address_space(3)))
DI unsigned xb_ld(unsigned* p)              { return __hip_atomic_load(p, __ATOMIC_RELAXED, __HIP_MEMORY_SCOPE_AGENT); }
DI unsigned xb_add(unsigned* p, unsigned v) { return __hip_atomic_fetch_add(p, v, __ATOMIC_RELAXED, __HIP_MEMORY_SCOPE_AGENT); }
DI unsigned xb_xcc_id() { return (unsigned)__builtin_amdgcn_s_getreg((3 << 11) | 20) & 0xFu; }
#define XB_SPIN(cond, bar) do { unsigned _sp = 0; while (cond) { __builtin_amdgcn_s_sleep(1); \
    if ((++_sp & 255u) == 0u) { if (xb_ld(&(bar)[XB_TMO])) break; if (_sp > XB_SPIN_CAP) { atomicAdd(&(bar)[XB_TMO], 1u); break; } } } } while (0)
struct XcdBarrier { unsigned* bar; unsigned x; volatile LAS unsigned* st; };
DI XcdBarrier xcd_barrier_post(unsigned* bar, volatile LAS unsigned* st) {
  XcdBarrier b; b.bar = bar; b.x = xb_xcc_id(); b.st = st;
  if (threadIdx.x == 0) (void)xb_add(&bar[XB_XCNT(b.x)], 1u);
  return b;
}
DI void xcd_barrier_complete(unsigned* bar, unsigned x, unsigned& nloc, unsigned& nx) {
  const unsigned G = gridDim.x * gridDim.y * gridDim.z;
  unsigned sum, cnt, mine, sp = 0u;
  for (;;) {
    sum = 0u; cnt = 0u; mine = 0u;
#pragma unroll
    for (unsigned j = 0; j < 16; ++j) { const unsigned c = xb_ld(&bar[XB_XCNT(j)]); sum += c; cnt += (c > 0u) ? 1u : 0u; mine = (j == x) ? c : mine; }
    if (sum == G) break;
    __builtin_amdgcn_s_sleep(1);
    if ((++sp & 255u) == 0u) { if (xb_ld(&bar[XB_TMO])) break; if (sp > XB_SPIN_CAP) { atomicAdd(&bar[XB_TMO], 1u); break; } }
  }
  nloc = mine > 0u ? mine : 1u; nx = cnt > 0u ? cnt : 1u;
}
DI void xcd_barrier(const XcdBarrier& b) {
  asm volatile("s_waitcnt vmcnt(0)" ::: "memory");
  __syncthreads();
  if (threadIdx.x == 0) {
    unsigned* bar = b.bar;
    __builtin_amdgcn_s_waitcnt(0);
    unsigned nloc = b.st[0], nx = b.st[1];
    if (nloc == 0u) { xcd_barrier_complete(bar, b.x, nloc, nx); b.st[0] = nloc; b.st[1] = nx; }
    const unsigned old = xb_add(&bar[XB_XSUB(b.x)], 1u);
    const unsigned gen = old / nloc;
    if (old + 1u == (gen + 1u) * nloc) {
      __builtin_amdgcn_fence(__ATOMIC_RELEASE, "agent");
      asm volatile("s_waitcnt vmcnt(0)" ::: "memory");
      const unsigned og = xb_add(&bar[XB_TOP], 1u);
      const unsigned tg = og / nx;
      if (og + 1u == (tg + 1u) * nx) xb_add(&bar[XB_TOPGEN], 1u);
      else XB_SPIN(xb_ld(&bar[XB_TOPGEN]) == tg, bar);
      __builtin_amdgcn_fence(__ATOMIC_ACQUIRE, "agent");
      xb_add(&bar[XB_XGEN(b.x)], 1u);
      asm volatile("s_waitcnt vmcnt(0)" ::: "memory");
    } else {
      XB_SPIN(xb_ld(&bar[XB_XGEN(b.x)]) == gen, bar);
      __builtin_amdgcn_fence(__ATOMIC_ACQUIRE, "agent");
      asm volatile("s_waitcnt vmcnt(0)" ::: "memory");
    }
  }
  __syncthreads();
}

template <class Epi>
DI void gemm_tile(const bf16_t* __restrict__ A, int lda, const bf16_t* __restrict__ Bt, int ldb, int K, char* lds, Epi epi) {
  const int tid_full = otid(); const int tid = tid_full & 255; lds += (tid_full >> 8) * HALF_LDS;
  const int lane = tid & 63, w = tid >> 6, l31 = lane & 31, h = lane >> 5;
  const int wr = w >> 1, wc = w & 1;
  const int lrow = tid >> 3, lch = (tid & 7) ^ ((tid >> 4) & 7);
  const bf16_t* ag = A + (size_t)lrow * lda + lch * 8;
  const bf16_t* bg = Bt + (size_t)lrow * ldb + lch * 8;
  const size_t a32 = (size_t)32 * lda, b32 = (size_t)32 * ldb;
  f32x16 acc[2][2];
#pragma unroll
  for (int i = 0; i < 2; ++i)
#pragma unroll
    for (int j = 0; j < 2; ++j)
#pragma unroll
      for (int e = 0; e < 16; ++e) acc[i][j][e] = 0.f;
  const int nk = K >> 6;
  const int rsw = (l31 >> 1) & 7;
  const int aoff = (wr * 64 + l31) * 128, boff = 16384 + (wc * 64 + l31) * 128;
  char* ldst = lds + tid * 16;
#define G_DMA(BUF, KT) { const int ko_ = (KT) * 64; char* nb_ = ldst + (BUF) * 32768; _Pragma("unroll") for (int i = 0; i < 4; ++i) { \
    __builtin_amdgcn_global_load_lds((const unsigned*)(ag + i * a32 + ko_), (__attribute__((address_space(3))) unsigned*)(nb_ + i * 4096), 16, 0, 0); \
    __builtin_amdgcn_global_load_lds((const unsigned*)(bg + i * b32 + ko_), (__attribute__((address_space(3))) unsigned*)(nb_ + 16384 + i * 4096), 16, 0, 0); } }
#define G_COMPUTE(BUF) { const char* cur = lds + (BUF) * 32768; bf16x8 af[2][2], bf[2][2]; \
    { const int off = ((0 + h) ^ rsw) << 4; _Pragma("unroll") for (int i = 0; i < 2; ++i) { af[0][i] = *(const bf16x8*)(cur + aoff + i * 4096 + off); bf[0][i] = *(const bf16x8*)(cur + boff + i * 4096 + off); } } \
    _Pragma("unroll") for (int ks = 0; ks < 4; ++ks) { \
      if (ks < 3) { const int off = ((2 * (ks + 1) + h) ^ rsw) << 4; _Pragma("unroll") for (int i = 0; i < 2; ++i) { af[(ks + 1) & 1][i] = *(const bf16x8*)(cur + aoff + i * 4096 + off); bf[(ks + 1) & 1][i] = *(const bf16x8*)(cur + boff + i * 4096 + off); } } \
      _Pragma("unroll") for (int i = 0; i < 2; ++i) _Pragma("unroll") for (int j = 0; j < 2; ++j) acc[i][j] = MFMA32(bf[ks & 1][j], af[ks & 1][i], acc[i][j]); } }
#define G_WAIT() { asm volatile("s_waitcnt vmcnt(0)" ::: "memory"); __syncthreads(); }
  G_DMA(0, 0);
  G_WAIT();
  for (int kt = 0; kt < nk; kt += 2) {
    if (kt + 1 < nk) G_DMA(1, kt + 1);
    G_COMPUTE(0);
    G_WAIT();
    if (kt + 1 < nk) {
      if (kt + 2 < nk) G_DMA(0, kt + 2);
      G_COMPUTE(1);
      G_WAIT();
    }
  }
#undef G_DMA
#undef G_COMPUTE
#undef G_WAIT
  float* ct = (float*)lds;
#pragma unroll
  for (int i = 0; i < 2; ++i)
#pragma unroll
    for (int j = 0; j < 2; ++j)
#pragma unroll
      for (int q = 0; q < 4; ++q) {
        f32x4 v = {acc[i][j][4 * q], acc[i][j][4 * q + 1], acc[i][j][4 * q + 2], acc[i][j][4 * q + 3]};
        *(f32x4*)(ct + (wr * 64 + i * 32 + l31) * 132 + wc * 64 + j * 32 + 8 * q + 4 * h) = v;
      }
  __syncthreads();
#pragma unroll 4
  for (int it = 0; it < 16; ++it) {
    const int idx = it * 256 + tid; const int row = idx >> 5, c4 = (idx & 31) * 4;
    f32x4 v = *(const f32x4*)(ct + row * 132 + c4);
    epi(row, c4, v);
  }
  __syncthreads();
}


DI int g8_lds_byte(int r, int c) { int st = (r >> 4) * 2 + (c >> 5), rr = r & 15, cc = c & 31, ob = rr * 64 + cc * 2; return st * 1024 + (ob ^ (((ob >> 9) & 1) << 5)); }
DI void g8_stage_rc(int b, int& R, int& C) { int st = b / 1024, sb = b % 1024, swz = sb ^ (((sb >> 9) & 1) << 5); R = (st >> 1) * 16 + swz / 64; C = (st & 1) * 32 + (swz % 64) / 2; }
template <class Epi>
DI void gemm256(const bf16_t* __restrict__ A, int lda, const bf16_t* __restrict__ Bt, int ldb, int K, char* lds, Epi epi) {
  constexpr int BK = 64, HALFR = 128, HTB = HALFR * BK * 2;
  const int tid = otid();
  const int wid = tid >> 6, lane = tid & 63, wr = wid >> 2, wc = wid & 3, fr = lane & 15, fq = lane >> 4;
  const int obs = (fr * 64 + fq * 16) ^ ((((fr * 64 + fq * 16) >> 9) & 1) << 5);
  const char* lrda = lds + wr * 8192 + obs; const char* lrdb = lds + 4 * HTB + wc * 4096 + obs;
  int sr0, sc0, sr1, sc1; g8_stage_rc(tid * 16, sr0, sc0); g8_stage_rc(tid * 16 + 8192, sr1, sc1);
  const unsigned oa0 = (unsigned)(sr0 * lda + sc0) * 2u, oa1 = (unsigned)(sr1 * lda + sc1) * 2u;
#define ob0 oa0
#define ob1 oa1
#define SA8(b, h) (lds + ((b) * 2 + (h)) * HTB)
#define SB8(b, h) (lds + (4 + (b) * 2 + (h)) * HTB)
#define STAGE_A(Pp, br, kt) { const char* g_ = (const char*)(A + (size_t)(br) * lda + (size_t)(kt) * BK); \
    __builtin_amdgcn_global_load_lds((const unsigned*)(g_ + oa0), (LAS unsigned*)((Pp) + tid * 16), 16, 0, 0); \
    __builtin_amdgcn_global_load_lds((const unsigned*)(g_ + oa1), (LAS unsigned*)((Pp) + tid * 16 + 8192), 16, 0, 0); }
#define STAGE_B(Pp, br, kt) { const char* g_ = (const char*)(Bt + (size_t)(br) * ldb + (size_t)(kt) * BK); \
    __builtin_amdgcn_global_load_lds((const unsigned*)(g_ + ob0), (LAS unsigned*)((Pp) + tid * 16), 16, 0, 0); \
    __builtin_amdgcn_global_load_lds((const unsigned*)(g_ + ob1), (LAS unsigned*)((Pp) + tid * 16 + 8192), 16, 0, 0); }
#define LDA8(dst, b, h) _Pragma("unroll") for (int m = 0; m < 4; ++m) _Pragma("unroll") for (int k = 0; k < 2; ++k) \
    dst[m][k] = *(const bf16x8*)(lrda + ((b) * 2 + (h)) * HTB + (2 * m + k) * 1024)
#define LDB8(dst, b, h) _Pragma("unroll") for (int n = 0; n < 2; ++n) _Pragma("unroll") for (int k = 0; k < 2; ++k) \
    dst[n][k] = *(const bf16x8*)(lrdb + ((b) * 2 + (h)) * HTB + (2 * n + k) * 1024)
#define MMA8(ai, bj, AT, BT) { __builtin_amdgcn_s_setprio(1); \
    _Pragma("unroll") for (int m = 0; m < 4; ++m) _Pragma("unroll") for (int n = 0; n < 2; ++n) _Pragma("unroll") for (int k = 0; k < 2; ++k) \
      acc[ai][bj][m][n] = __builtin_amdgcn_mfma_f32_16x16x32_bf16(AT[m][k], BT[n][k], acc[ai][bj][m][n], 0, 0, 0); \
    __builtin_amdgcn_s_setprio(0); }
#define WAIT_V(n) asm volatile("s_waitcnt vmcnt(" #n ")" ::: "memory")
#define WAIT_L(n) asm volatile("s_waitcnt lgkmcnt(" #n ")" ::: "memory")
#define BAR8 __builtin_amdgcn_s_barrier()
#define SCHED8 __builtin_amdgcn_sched_barrier(0)
  f32x4 acc[2][2][4][2];
#pragma unroll
  for (int a = 0; a < 2; ++a)
#pragma unroll
    for (int b = 0; b < 2; ++b)
#pragma unroll
      for (int m = 0; m < 4; ++m)
#pragma unroll
        for (int n = 0; n < 2; ++n) { f32x4 z = {0.f, 0.f, 0.f, 0.f}; acc[a][b][m][n] = z; }
  bf16x8 At[4][2], B0[2][2], B1[2][2];
  const int nt = K / BK;
  WAIT_V(0);
  __syncthreads();
  STAGE_B(SB8(0, 0), 0, 0); STAGE_A(SA8(0, 0), 0, 0);
  STAGE_B(SB8(0, 1), HALFR, 0); STAGE_A(SA8(0, 1), HALFR, 0);
  if (wr == 1) BAR8;
  WAIT_V(4); BAR8;
  STAGE_B(SB8(1, 0), 0, 1); STAGE_A(SA8(1, 0), 0, 1); STAGE_B(SB8(1, 1), HALFR, 1);
  WAIT_V(6); BAR8;
  for (int t = 0; t < nt - 2; t += 2) {
    LDB8(B0, 0, 0); SCHED8; LDA8(At, 0, 0); STAGE_A(SA8(1, 1), HALFR, t + 1);
    WAIT_L(8); BAR8; WAIT_L(0); MMA8(0, 0, At, B0); BAR8; SCHED8;
    LDB8(B1, 0, 1); STAGE_B(SB8(0, 0), 0, t + 2);
    BAR8; WAIT_L(0); MMA8(0, 1, At, B1); BAR8;
    LDA8(At, 0, 1); STAGE_A(SA8(0, 0), 0, t + 2);
    BAR8; WAIT_L(0); MMA8(1, 0, At, B0); BAR8; SCHED8;
    STAGE_B(SB8(0, 1), HALFR, t + 2);
    WAIT_V(6); BAR8; MMA8(1, 1, At, B1); BAR8;
    LDB8(B0, 1, 0); SCHED8; LDA8(At, 1, 0); STAGE_A(SA8(0, 1), HALFR, t + 2);
    WAIT_L(8); BAR8; WAIT_L(0); MMA8(0, 0, At, B0); BAR8; SCHED8;
    LDB8(B1, 1, 1); STAGE_B(SB8(1, 0), 0, t + 3);
    BAR8; WAIT_L(0); MMA8(0, 1, At, B1); BAR8;
    LDA8(At, 1, 1); STAGE_A(SA8(1, 0), 0, t + 3);
    BAR8; WAIT_L(0); MMA8(1, 0, At, B0); BAR8; SCHED8;
    STAGE_B(SB8(1, 1), HALFR, t + 3);
    WAIT_V(6); BAR8; MMA8(1, 1, At, B1); BAR8;
  }
  { LDB8(B0, 0, 0); LDA8(At, 0, 0); STAGE_A(SA8(1, 1), HALFR, nt - 1);
    BAR8; WAIT_L(0); MMA8(0, 0, At, B0); BAR8;
    LDB8(B1, 0, 1); BAR8; WAIT_L(0); MMA8(0, 1, At, B1); BAR8;
    LDA8(At, 0, 1); WAIT_V(4); BAR8; WAIT_L(0); MMA8(1, 0, At, B0); MMA8(1, 1, At, B1); BAR8; }
  { LDB8(B0, 1, 0); LDA8(At, 1, 0); WAIT_V(2); BAR8; WAIT_L(0); MMA8(0, 0, At, B0); BAR8;
    LDB8(B1, 1, 1); WAIT_V(0); BAR8; WAIT_L(0); MMA8(0, 1, At, B1); BAR8;
    LDA8(At, 1, 1); BAR8; WAIT_L(0); MMA8(1, 0, At, B0); MMA8(1, 1, At, B1); BAR8; }
  if (wr == 0) BAR8;
  float* ct = (float*)lds;
#pragma unroll
  for (int ai = 0; ai < 2; ++ai) {
    __syncthreads();
#pragma unroll
    for (int bj = 0; bj < 2; ++bj)
#pragma unroll
      for (int m = 0; m < 4; ++m)
#pragma unroll
        for (int n = 0; n < 2; ++n)
#pragma unroll
          for (int j = 0; j < 4; ++j) ct[(wr * 64 + m * 16 + fq * 4 + j) * 260 + bj * 128 + wc * 32 + n * 16 + fr] = acc[ai][bj][m][n][j];
    __syncthreads();
#pragma unroll 2
    for (int it = 0; it < 16; ++it) {
      const int idx = it * NTHR + tid; const int row = idx >> 6, c4 = (idx & 63) * 4;
      f32x4 v = *(const f32x4*)(ct + row * 260 + c4);
      epi(ai * 128 + row, c4, v);
    }
  }
  __syncthreads();
#undef ob0
#undef ob1
#undef SA8
#undef SB8
#undef STAGE_A
#undef STAGE_B
#undef LDA8
#undef LDB8
#undef MMA8
#undef WAIT_V
#undef WAIT_L
#undef BAR8
#undef SCHED8
}

template <int DQK, bool STATIC>
DI void attn_item(const bf16_t* __restrict__ Q, const bf16_t* __restrict__ Kp, const bf16_t* __restrict__ Vt, int nkeys, char* lds,
                  const bf16_t* __restrict__ Pg, bf16_t* __restrict__ Yg  , float mfix) {
  constexpr int KSTR = DQK * 2 + 16, VSTR = 136, KCH = DQK / 8, NKC = (64 * KCH) / 256, NQS = DQK / 16;
  constexpr int KBUF = 64 * KSTR, BUF = KBUF + 64 * VSTR;
  const int tid_full = otid(); const int tid = tid_full & 255; lds += (tid_full >> 8) * HALF_LDS;
  const int lane = tid & 63, w = tid >> 6, l31 = lane & 31, h = lane >> 5;
  bf16x8 qf[NQS];
#pragma unroll
  for (int ks = 0; ks < NQS; ++ks) qf[ks] = *(const bf16x8*)(Q + (size_t)(32 * w + l31) * DQK + 16 * ks + 8 * h);
  f32x16 o[2];
#pragma unroll
  for (int d = 0; d < 2; ++d)
#pragma unroll
    for (int e = 0; e < 16; ++e) o[d][e] = 0.f;
  float m_run = STATIC ? mfix : -1e30f, l_run = 0.f;
  u32x4 rk[NKC], rv[2];
  int koffg[NKC], koffl[NKC];
#pragma unroll
  for (int i = 0; i < NKC; ++i) { const int c = tid + 256 * i; const int key = c / KCH, part = c % KCH; koffg[i] = c * 8; koffl[i] = key * KSTR + part * 16; }
  const int vdv0 = tid >> 3, vpart = tid & 7;
  const bf16_t* vg = Vt + (size_t)vdv0 * T + vpart * 8;
  const int voffl = KBUF + vdv0 * VSTR + vpart * 16;
  const int nt = nkeys >> 6;
#pragma unroll
  for (int i = 0; i < NKC; ++i) rk[i] = *(const u32x4*)(Kp + koffg[i]);
#pragma unroll
  for (int i = 0; i < 2; ++i) rv[i] = *(const u32x4*)(vg + (size_t)i * 32 * T);
#pragma unroll
  for (int i = 0; i < NKC; ++i) *(u32x4*)(lds + koffl[i]) = rk[i];
#pragma unroll
  for (int i = 0; i < 2; ++i) { u32x2 a = {rv[i].x, rv[i].y}, b = {rv[i].z, rv[i].w}; *(u32x2*)(lds + voffl + i * 32 * VSTR) = a; *(u32x2*)(lds + voffl + i * 32 * VSTR + 8) = b; }
  __syncthreads();
  for (int j = 0; j < nt; ++j) {
    char* cur = lds + (j & 1) * BUF;
    const bool more = (j + 1 < nt);
    if (more) {
#pragma unroll
      for (int i = 0; i < NKC; ++i) rk[i] = *(const u32x4*)(Kp + (size_t)(j + 1) * 64 * DQK + koffg[i]);
#pragma unroll
      for (int i = 0; i < 2; ++i) rv[i] = *(const u32x4*)(vg + (size_t)i * 32 * T + (j + 1) * 64);
    }
    f32x16 s0, s1;
    bf16x8 kf[2][NQS];
#pragma unroll
    for (int kb = 0; kb < 2; ++kb)
#pragma unroll
      for (int ks = 0; ks < NQS; ++ks) kf[kb][ks] = *(const bf16x8*)(cur + (32 * kb + l31) * KSTR + (2 * ks + h) * 16);
    u32x4 vw[2][2][2];
#pragma unroll
    for (int kb = 0; kb < 2; ++kb)
#pragma unroll
      for (int s2 = 0; s2 < 2; ++s2)
#pragma unroll
        for (int d = 0; d < 2; ++d) {
          const char* vp = cur + KBUF + (32 * d + l31) * VSTR + (32 * kb + 16 * s2 + 4 * h) * 2;
          u32x2 v0 = *(const u32x2*)vp, v1 = *(const u32x2*)(vp + 16);
          u32x4 t4 = {v0.x, v0.y, v1.x, v1.y}; vw[kb][s2][d] = t4;
        }
#pragma unroll
    for (int e = 0; e < 16; ++e) { s0[e] = STATIC ? -mfix : 0.f; s1[e] = STATIC ? -mfix : 0.f; }
#pragma unroll
    for (int ks = 0; ks < NQS; ++ks) s0 = MFMA32(kf[0][ks], qf[ks], s0);
    if (!STATIC) {
      float mx = s0[0];
#pragma unroll
      for (int e = 1; e < 16; ++e) mx = fmaxf(mx, s0[e]);
      mx = fmaxf(mx, __shfl_xor(mx, 32));
      if (!__all(mx <= m_run + 8.f)) {
        const float m_new = fmaxf(m_run, mx);
        const float alpha = __builtin_amdgcn_exp2f(m_run - m_new);
        m_run = m_new; l_run *= alpha;
#pragma unroll
        for (int d = 0; d < 2; ++d)
#pragma unroll
          for (int e = 0; e < 16; ++e) o[d][e] *= alpha;
      }
    }
#pragma unroll
    for (int ks = 0; ks < NQS; ++ks) s1 = MFMA32(kf[1][ks], qf[ks], s1);
    {
      float ps = 0.f;
#pragma unroll
      for (int e = 0; e < 16; ++e) { float p = STATIC ? __builtin_amdgcn_exp2f(s0[e]) : __builtin_amdgcn_exp2f(s0[e] - m_run); s0[e] = p; ps += p; }
      l_run += ps;
    }
    if (!STATIC) {
      float mx = s1[0];
#pragma unroll
      for (int e = 1; e < 16; ++e) mx = fmaxf(mx, s1[e]);
      mx = fmaxf(mx, __shfl_xor(mx, 32));
      if (!__all(mx <= m_run + 8.f)) {
        const float m_new = fmaxf(m_run, mx);
        const float alpha = __builtin_amdgcn_exp2f(m_run - m_new);
        m_run = m_new; l_run *= alpha;
#pragma unroll
        for (int e = 0; e < 16; ++e) s0[e] *= alpha;
#pragma unroll
        for (int d = 0; d < 2; ++d)
#pragma unroll
          for (int e = 0; e < 16; ++e) o[d][e] *= alpha;
      }
    }
#pragma unroll
    for (int s2 = 0; s2 < 2; ++s2) {
      u32x4 pw = {cvtpk(s0[8 * s2], s0[8 * s2 + 1]), cvtpk(s0[8 * s2 + 2], s0[8 * s2 + 3]), cvtpk(s0[8 * s2 + 4], s0[8 * s2 + 5]), cvtpk(s0[8 * s2 + 6], s0[8 * s2 + 7])};
      bf16x8 pf = __builtin_bit_cast(bf16x8, pw);
#pragma unroll
      for (int d = 0; d < 2; ++d) o[d] = MFMA32(__builtin_bit_cast(bf16x8, vw[0][s2][d]), pf, o[d]);
    }
    {
      float ps = 0.f;
#pragma unroll
      for (int e = 0; e < 16; ++e) { float p = STATIC ? __builtin_amdgcn_exp2f(s1[e]) : __builtin_amdgcn_exp2f(s1[e] - m_run); s1[e] = p; ps += p; }
      l_run += ps;
    }
#pragma unroll
    for (int s2 = 0; s2 < 2; ++s2) {
      u32x4 pw = {cvtpk(s1[8 * s2], s1[8 * s2 + 1]), cvtpk(s1[8 * s2 + 2], s1[8 * s2 + 3]), cvtpk(s1[8 * s2 + 4], s1[8 * s2 + 5]), cvtpk(s1[8 * s2 + 6], s1[8 * s2 + 7])};
      bf16x8 pf = __builtin_bit_cast(bf16x8, pw);
#pragma unroll
      for (int d = 0; d < 2; ++d) o[d] = MFMA32(__builtin_bit_cast(bf16x8, vw[1][s2][d]), pf, o[d]);
    }
    if (more) {
      char* nxt = lds + ((j + 1) & 1) * BUF;
#pragma unroll
      for (int i = 0; i < NKC; ++i) *(u32x4*)(nxt + koffl[i]) = rk[i];
#pragma unroll
      for (int i = 0; i < 2; ++i) { u32x2 a = {rv[i].x, rv[i].y}, b = {rv[i].z, rv[i].w}; *(u32x2*)(nxt + voffl + i * 32 * VSTR) = a; *(u32x2*)(nxt + voffl + i * 32 * VSTR + 8) = b; }
    }
    __syncthreads();
  }
  const float lt = l_run + __shfl_xor(l_run, 32);
  const float inv = 1.f / lt;
  const size_t rq = (size_t)(32 * w + l31);
#pragma unroll
  for (int d = 0; d < 2; ++d)
#pragma unroll
    for (int q = 0; q < 4; ++q) {
      const int dv = 32 * d + 8 * q + 4 * h;
      f32x4 g = unpack4(*(const u32x2*)(Pg + rq * NIN + dv));
      f32x4 v = {o[d][4 * q] * inv * silu(g[0]), o[d][4 * q + 1] * inv * silu(g[1]), o[d][4 * q + 2] * inv * silu(g[2]), o[d][4 * q + 3] * inv * silu(g[3])};
      *(u32x2*)(Yg + rq * 1024 + dv) = pack4(v);
    }
}

template <int DQK, bool STATIC>
DI void attn_item8(const bf16_t* __restrict__ Q, const bf16_t* __restrict__ Kp, const bf16_t* __restrict__ Vt, int nkeys, char* lds,
                  const bf16_t* __restrict__ Pg, bf16_t* __restrict__ Yg  , float mfix) {
  constexpr int KSTR = DQK * 2 + 16, VSTR = 136, KCH = DQK / 8, NKC = (64 * KCH + 511) / 512, NQS = DQK / 16;
  constexpr int KBUF = 64 * KSTR, BUF = KBUF + 64 * VSTR;
  const int tid = otid();
  const int lane = tid & 63, w = tid >> 6, l31 = lane & 31, h = lane >> 5;
  bf16x8 qf[NQS];
#pragma unroll
  for (int ks = 0; ks < NQS; ++ks) qf[ks] = *(const bf16x8*)(Q + (size_t)(32 * w + l31) * DQK + 16 * ks + 8 * h);
  f32x16 o[2];
#pragma unroll
  for (int d = 0; d < 2; ++d)
#pragma unroll
    for (int e = 0; e < 16; ++e) o[d][e] = 0.f;
  float m_run = STATIC ? mfix : -1e30f, l_run = 0.f;
  u32x4 rk[NKC], rv[1];
  int koffg[NKC], koffl[NKC];
#pragma unroll
  for (int i = 0; i < NKC; ++i) { const int c = tid + 512 * i; const int key = c / KCH, part = c % KCH; koffg[i] = (c < 64 * KCH) ? c * 8 : 0; koffl[i] = (c < 64 * KCH) ? key * KSTR + part * 16 : -1; }
  const int vdv0 = tid >> 3, vpart = tid & 7;
  const bf16_t* vg = Vt + (size_t)vdv0 * T + vpart * 8;
  const int voffl = KBUF + vdv0 * VSTR + vpart * 16;
  const int nt = nkeys >> 6;
#pragma unroll
  for (int i = 0; i < NKC; ++i) rk[i] = *(const u32x4*)(Kp + koffg[i]);
#pragma unroll
  for (int i = 0; i < 1; ++i) rv[i] = *(const u32x4*)(vg + (size_t)i * 32 * T);
#pragma unroll
  for (int i = 0; i < NKC; ++i) if (koffl[i] >= 0) *(u32x4*)(lds + koffl[i]) = rk[i];
#pragma unroll
  for (int i = 0; i < 1; ++i) { u32x2 a = {rv[i].x, rv[i].y}, b = {rv[i].z, rv[i].w}; *(u32x2*)(lds + voffl + i * 32 * VSTR) = a; *(u32x2*)(lds + voffl + i * 32 * VSTR + 8) = b; }
  {
#pragma unroll
    for (int i = 0; i < NKC; ++i) rk[i] = *(const u32x4*)(Kp + (size_t)64 * DQK + koffg[i]);
    rv[0] = *(const u32x4*)(vg + 64);
#pragma unroll
    for (int i = 0; i < NKC; ++i) if (koffl[i] >= 0) *(u32x4*)(lds + BUF + koffl[i]) = rk[i];
    { u32x2 a = {rv[0].x, rv[0].y}, b = {rv[0].z, rv[0].w}; *(u32x2*)(lds + BUF + voffl) = a; *(u32x2*)(lds + BUF + voffl + 8) = b; }
  }
  __syncthreads();
  const int np = nt >> 1;
  for (int jj = 0; jj < np; ++jj) {
   char* curp = lds + (jj & 1) * 2 * BUF; char* nxtp = lds + ((jj + 1) & 1) * 2 * BUF;
   const bool more = (jj + 1 < np);
#pragma nounroll
   for (int sub = 0; sub < 2; ++sub) {
    const char* cur = curp + sub * BUF;
    const int j = 2 * jj + sub + 1;
    if (more) {
#pragma unroll
      for (int i = 0; i < NKC; ++i) rk[i] = *(const u32x4*)(Kp + (size_t)(j + 1) * 64 * DQK + koffg[i]);
#pragma unroll
      for (int i = 0; i < 1; ++i) rv[i] = *(const u32x4*)(vg + (size_t)i * 32 * T + (j + 1) * 64);
    }
    f32x16 s0, s1;
    bf16x8 kf[2][NQS];
#pragma unroll
    for (int kb = 0; kb < 2; ++kb)
#pragma unroll
      for (int ks = 0; ks < NQS; ++ks) kf[kb][ks] = *(const bf16x8*)(cur + (32 * kb + l31) * KSTR + (2 * ks + h) * 16);
    u32x4 vw[2][2][2];
#pragma unroll
    for (int kb = 0; kb < 2; ++kb)
#pragma unroll
      for (int s2 = 0; s2 < 2; ++s2)
#pragma unroll
        for (int d = 0; d < 2; ++d) {
          const char* vp = cur + KBUF + (32 * d + l31) * VSTR + (32 * kb + 16 * s2 + 4 * h) * 2;
          u32x2 v0 = *(const u32x2*)vp, v1 = *(const u32x2*)(vp + 16);
          u32x4 t4 = {v0.x, v0.y, v1.x, v1.y}; vw[kb][s2][d] = t4;
        }
#pragma unroll
    for (int e = 0; e < 16; ++e) { s0[e] = STATIC ? -mfix : 0.f; s1[e] = STATIC ? -mfix : 0.f; }
#pragma unroll
    for (int ks = 0; ks < NQS; ++ks) s0 = MFMA32(kf[0][ks], qf[ks], s0);
    if (!STATIC) {
      float mx = s0[0];
#pragma unroll
      for (int e = 1; e < 16; ++e) mx = fmaxf(mx, s0[e]);
      mx = fmaxf(mx, __shfl_xor(mx, 32));
      if (!__all(mx <= m_run + 8.f)) {
        const float m_new = fmaxf(m_run, mx);
        const float alpha = __builtin_amdgcn_exp2f(m_run - m_new);
        m_run = m_new; l_run *= alpha;
#pragma unroll
        for (int d = 0; d < 2; ++d)
#pragma unroll
          for (int e = 0; e < 16; ++e) o[d][e] *= alpha;
      }
    }
#pragma unroll
    for (int ks = 0; ks < NQS; ++ks) s1 = MFMA32(kf[1][ks], qf[ks], s1);
    {
      float ps = 0.f;
#pragma unroll
      for (int e = 0; e < 16; ++e) { float p = STATIC ? __builtin_amdgcn_exp2f(s0[e]) : __builtin_amdgcn_exp2f(s0[e] - m_run); s0[e] = p; ps += p; }
      l_run += ps;
    }
    if (!STATIC) {
      float mx = s1[0];
#pragma unroll
      for (int e = 1; e < 16; ++e) mx = fmaxf(mx, s1[e]);
      mx = fmaxf(mx, __shfl_xor(mx, 32));
      if (!__all(mx <= m_run + 8.f)) {
        const float m_new = fmaxf(m_run, mx);
        const float alpha = __builtin_amdgcn_exp2f(m_run - m_new);
        m_run = m_new; l_run *= alpha;
#pragma unroll
        for (int e = 0; e < 16; ++e) s0[e] *= alpha;
#pragma unroll
        for (int d = 0; d < 2; ++d)
#pragma unroll
          for (int e = 0; e < 16; ++e) o[d][e] *= alpha;
      }
    }
#pragma unroll
    for (int s2 = 0; s2 < 2; ++s2) {
      u32x4 pw = {cvtpk(s0[8 * s2], s0[8 * s2 + 1]), cvtpk(s0[8 * s2 + 2], s0[8 * s2 + 3]), cvtpk(s0[8 * s2 + 4], s0[8 * s2 + 5]), cvtpk(s0[8 * s2 + 6], s0[8 * s2 + 7])};
      bf16x8 pf = __builtin_bit_cast(bf16x8, pw);
#pragma unroll
      for (int d = 0; d < 2; ++d) o[d] = MFMA32(__builtin_bit_cast(bf16x8, vw[0][s2][d]), pf, o[d]);
    }
    {
      float ps = 0.f;
#pragma unroll
      for (int e = 0; e < 16; ++e) { float p = STATIC ? __builtin_amdgcn_exp2f(s1[e]) : __builtin_amdgcn_exp2f(s1[e] - m_run); s1[e] = p; ps += p; }
      l_run += ps;
    }
#pragma unroll
    for (int s2 = 0; s2 < 2; ++s2) {
      u32x4 pw = {cvtpk(s1[8 * s2], s1[8 * s2 + 1]), cvtpk(s1[8 * s2 + 2], s1[8 * s2 + 3]), cvtpk(s1[8 * s2 + 4], s1[8 * s2 + 5]), cvtpk(s1[8 * s2 + 6], s1[8 * s2 + 7])};
      bf16x8 pf = __builtin_bit_cast(bf16x8, pw);
#pragma unroll
      for (int d = 0; d < 2; ++d) o[d] = MFMA32(__builtin_bit_cast(bf16x8, vw[1][s2][d]), pf, o[d]);
    }
    if (more) {
      char* nxt = nxtp + sub * BUF;
#pragma unroll
      for (int i = 0; i < NKC; ++i) if (koffl[i] >= 0) *(u32x4*)(nxt + koffl[i]) = rk[i];
#pragma unroll
      for (int i = 0; i < 1; ++i) { u32x2 a = {rv[i].x, rv[i].y}, b = {rv[i].z, rv[i].w}; *(u32x2*)(nxt + voffl + i * 32 * VSTR) = a; *(u32x2*)(nxt + voffl + i * 32 * VSTR + 8) = b; }
    }
   }
   __syncthreads();
  }
  const float lt = l_run + __shfl_xor(l_run, 32);
  const float inv = 1.f / lt;
  const size_t rq = (size_t)(32 * w + l31);
#pragma unroll
  for (int d = 0; d < 2; ++d)
#pragma unroll
    for (int q = 0; q < 4; ++q) {
      const int dv = 32 * d + 8 * q + 4 * h;
      f32x4 g = unpack4(*(const u32x2*)(Pg + rq * NIN + dv));
      f32x4 v = {o[d][4 * q] * inv * silu(g[0]), o[d][4 * q + 1] * inv * silu(g[1]), o[d][4 * q + 2] * inv * silu(g[2]), o[d][4 * q + 3] * inv * silu(g[3])};
      *(u32x2*)(Yg + rq * 1024 + dv) = pack4(v);
    }
}

DI void xpose_cvt(const float* __restrict__ src, bf16_t* __restrict__ dst, int K, int N, int Npad, bool perm_kv, size_t gtid, size_t gstride) {
  const size_t total = (size_t)Npad * (K >> 3);
#pragma nounroll
  for (size_t i = gtid; i < total; i += gstride) {
    const int n = (int)(i % Npad), kb = (int)(i / Npad);
    float v[8];
#pragma unroll
    for (int e = 0; e < 8; ++e) v[e] = (n < N) ? src[(size_t)(8 * kb + e) * N + n] : 0.f;
    int row = n;
    if (perm_kv) { const int hh = n >> 7, wv = n & 127; row = (wv < 64) ? (64 * hh + wv) : (256 + 64 * hh + (wv - 64)); }
    u32x4 o = {cvtpk(v[0], v[1]), cvtpk(v[2], v[3]), cvtpk(v[4], v[5]), cvtpk(v[6], v[7])};
    *(u32x4*)(dst + (size_t)row * K + 8 * kb) = o;
  }
}

DI void phase0(KP p, char* lds) {
  unsigned char* ws = p->ws; asm volatile("" : "+s"(ws));
  const int tid = otid();
  const size_t gtid = (size_t)blockIdx.x * NTHR + tid, gstride = (size_t)gridDim.x * NTHR;
  for (int l = 0; l < 2; ++l) {
    xpose_cvt(p->w_in + (size_t)l * 1024 * NIN, (bf16_t*)(ws + WS_WIN) + (size_t)l * NINP * 1024, 1024, NIN, NINP, false, gtid, gstride);
    xpose_cvt(p->mla_w_uq + (size_t)l * 192 * 384, (bf16_t*)(ws + WS_WUQ) + (size_t)l * 384 * 192, 192, 384, 384, false, gtid, gstride);
    xpose_cvt(p->mla_w_ukv + (size_t)l * 128 * 512, (bf16_t*)(ws + WS_WUKV) + (size_t)l * 512 * 128, 128, 512, 512, true, gtid, gstride);
    xpose_cvt(p->fnet_w + (size_t)l * 256 * 256, (bf16_t*)(ws + WS_WF) + (size_t)l * 256 * 256, 256, 256, 256, false, gtid, gstride);
    xpose_cvt(p->w_out + (size_t)l * 1024 * 1024, (bf16_t*)(ws + WS_WOUT) + (size_t)l * 1024 * 1024, 1024, 1024, 1024, false, gtid, gstride);
  }
  {
    const float* src = p->cm_w_s; bf16_t* dst = (bf16_t*)(ws + WS_WS);
    for (size_t i = gtid; i < (size_t)2 * 4 * 128 * 128 / 8; i += gstride) {
      f32x4 a = *(const f32x4*)(src + i * 8), b = *(const f32x4*)(src + i * 8 + 4);
      u32x4 o = {cvtpk(a[0], a[1]), cvtpk(a[2], a[3]), cvtpk(b[0], b[1]), cvtpk(b[2], b[3])};
      *(u32x4*)(dst + i * 8) = o;
    }
  }
  {
    bf16_t* dl = (bf16_t*)(ws + WS_DLAT);
#pragma nounroll
    for (size_t i = gtid; i < (size_t)2048 * 256; i += gstride) {
      const int sp = (int)(i >> 8), k8 = (int)(i & 255) * 8;
      float v[8];
#pragma unroll
      for (int e = 0; e < 8; ++e) { const int k = k8 + e, s = (k <= 1024) ? k : k - 1024; const int ph = (sp * s) & 2047; const float a = (float)ph * (1.f / 1024.f); v[e] = (k <= 1024) ? cospif(a) : -sinpif(a); }
      u32x4 o = {cvtpk(v[0], v[1]), cvtpk(v[2], v[3]), cvtpk(v[4], v[5]), cvtpk(v[6], v[7])};
      *(u32x4*)(dl + (size_t)sp * 2048 + k8) = o;
    }
    bf16_t* dc = (bf16_t*)(ws + WS_DCTX);
    for (size_t i = gtid; i < (size_t)256 * 64; i += gstride) {
      const int sp = (int)(i >> 6), k8 = (int)(i & 63) * 8;
      float v[8];
#pragma unroll
      for (int e = 0; e < 8; ++e) { const int k = k8 + e, s = k & 255; const int ph = (sp * s) & 255; const float a = (float)ph * (1.f / 128.f); v[e] = (k < 256) ? cospif(a) : -sinpif(a); }
      u32x4 o = {cvtpk(v[0], v[1]), cvtpk(v[2], v[3]), cvtpk(v[4], v[5]), cvtpk(v[6], v[7])};
      *(u32x4*)(dc + (size_t)sp * 512 + k8) = o;
    }
    bf16_t* cm = (bf16_t*)(ws + WS_CM);
    for (size_t i = gtid; i < (size_t)128 * 64; i += gstride) {
      const int n = (int)(i >> 6), c = (int)(i & 63);
      const int ph = (c * (n & 63)) & 63; const float a = (float)ph * (1.f / 32.f);
      cm[i] = f2bf((n < 64) ? cospif(a) : sinpif(a));
    }
    float* rg = (float*)(ws + WS_ROPG);
    for (size_t i = gtid; i < 64 * 16; i += gstride) {
      const int pos = (int)(i >> 4), j = (int)(i & 15);
      const float inv = powf(10000.f, -(float)j / 16.f); float sn, cs; sincosf((float)pos * inv, &sn, &cs);
      rg[2 * i] = cs; rg[2 * i + 1] = sn;
    }
    if (blockIdx.x == 0 && tid < 4) {
      const int l = tid >> 1, isb = tid & 1; const int d = isb ? 64 : 96;
      const float* gq = (isb ? p->gqa_qn : p->mla_qn) + l * d; const float* gk = (isb ? p->gqa_kn : p->mla_kn) + l * d;
      float mq = 0.f, mk = 0.f;
      for (int i = 0; i < d; ++i) { mq = fmaxf(mq, fabsf(gq[i])); mk = fmaxf(mk, fabsf(gk[i])); }
      ((float*)(ws + WS_SBND))[l * 2 + isb] = sqrtf((float)d) * mq * mk * 1.4426950408889634f;
    }
    float* rm = (float*)(ws + WS_ROPM);
    for (size_t i = gtid; i < 64 * 8; i += gstride) {
      const int pos = (int)(i >> 3), j = (int)(i & 7);
      const float inv = powf(10000.f, -(float)j / 8.f); float sn, cs; sincosf((float)pos * inv, &sn, &cs);
      rm[2 * i] = cs; rm[2 * i + 1] = sn;
    }
  }
  const int hb = tid >> 8, tq = tid & 255;
  float* sl = (float*)(lds + hb * HALF_LDS);
  float* mod = (float*)(ws + WS_MOD);
  const int kg = tq >> 5, cn = tq & 31;
  for (int it = 2 * blockIdx.x + hb; it < 192; it += 2 * gridDim.x) {
    const int l = it / 96, n = (it % 96) * 32 + cn;
    float acc[17];
#pragma unroll
    for (int i = 0; i < 17; ++i) acc[i] = 0.f;
    for (int half = 0; half < 2; ++half) {
      __syncthreads();
      for (int e = tq; e < 17 * 512; e += 256) {
        const int i = e >> 9, k = (e & 511) + 512 * half;
        const float cv = (i < 16) ? p->c[i * 1024 + k] : p->c_ctx[k];
        sl[e] = silu(cv);
      }
      __syncthreads();
      const float* wp = p->w_mod + ((size_t)l * 1024 + 512 * half + kg * 64) * 3072 + n;
#pragma unroll 4
      for (int kk = 0; kk < 64; ++kk) {
        const float wv = wp[(size_t)kk * 3072];
#pragma unroll
        for (int i = 0; i < 17; ++i) acc[i] = fmaf(sl[i * 512 + kg * 64 + kk], wv, acc[i]);
      }
    }
    __syncthreads();
#pragma unroll
    for (int i = 0; i < 17; ++i) sl[(kg * 17 + i) * 32 + cn] = acc[i];
    __syncthreads();
    for (int e = tq; e < 17 * 32; e += 256) {
      const int i = e >> 5, c2 = e & 31;
      float s = 0.f;
#pragma unroll
      for (int g = 0; g < 8; ++g) s += sl[(g * 17 + i) * 32 + c2];
      const int nn = (it % 96) * 32 + c2;
      mod[((size_t)l * 17 + i) * 3072 + nn] = s + p->b_mod[l * 3072 + nn];
    }
    __syncthreads();
  }
}

DI void phase_norm(KP p, int l) {
  unsigned char* ws = p->ws; asm volatile("" : "+s"(ws));
  const float* xl = (l == 0) ? p->x : p->out;
  const float* xc = (l == 0) ? p->ctx : (const float*)(ws + WS_CTX1);
  const float* g = p->norm_g + l * 1024;
  const float* mod = (const float*)(ws + WS_MOD) + (size_t)l * 17 * 3072;
  bf16_t* hx = (bf16_t*)(ws + WS_R1);
  const int tid = otid(); const int lane = tid & 63;
  const int gw = blockIdx.x * (NTHR / 64) + (tid >> 6), nw = gridDim.x * (NTHR / 64);
  const int rpw = (M + nw - 1) / nw;
  int cur_mod = -1;
  f32x4 G[4], SH[4];
#pragma unroll 2
  for (int r = gw * rpw; r < min(M, (gw + 1) * rpw); ++r) {
    const int b = r / T, t = r % T;
    const float* src = (t < SEQ) ? xl + ((size_t)b * SEQ + t) * 1024 : xc + ((size_t)b * CL + (t - SEQ)) * 1024;
    const int mrow = (t < SEQ) ? b : 16;
    if (mrow != cur_mod) {
      cur_mod = mrow;
      const float* mr = mod + (size_t)mrow * 3072;
#pragma unroll
      for (int i = 0; i < 4; ++i) {
        const int k = i * 256 + lane * 4;
        const f32x4 gg = *(const f32x4*)(g + k), sc = *(const f32x4*)(mr + 1024 + k);
        SH[i] = *(const f32x4*)(mr + k);
#pragma unroll
        for (int e = 0; e < 4; ++e) G[i][e] = gg[e] * (1.f + sc[e]);
      }
    }
    f32x4 v[4]; float ss = 0.f;
#pragma unroll
    for (int i = 0; i < 4; ++i) { v[i] = *(const f32x4*)(src + i * 256 + lane * 4); ss += v[i][0] * v[i][0] + v[i][1] * v[i][1] + v[i][2] * v[i][2] + v[i][3] * v[i][3]; }
    ss = red64(ss);
    const float rstd = rsqrtf(ss * (1.f / 1024.f) + 1e-6f);
#pragma unroll
    for (int i = 0; i < 4; ++i) {
      const int k = i * 256 + lane * 4;
      f32x4 o;
#pragma unroll
      for (int e = 0; e < 4; ++e) o[e] = v[i][e] * rstd * G[i][e] + SH[i][e];
      *(u32x2*)(hx + (size_t)r * 1024 + k) = pack4(o);
    }
  }
}

DI void phase_inproj(KP p, int l, char* lds) {
  unsigned char* ws = p->ws; asm volatile("" : "+s"(ws));
  const bf16_t* hx = (const bf16_t*)(ws + WS_R1);
  const bf16_t* wt = (const bf16_t*)(ws + WS_WIN) + (size_t)l * NINP * 1024;
  bf16_t* P = (bf16_t*)(ws + WS_P);
  const int xcd = blockIdx.x & 7, lb = blockIdx.x >> 3, nlb = gridDim.x >> 3, hb = __builtin_amdgcn_readfirstlane(otid() >> 8);
  constexpr int NBIG = 18 * 10;
  for (int j = lb; j < NBIG + 18; j += nlb) {
    if (j < NBIG) {
      int mloc, ntile;
      if (j < 144) { mloc = (j % 72) >> 2; ntile = (j / 72) * 4 + (j & 3); } else { const int j2 = j - 144; mloc = j2 >> 1; ntile = 8 + (j2 & 1); }
      const int mt = 18 * xcd + mloc;
      if (l == 1 && (mt % 9) == 8 && !(ntile == 0 || ntile == 1 || ntile == 3 || ntile == 4)) continue;
      const int m0 = mt * 256, n0 = ntile * 256;
      gemm256(hx + (size_t)m0 * 1024, 1024, wt + (size_t)n0 * 1024, 1024, 1024, lds, [&](int m, int n, f32x4 v) {
        __builtin_nontemporal_store(pack4(v), (u32x2*)(P + (size_t)(m0 + m) * NIN + n0 + n));
      });
    } else {
      const int mt = 36 * xcd + 2 * (j - NBIG) + hb;
      if (l == 1 && (mt % 18) >= 16) continue;
      const int m0 = mt * 128;
      gemm_tile(hx + (size_t)m0 * 1024, 1024, wt + (size_t)2560 * 1024, 1024, 1024, lds, [&](int m, int n, f32x4 v) {
        if (2560 + n < NIN) __builtin_nontemporal_store(pack4(v), (u32x2*)(P + (size_t)(m0 + m) * NIN + 2560 + n));
      });
    }
  }
}

DI void rope4(f32x4& v, int u, const float sg, const float* cs) {
#pragma unroll
  for (int e = 0; e < 4; ++e) {
    const float xp = __shfl_xor(v[e], 4);
    v[e] = v[e] * cs[2 * e] + sg * xp * cs[2 * e + 1];
  }
}
DI void rope2(float& a, float& b, const float sg, const f32x4 cs) {
  const float ap = __shfl_xor(a, 4), bp = __shfl_xor(b, 4);
  a = a * cs[0] + sg * ap * cs[1];
  b = b * cs[2] + sg * bp * cs[3];
}

DI void phase_feat_a(KP p, int l, char* lds) {
  unsigned char* ws = p->ws; asm volatile("" : "+s"(ws));
  const bf16_t* P = (const bf16_t*)(ws + WS_P);
  bf16_t* cqn = (bf16_t*)(ws + WS_R1 + R1_CQN);
  bf16_t* ckvn = (bf16_t*)(ws + WS_R1 + R1_CKVN);
  bf16_t* QB = (bf16_t*)(ws + WS_QB); bf16_t* KB = (bf16_t*)(ws + WS_KB); bf16_t* VBT = (bf16_t*)(ws + WS_VBT);
  bf16_t* vnT = (bf16_t*)(ws + WS_VNT);
  const float* rg = (const float*)(ws + WS_ROPG);
  const int tid = otid(); const int lane = tid & 63, u = lane & 15, sub = lane >> 4;
  const int gw = blockIdx.x * (NTHR / 64) + (tid >> 6), nw = gridDim.x * (NTHR / 64);
  const int hb = tid >> 8, tq = tid & 255; char* ldh = lds + hb * HALF_LDS;
  {
    constexpr int STR = 144;
    const float* lg = p->cm_ln_g + l * 256; const float* lbp = p->cm_ln_b + l * 256;
    for (int unit = 2 * blockIdx.x + hb; unit < (M / 64) * 2; unit += 2 * gridDim.x) {
      const int grp = unit >> 1; const bool isv2 = unit & 1;
      const int r0 = grp * 64; const int b = r0 / T, t0 = r0 % T;
      if (!isv2) {
        const int c = tq & 31, rb = 2 * (tq >> 5);
        f32x4 g0 = *(const f32x4*)(lg + 8 * c), g1 = *(const f32x4*)(lg + 8 * c + 4), b0 = *(const f32x4*)(lbp + 8 * c), b1 = *(const f32x4*)(lbp + 8 * c + 4);
        const float gg[8] = {g0[0], g0[1], g0[2], g0[3], g1[0], g1[1], g1[2], g1[3]};
        const float bb[8] = {b0[0], b0[1], b0[2], b0[3], b1[0], b1[1], b1[2], b1[3]};
#pragma unroll
        for (int i = 0; i < 4; ++i) {
          float vn[2][8];
#pragma unroll
          for (int rr = 0; rr < 2; ++rr) {
            const int row = rb + 16 * i + rr;
            u32x4 q = *(const u32x4*)(P + (size_t)(r0 + row) * NIN + O_V + 8 * c);
            float f[8] = {bflo(q.x), bfhi(q.x), bflo(q.y), bfhi(q.y), bflo(q.z), bfhi(q.z), bflo(q.w), bfhi(q.w)};
            float s1 = 0.f, s2 = 0.f;
#pragma unroll
            for (int e = 0; e < 8; ++e) { s1 += f[e]; s2 += f[e] * f[e]; }
#pragma unroll
            for (int m = 1; m < 32; m <<= 1) { s1 += __shfl_xor(s1, m); s2 += __shfl_xor(s2, m); }
            const float mu = s1 * (1.f / 256.f); const float var = fmaxf(s2 * (1.f / 256.f) - mu * mu, 0.f); const float rs = rsqrtf(var + 1e-6f);
#pragma unroll
            for (int e = 0; e < 8; ++e) vn[rr][e] = (f[e] - mu) * rs * gg[e] + bb[e];
          }
#pragma unroll
          for (int e = 0; e < 8; ++e) *(unsigned*)(ldh + (8 * c + e) * STR + (rb + 16 * i) * 2) = cvtpk(vn[0][e], vn[1][e]);
        }
        __syncthreads();
        bf16_t* vo = vnT + (size_t)(r0 >> 7) * 256 * 128 + (r0 & 127);
#pragma unroll
        for (int i = 0; i < 8; ++i) {
          const int ch = (tq >> 3) + 32 * i, part = tq & 7;
          *(u32x4*)(vo + (size_t)ch * 128 + part * 8) = *(const u32x4*)(ldh + ch * STR + part * 16);
        }
      } else {
        const int c = tq & 15, rb = 2 * (tq >> 4);
#pragma unroll
        for (int i = 0; i < 2; ++i) {
          u32x4 q0 = *(const u32x4*)(P + (size_t)(r0 + rb + 32 * i) * NIN + O_V2 + 8 * c);
          u32x4 q1 = *(const u32x4*)(P + (size_t)(r0 + rb + 32 * i + 1) * NIN + O_V2 + 8 * c);
          const unsigned a[4] = {q0.x, q0.y, q0.z, q0.w}, d[4] = {q1.x, q1.y, q1.z, q1.w};
#pragma unroll
          for (int e = 0; e < 4; ++e) {
            *(unsigned*)(ldh + (8 * c + 2 * e) * STR + (rb + 32 * i) * 2) = (a[e] & 0xffffu) | (d[e] << 16);
            *(unsigned*)(ldh + (8 * c + 2 * e + 1) * STR + (rb + 32 * i) * 2) = (a[e] >> 16) | (d[e] & 0xffff0000u);
          }
        }
        __syncthreads();
        bf16_t* vb = VBT + (size_t)b * 2 * 64 * T + t0;
#pragma unroll
        for (int i = 0; i < 4; ++i) {
          const int ch = (tq >> 3) + 32 * i, part = tq & 7;
          *(u32x4*)(vb + (size_t)ch * T + part * 8) = *(const u32x4*)(ldh + ch * STR + part * 16);
        }
      }
      __syncthreads();
    }
  }
  constexpr int NTA = M / 4;
  f32x4 gcq[3], gckv[2];
#pragma unroll
  for (int e = 0; e < 3; ++e) gcq[e] = *(const f32x4*)(p->mla_q_norm + l * 192 + 12 * u + 4 * e);
#pragma unroll
  for (int e = 0; e < 2; ++e) gckv[e] = *(const f32x4*)(p->mla_kv_norm + l * 128 + 8 * u + 4 * e);
#pragma unroll 4
  for (int task = gw; task < NTA; task += nw) {
    {
      const int r = task * 4 + sub; const int b = r / T, t = r % T;
      const bf16_t* pr = P + (size_t)r * NIN;
      {
        f32x4 v[3]; float ss = 0.f;
#pragma unroll
        for (int e = 0; e < 3; ++e) { v[e] = unpack4(*(const u32x2*)(pr + O_CQ + 12 * u + 4 * e)); ss += v[e][0] * v[e][0] + v[e][1] * v[e][1] + v[e][2] * v[e][2] + v[e][3] * v[e][3]; }
        ss = red16(ss); const float rs = rsqrtf(ss * (1.f / 192.f) + 1e-6f);
#pragma unroll
        for (int e = 0; e < 3; ++e) {
          const f32x4 g = gcq[e];
          f32x4 o = {v[e][0] * rs * g[0], v[e][1] * rs * g[1], v[e][2] * rs * g[2], v[e][3] * rs * g[3]};
          *(u32x2*)(cqn + (size_t)r * 192 + 12 * u + 4 * e) = pack4(o);
        }
      }
      {
        f32x4 v[2]; float ss = 0.f;
#pragma unroll
        for (int e = 0; e < 2; ++e) { v[e] = unpack4(*(const u32x2*)(pr + O_CKV + 8 * u + 4 * e)); ss += v[e][0] * v[e][0] + v[e][1] * v[e][1] + v[e][2] * v[e][2] + v[e][3] * v[e][3]; }
        ss = red16(ss); const float rs = rsqrtf(ss * (1.f / 128.f) + 1e-6f);
#pragma unroll
        for (int e = 0; e < 2; ++e) {
          const f32x4 g = gckv[e];
          f32x4 o = {v[e][0] * rs * g[0], v[e][1] * rs * g[1], v[e][2] * rs * g[2], v[e][3] * rs * g[3]};
          *(u32x2*)(ckvn + (size_t)r * 128 + 8 * u + 4 * e) = pack4(o);
        }
      }
      const int posg = (u & 8) ? (t & 63) : (t >> 6); const float sgg = (u & 4) ? 1.f : -1.f;
      const f32x4 c01 = *(const f32x4*)(rg + (posg * 16 + 4 * (u & 3)) * 2), c23 = *(const f32x4*)(rg + (posg * 16 + 4 * (u & 3) + 2) * 2);
      const float csg[8] = {c01[0], c01[1], c01[2], c01[3], c23[0], c23[1], c23[2], c23[3]};
      const f32x4 gqv = *(const f32x4*)(p->gqa_qn + l * 64 + 4 * u), gkv = *(const f32x4*)(p->gqa_kn + l * 64 + 4 * u);
#pragma unroll
      for (int hh = 0; hh < 6; ++hh) {
        const bool isq = hh < 4; const int hd = isq ? hh : hh - 4;
        f32x4 v = unpack4(*(const u32x2*)(pr + (isq ? O_Q2 : O_K2) + 64 * hd + 4 * u));
        float ss = red16(v[0] * v[0] + v[1] * v[1] + v[2] * v[2] + v[3] * v[3]);
        const float rs = rsqrtf(ss * (1.f / 64.f) + 1e-6f);
        const f32x4 g = isq ? gqv : gkv;
#pragma unroll
        for (int e = 0; e < 4; ++e) v[e] = v[e] * rs * g[e];
        if (t < SEQ) rope4(v, u, sgg, csg);
        if (isq) {
#pragma unroll
          for (int e = 0; e < 4; ++e) v[e] *= 0.18033688011112042f;
        }
        bf16_t* dst = isq ? QB + (((size_t)b * 4 + hd) * T + t) * 64 + 4 * u : KB + (((size_t)b * 2 + hd) * T + t) * 64 + 4 * u;
        *(u32x2*)dst = pack4(v);
      }
    }
  }
}

DI void phase_feat_b(KP p, int l, char* lds) {
  unsigned char* ws = p->ws; asm volatile("" : "+s"(ws));
  const bf16_t* P = (const bf16_t*)(ws + WS_P);
  const bf16_t* cqn = (const bf16_t*)(ws + WS_R1 + R1_CQN);
  const bf16_t* ckvn = (const bf16_t*)(ws + WS_R1 + R1_CKVN);
  bf16_t* q1r = (bf16_t*)(ws + WS_R1 + R1_Q1R);
  bf16_t* kr = (bf16_t*)(ws + WS_R1 + R1_KR);
  const bf16_t* wuq = (const bf16_t*)(ws + WS_WUQ) + (size_t)l * 384 * 192;
  const bf16_t* wukv = (const bf16_t*)(ws + WS_WUKV) + (size_t)l * 512 * 128;
  const bf16_t* cm = (const bf16_t*)(ws + WS_CM);
  bf16_t* VAT = (bf16_t*)(ws + WS_VAT); bf16_t* FT = (bf16_t*)(ws + WS_FT); bf16_t* FTC = (bf16_t*)(ws + WS_FTC);
  constexpr int N1 = 288 * 3, N2 = 288 * 2, N3 = 288 * 2, N4 = 288 * 4;
  const int hbb = __builtin_amdgcn_readfirstlane(otid() >> 8);
  for (int it = 2 * blockIdx.x + hbb; it < N1 + N2 + N3 + N4; it += 2 * gridDim.x) {
    if (it < N1) {
      const int mt = it / 3, nt = it % 3; const int m0 = mt * 128, n0 = nt * 128;
      gemm_tile(cqn + (size_t)m0 * 192, 192, wuq + (size_t)n0 * 192, 192, 192, lds, [&](int m, int n, f32x4 v) {
        *(u32x2*)(q1r + (size_t)(m0 + m) * 384 + n0 + n) = pack4(v); });
    } else if (it < N1 + N2) {
      const int i2 = it - N1; const int mt = i2 >> 1, nt = i2 & 1; const int m0 = mt * 128, n0 = nt * 128;
      gemm_tile(ckvn + (size_t)m0 * 128, 128, wukv + (size_t)n0 * 128, 128, 128, lds, [&](int m, int n, f32x4 v) {
        *(u32x2*)(kr + (size_t)(m0 + m) * 256 + n0 + n) = pack4(v); });
    } else if (it < N1 + N2 + N3) {
      const int i2 = it - N1 - N2; const int tt = i2 >> 1, mt2 = i2 & 1;
      gemm_tile(wukv + (size_t)(256 + 128 * mt2) * 128, 128, ckvn + (size_t)tt * 128 * 128, 128, 128, lds, [&](int m, int n, f32x4 v) {
        const int mm = 128 * mt2 + m, head = mm >> 6, dv = mm & 63; const int r = tt * 128 + n; const int b = r / T, t = r % T;
        *(u32x2*)(VAT + (((size_t)b * 4 + head) * 64 + dv) * T + t) = pack4(v); });
    } else {
      const int i2 = it - N1 - N2 - N3; const int tt = i2 >> 2, g = i2 & 3;
      gemm_tile(cm, 64, P + (size_t)tt * 128 * NIN + O_F + 64 * g, NIN, 64, lds, [&](int m, int n, f32x4 v) {
        const int col = 64 * g + (m & 63), part = m >> 6; const int r = tt * 128 + n; const int b = r / T, t = r % T;
        if (t < SEQ) *(u32x2*)(FT + ((size_t)b * 256 + col) * 4096 + part * 2048 + t) = pack4(v);
        else *(u32x2*)(FTC + ((size_t)b * 256 + col) * 512 + part * 256 + (t - SEQ)) = pack4(v); });
    }
  }
}

DI void phase_feat_c(KP p, int l) {
  unsigned char* ws = p->ws; asm volatile("" : "+s"(ws));
  const bf16_t* P = (const bf16_t*)(ws + WS_P);
  const bf16_t* q1r = (const bf16_t*)(ws + WS_R1 + R1_Q1R);
  const bf16_t* krw = (const bf16_t*)(ws + WS_R1 + R1_KR);
  bf16_t* QA = (bf16_t*)(ws + WS_QA); bf16_t* KA = (bf16_t*)(ws + WS_KA);
  const float* rm = (const float*)(ws + WS_ROPM);
  const int tid = otid(); const int lane = tid & 63, u = lane & 15, sub = lane >> 4;
  const int gw = blockIdx.x * (NTHR / 64) + (tid >> 6), nw = gridDim.x * (NTHR / 64);
  {
    const bf16_t* FT = (const bf16_t*)(ws + WS_FT); bf16_t* FTF = (bf16_t*)(ws + WS_FTF);
    for (int task = gw; task < NB * 256 * 4; task += nw) {
      const int row = task >> 2, k8 = (task & 3) * 512 + lane * 8;
      const bf16_t* fr = FT + (size_t)row * 4096;
      const bool cosp = k8 < 1024;
      const int f0 = cosp ? k8 : 2048 + (k8 - 1024);
      const int mi = cosp ? 2048 - k8 : 4096 - (k8 - 1024);
      const u32x4 fw = *(const u32x4*)(fr + f0), ml = *(const u32x4*)(fr + mi - 8);
      const float m0v = bflo((unsigned)fr[(mi < 4096) ? mi : 4095]);
      const float f[8] = {bflo(fw.x), bfhi(fw.x), bflo(fw.y), bfhi(fw.y), bflo(fw.z), bfhi(fw.z), bflo(fw.w), bfhi(fw.w)};
      const float mr[8] = {m0v, bfhi(ml.w), bflo(ml.w), bfhi(ml.z), bflo(ml.z), bfhi(ml.y), bflo(ml.y), bfhi(ml.x)};
      float v[8];
#pragma unroll
      for (int e = 0; e < 8; ++e) {
        const int k = k8 + e;
        if (k < 1024) v[e] = f[e] + ((k == 0) ? 0.f : mr[e]);
        else if (k == 1024) v[e] = bflo((unsigned)fr[1024]);
        else v[e] = f[e] - mr[e];
      }
      u32x4 o = {cvtpk(v[0], v[1]), cvtpk(v[2], v[3]), cvtpk(v[4], v[5]), cvtpk(v[6], v[7])};
      *(u32x4*)(FTF + (size_t)row * 2048 + k8) = o;
    }
  }
#pragma unroll 4
  for (int task = gw; task < M / 4; task += nw) {
    const int r = task * 4 + sub; const int b = r / T, t = r % T;
    const unsigned krp = *(const unsigned*)(P + (size_t)r * NIN + O_KR + 2 * u);
    const int posm = (u & 8) ? (t & 63) : (t >> 6); const float sgm = (u & 4) ? 1.f : -1.f;
    const f32x4 csm = *(const f32x4*)(rm + (posm * 8 + 2 * (u & 3)) * 2);
    const f32x4 gq4 = *(const f32x4*)(p->mla_qn + l * 96 + 4 * u), gk4 = *(const f32x4*)(p->mla_kn + l * 96 + 4 * u);
    const f32x2 gq2 = *(const f32x2*)(p->mla_qn + l * 96 + 64 + 2 * u), gk2 = *(const f32x2*)(p->mla_kn + l * 96 + 64 + 2 * u);
#pragma unroll
    for (int hh = 0; hh < 8; ++hh) {
      const bool isq = hh < 4; const int hd = hh & 3;
      f32x4 v; float ra, rb;
      if (isq) {
        v = unpack4(*(const u32x2*)(q1r + (size_t)r * 384 + 96 * hd + 4 * u));
        const unsigned rr = *(const unsigned*)(q1r + (size_t)r * 384 + 96 * hd + 64 + 2 * u); ra = bflo(rr); rb = bfhi(rr);
      } else {
        v = unpack4(*(const u32x2*)(krw + (size_t)r * 256 + 64 * hd + 4 * u));
        ra = bflo(krp); rb = bfhi(krp);
      }
      float ss = red16(v[0] * v[0] + v[1] * v[1] + v[2] * v[2] + v[3] * v[3] + ra * ra + rb * rb);
      const float rs = rsqrtf(ss * (1.f / 96.f) + 1e-6f);
      const f32x4 g = isq ? gq4 : gk4; const f32x2 g2 = isq ? gq2 : gk2;
#pragma unroll
      for (int e = 0; e < 4; ++e) v[e] = v[e] * rs * g[e];
      ra = ra * rs * g2[0]; rb = rb * rs * g2[1];
      if (t < SEQ) rope2(ra, rb, sgm, csm);
      if (isq) {
        const float cq = 1.4426950408889634f / __builtin_sqrtf(96.f);
#pragma unroll
        for (int e = 0; e < 4; ++e) v[e] *= cq;
        ra *= cq; rb *= cq;
      }
      bf16_t* dst = (isq ? QA : KA) + (((size_t)b * 4 + hd) * T + t) * 96;
      *(u32x2*)(dst + 4 * u) = pack4(v);
      *(unsigned*)(dst + 64 + 2 * u) = cvtpk(ra, rb);
    }
  }
}

DI void phase_mix(KP p, int l, char* lds) {
  unsigned char* ws = p->ws; asm volatile("" : "+s"(ws));
  const bf16_t* P = (const bf16_t*)(ws + WS_P);
  bf16_t* Y = (bf16_t*)(ws + WS_R1);
  bf16_t* YD = (bf16_t*)(ws + WS_YD);
  const bf16_t* QA = (const bf16_t*)(ws + WS_QA); const bf16_t* KA = (const bf16_t*)(ws + WS_KA); const bf16_t* VAT = (const bf16_t*)(ws + WS_VAT);
  const bf16_t* QB = (const bf16_t*)(ws + WS_QB); const bf16_t* KB = (const bf16_t*)(ws + WS_KB); const bf16_t* VBT = (const bf16_t*)(ws + WS_VBT);
  const bf16_t* FTF = (const bf16_t*)(ws + WS_FTF); const bf16_t* FTC = (const bf16_t*)(ws + WS_FTC);
  const bf16_t* DL = (const bf16_t*)(ws + WS_DLAT); const bf16_t* DC = (const bf16_t*)(ws + WS_DCTX);
  const bf16_t* vnT = (const bf16_t*)(ws + WS_VNT);
  const bf16_t* wsb = (const bf16_t*)(ws + WS_WS) + (size_t)l * 4 * 128 * 128;
  const bool upd = (l == 0);
  const float sbA = ((const float*)(ws + WS_SBND))[l * 2], sbB = ((const float*)(ws + WS_SBND))[l * 2 + 1];
  const int xcd = blockIdx.x & 7, lb = 2 * (blockIdx.x >> 3) + __builtin_amdgcn_readfirstlane(otid() >> 8), nlb = 2 * (gridDim.x >> 3);
  const int nDL = 64, nA = 0, nB = 0, nDC = upd ? 8 : 0, nAc = 0, nBc = 0, nCM = 144, nFN = upd ? 72 : 64;
  const int e0 = nDL, e1 = e0 + nA, e2 = e1 + nB, e3 = e2 + nDC, e4 = e3 + nAc, e5 = e4 + nBc, e6 = e5 + nCM, e7 = e6 + nFN;
  unsigned* cnt = (unsigned*)(ws + WS_CNT) + l * 288;
  const bf16_t* wf = (const bf16_t*)(ws + WS_WF) + (size_t)l * 256 * 256;
  {
    const int lbw = blockIdx.x >> 3, nlbw = gridDim.x >> 3;
    const int nW = upd ? 144 : 128;
    for (int it = lbw; it < nW; it += nlbw) {
      const bool isA = (it < 64) || (it >= 128 && it < 136);
      int b, hd, q0, k0, nk;
      if (it < 128) { const int i2 = it & 63; b = 2 * xcd + (i2 >> 5); hd = (i2 >> 3) & 3; q0 = (i2 & 7) * 256; k0 = 0; nk = T; }
      else { const int i2 = (it - 128) & 7; b = 2 * xcd + (i2 >> 2); hd = i2 & 3; q0 = SEQ; k0 = SEQ; nk = CL; }
      const size_t r0 = (size_t)b * T + q0; const size_t bh = (size_t)b * 4 + hd, bk = (size_t)b * 2 + (hd >> 1);
      if (isA) {
        if (sbA <= 30.f) attn_item8<96, true>(QA + (bh * T + q0) * 96, KA + (bh * T + k0) * 96, VAT + bh * 64 * T + k0, nk, lds, P + r0 * NIN + O_GA + 64 * hd, Y + r0 * 1024 + 64 * hd, sbA);
        else attn_item8<96, false>(QA + (bh * T + q0) * 96, KA + (bh * T + k0) * 96, VAT + bh * 64 * T + k0, nk, lds, P + r0 * NIN + O_GA + 64 * hd, Y + r0 * 1024 + 64 * hd, 0.f);
      } else {
        if (sbB <= 30.f) attn_item8<64, true>(QB + (bh * T + q0) * 64, KB + (bk * T + k0) * 64, VBT + bk * 64 * T + k0, nk, lds, P + r0 * NIN + O_GB + 64 * hd, Y + r0 * 1024 + 256 + 64 * hd, sbB);
        else attn_item8<64, false>(QB + (bh * T + q0) * 64, KB + (bk * T + k0) * 64, VBT + bk * 64 * T + k0, nk, lds, P + r0 * NIN + O_GB + 64 * hd, Y + r0 * 1024 + 256 + 64 * hd, 0.f);
      }
    }
    __syncthreads();
  }
  const int tid0 = otid() & 255;
  for (int it = lb; it < e7; it += nlb) {
    if (it >= e6) {
      const int i2 = it - e6; const int mpb = upd ? 18 : 16; const int mloc = i2 >> 1, nt = i2 & 1;
      const int mt = (2 * xcd + mloc / mpb) * 18 + (mloc % mpb);
      if (tid0 == 0) {
        unsigned sp = 0;
        while (__hip_atomic_load(&cnt[mt], __ATOMIC_RELAXED, __HIP_MEMORY_SCOPE_AGENT) < 2u) { __builtin_amdgcn_s_sleep(2); if (++sp > (1u << 24)) break; }
        __builtin_amdgcn_fence(__ATOMIC_ACQUIRE, "agent");
        asm volatile("s_waitcnt vmcnt(0)" ::: "memory");
      }
      __syncthreads();
      const int m0 = mt * 128, n0 = nt * 128;
      gemm_tile(YD + (size_t)m0 * 256, 256, wf + (size_t)n0 * 256, 256, 256, lds, [&](int m, int n, f32x4 v) {
        const size_t r = (size_t)m0 + m;
        f32x4 gd = unpack4(*(const u32x2*)(P + r * NIN + O_GD + n0 + n));
        f32x4 o = {v[0] * silu(gd[0]), v[1] * silu(gd[1]), v[2] * silu(gd[2]), v[3] * silu(gd[3])};
        *(u32x2*)(Y + r * 1024 + 768 + n0 + n) = pack4(o); });
      continue;
    }
    if (it < e0 || (it >= e2 && it < e3)) {
      const bool isl = it < e0; const int i2 = isl ? it : it - e2;
      int b, mt, nt, K; const bf16_t* Ap; const bf16_t* Bp; float sc; size_t rbase;
      if (isl) { b = 2 * xcd + (i2 >> 5); mt = (i2 >> 1) & 15; nt = i2 & 1; K = 2048; Ap = DL + (size_t)mt * 128 * 2048; Bp = FTF + ((size_t)b * 256 + nt * 128) * 2048; sc = 0.00276213586f; rbase = (size_t)b * T + mt * 128; }
      else { b = 2 * xcd + (i2 >> 2); mt = (i2 >> 1) & 1; nt = i2 & 1; K = 512; Ap = DC + (size_t)mt * 128 * 512; Bp = FTC + ((size_t)b * 256 + nt * 128) * 512; sc = 0.0078125f; rbase = (size_t)b * T + SEQ + mt * 128; }
      bf16_t* yo = YD + rbase * 256 + nt * 128;
      gemm_tile(Ap, K, Bp, K, K, lds, [&](int m, int n, f32x4 v) {
        f32x4 o = {v[0] * sc, v[1] * sc, v[2] * sc, v[3] * sc};
        *(u32x2*)(yo + (size_t)m * 256 + n) = pack4(o); });
      asm volatile("s_waitcnt vmcnt(0)" ::: "memory");
      __syncthreads();
      if (tid0 == 0) {
        __builtin_amdgcn_fence(__ATOMIC_RELEASE, "agent");
        asm volatile("s_waitcnt vmcnt(0)" ::: "memory");
        __hip_atomic_fetch_add(&cnt[b * 18 + (isl ? mt : 16 + mt)], 1u, __ATOMIC_RELAXED, __HIP_MEMORY_SCOPE_AGENT);
      }
    } else {
      const int i2 = it - e5; const int bl = i2 / 72, rem = i2 % 72; const int chl = rem >> 2, g = rem & 3;
      const int ch = (2 * xcd + bl) * 18 + chl;
      if (!upd && chl >= 16) continue;
      const float* bs = p->cm_b_s + ((size_t)l * 4 + g) * 128;
      const bf16_t* Pr = P + (size_t)ch * 128 * NIN + 64 * g; bf16_t* Yr = Y + (size_t)ch * 128 * 1024 + 512 + 64 * g;
      gemm_tile(wsb + (size_t)g * 128 * 128, 128, vnT + ((size_t)ch * 256 + 64 * g) * 128, 128, 128, lds, [&](int m, int n, f32x4 v) {
        if (n < 64) {
          const float bias = bs[m];
          f32x4 uu = unpack4(*(const u32x2*)(Pr + (size_t)m * NIN + O_U + n)), gc = unpack4(*(const u32x2*)(Pr + (size_t)m * NIN + O_GC + n));
          f32x4 o;
#pragma unroll
          for (int e = 0; e < 4; ++e) o[e] = uu[e] * (v[e] + bias) * silu(gc[e]);
          *(u32x2*)(Yr + (size_t)m * 1024 + n) = pack4(o);
        } });
    }
  }
}

DI void phase_outproj(KP p, int l, char* lds) {
  unsigned char* ws = p->ws; asm volatile("" : "+s"(ws));
  const bf16_t* Y = (const bf16_t*)(ws + WS_R1);
  const bf16_t* wo = (const bf16_t*)(ws + WS_WOUT) + (size_t)l * 1024 * 1024;
  const float* mod = (const float*)(ws + WS_MOD) + (size_t)l * 17 * 3072;
  const float* xl = (l == 0) ? p->x : p->out;
  float* ctx1 = (float*)(ws + WS_CTX1);
  const int xcd = blockIdx.x & 7, lb = blockIdx.x >> 3, nlb = gridDim.x >> 3, hb = __builtin_amdgcn_readfirstlane(otid() >> 8);
  const int nsm = (l == 0) ? 16 : 0;
  for (int j = lb; j < 64; j += nlb) {
    {
      const int mi = j >> 2, nt = j & 3;
      const int bb = 2 * xcd + (mi >> 3), tt = mi & 7;
      const int m0 = (bb * 9 + tt) * 256, n0 = nt * 256;
      const float* src = xl + ((size_t)bb * SEQ + tt * 256) * 1024;
      float* dst = p->out + ((size_t)bb * SEQ + tt * 256) * 1024;
      const float* gt = mod + (size_t)bb * 3072 + 2048;
      gemm256(Y + (size_t)m0 * 1024, 1024, wo + (size_t)n0 * 1024, 1024, 1024, lds, [&](int m, int n, f32x4 v) {
        const size_t o = (size_t)m * 1024 + n0 + n;
        f32x4 xv = __builtin_nontemporal_load((const f32x4*)(src + o)), g = *(const f32x4*)(gt + n0 + n);
        f32x4 r = {xv[0] + g[0] * v[0], xv[1] + g[1] * v[1], xv[2] + g[2] * v[2], xv[3] + g[3] * v[3]};
        __builtin_nontemporal_store(r, (f32x4*)(dst + o)); });
    }
  }
  for (int j = lb; j < nsm; j += nlb) {
    {
      const int item = 2 * j + hb; const int bb = 2 * xcd + (item >> 4), m128 = (item >> 3) & 1, nt = item & 7;
      const int m0 = (bb * 18 + 16 + m128) * 128, n0 = nt * 128;
      const float* src = p->ctx + ((size_t)bb * CL + m128 * 128) * 1024;
      float* dst = ctx1 + ((size_t)bb * CL + m128 * 128) * 1024;
      const float* gt = mod + (size_t)16 * 3072 + 2048;
      gemm_tile(Y + (size_t)m0 * 1024, 1024, wo + (size_t)n0 * 1024, 1024, 1024, lds, [&](int m, int n, f32x4 v) {
        const size_t o = (size_t)m * 1024 + n0 + n;
        f32x4 xv = *(const f32x4*)(src + o), g = *(const f32x4*)(gt + n0 + n);
        f32x4 r = {xv[0] + g[0] * v[0], xv[1] + g[1] * v[1], xv[2] + g[2] * v[2], xv[3] + g[3] * v[3]};
        *(f32x4*)(dst + o) = r; });
    }
  }
}

__global__ void __launch_bounds__(NTHR, 2) fwd_megakernel(Params p_byval) {
  KP p = (KP)__builtin_amdgcn_kernarg_segment_ptr();
  extern __shared__ __attribute__((aligned(16))) char lds[];
  cg::grid_group grid = cg::this_grid();
  uint4* xbw = (uint4*)(lds + LDS_MAIN);
  if (threadIdx.x == 0) *xbw = make_uint4(0u, 0u, 0u, 0u);
  __syncthreads();
  XcdBarrier xb = xcd_barrier_post((unsigned*)(p->ws + WS_BAR), (volatile LAS unsigned*)xbw);
  if (p->ph_hi < p->ph_lo) grid.sync();
  (void)p_byval;
  for (int ph = p->ph_lo; ph < p->ph_hi; ++ph) {
    asm volatile("" : "+s"(p));
    if (ph == 0) phase0(p, lds);
    else {
      const int l = (ph - 1) / 7, s = (ph - 1) % 7;
      switch (s) {
        case 0: phase_norm(p, l); break;
        case 1: phase_inproj(p, l, lds); break;
        case 2: phase_feat_a(p, l, lds); break;
        case 3: phase_feat_b(p, l, lds); break;
        case 4: phase_feat_c(p, l); break;
        case 5: phase_mix(p, l, lds); break;
        default: phase_outproj(p, l, lds); break;
      }
    }
    if (ph + 1 < p->ph_hi) xcd_barrier(xb);
  }
}

extern "C" void kernel_launch(void* const* d_in, const int* in_sizes, int n_in, void* d_out, int out_size, void* d_ws, size_t ws_size, hipStream_t stream) {
  static int grid_blocks = 0;
  if (!grid_blocks) {
    int dev = 0, cus = 0, per_cu = 0;
    hipGetDevice(&dev);
    hipDeviceGetAttribute(&cus, hipDeviceAttributeMultiprocessorCount, dev);
    hipFuncSetAttribute((const void*)fwd_megakernel, hipFuncAttributeMaxDynamicSharedMemorySize, LDS_BYTES);
    hipOccupancyMaxActiveBlocksPerMultiprocessor(&per_cu, fwd_megakernel, NTHR, LDS_BYTES);
    if (per_cu > 1) per_cu = 1;
    if (per_cu < 1) per_cu = 1;
    grid_blocks = cus * per_cu;
    if (ws_size < WS_END) fprintf(stderr, "kernel_launch: workspace too small: %zu < %zu\n", ws_size, (size_t)WS_END);
  }
  hipMemsetAsync((unsigned char*)d_ws + WS_BAR, 0, WS_ZERO_BYTES, stream);
  Params p{};
  const float** pp = (const float**)&p;
  for (int i = 0; i < 22; ++i) pp[i] = (const float*)d_in[i];
  p.out = (float*)d_out; p.ws = (unsigned char*)d_ws;
  constexpr int NPH = 15;
#if PER_PHASE_LAUNCH
  for (int ph = 0; ph < NPH; ++ph) {
    p.ph_lo = ph; p.ph_hi = ph + 1;
    hipLaunchKernelGGL(fwd_megakernel, dim3(grid_blocks), dim3(NTHR), LDS_BYTES, stream, p);
  }
#else
  p.ph_lo = 0; p.ph_hi = NPH;
  void* args[] = {&p};
  hipError_t e = hipLaunchCooperativeKernel((void*)fwd_megakernel, dim3(grid_blocks), dim3(NTHR), args, LDS_BYTES, stream);
  if (e != hipSuccess) fprintf(stderr, "cooperative launch failed: %s (grid %d)\n", hipGetErrorString(e), grid_blocks);
#endif
}
```

```cpp
#include <hip/hip_runtime.h>
#include <hip/hip_cooperative_groups.h>
#include <stdint.h>
#include <stdio.h>
namespace cg = cooperative_groups;

#ifndef PER_PHASE_LAUNCH
#define PER_PHASE_LAUNCH 0
#endif

#define DI __device__ __forceinline__
DI int otid() { int t = threadIdx.x; asm volatile("" : "+v"(t)); return t; }
typedef unsigned short bf16_t;
using bf16x8 = __attribute__((ext_vector_type(8))) short;
using f32x16 = __attribute__((ext_vector_type(16))) float;
using f32x4  = __attribute__((ext_vector_type(4))) float;
using f32x2  = __attribute__((ext_vector_type(2))) float;
using u32x4  = __attribute__((ext_vector_type(4))) unsigned;
using u32x2  = __attribute__((ext_vector_type(2))) unsigned;
typedef __bf16 bf16x2_t __attribute__((ext_vector_type(2)));

constexpr int NB = 16, SEQ = 2048, CL = 256, T = 2304, D = 1024, M = NB * T, NIN = 2656, NINP = 2816;
constexpr int O_CQ = 0, O_CKV = 192, O_KR = 320, O_GA = 352, O_Q2 = 608, O_K2 = 864, O_V2 = 992, O_GB = 1120,
              O_U = 1376, O_V = 1632, O_GC = 1888, O_F = 2144, O_GD = 2400;
constexpr int NTHR = 512;
constexpr int HALF_LDS = 69632, LDS_MAIN = 2 * HALF_LDS, LDS_BYTES = LDS_MAIN + 256;

constexpr size_t al256(size_t x) { return (x + 255) & ~(size_t)255; }
constexpr size_t WS_MOD  = 0;
constexpr size_t WS_ROPG = al256(WS_MOD + 2 * 17 * 3072 * 4);
constexpr size_t WS_ROPM = al256(WS_ROPG + 64 * 16 * 2 * 4);
constexpr size_t WS_SBND = al256(WS_ROPM + 64 * 8 * 2 * 4);
constexpr size_t WS_WIN  = al256(WS_SBND + 256);
constexpr size_t WS_WUQ  = al256(WS_WIN + (size_t)2 * NINP * 1024 * 2);
constexpr size_t WS_WUKV = al256(WS_WUQ + 2 * 384 * 192 * 2);
constexpr size_t WS_WF   = al256(WS_WUKV + 2 * 512 * 128 * 2);
constexpr size_t WS_WOUT = al256(WS_WF + 2 * 256 * 256 * 2);
constexpr size_t WS_WS   = al256(WS_WOUT + (size_t)2 * 1024 * 1024 * 2);
constexpr size_t WS_CM   = al256(WS_WS + 2 * 4 * 128 * 128 * 2);
constexpr size_t WS_DLAT = al256(WS_CM + 128 * 64 * 2);
constexpr size_t WS_DCTX = al256(WS_DLAT + (size_t)2048 * 2048 * 2);
constexpr size_t WS_R1   = al256(WS_DCTX + 256 * 512 * 2);
constexpr size_t R1_CQN = 0, R1_CKVN = (size_t)M * 192 * 2, R1_Q1R = R1_CKVN + (size_t)M * 128 * 2, R1_KR = R1_Q1R + (size_t)M * 384 * 2;
constexpr size_t WS_P    = al256(WS_R1 + (size_t)M * 1024 * 2);
constexpr size_t WS_FT   = al256(WS_P + (size_t)M * NIN * 2);
constexpr size_t WS_FTF  = al256(WS_FT + (size_t)NB * 256 * 4096 * 2);
constexpr size_t WS_FTC  = al256(WS_FTF + (size_t)NB * 256 * 2048 * 2);
constexpr size_t WS_YD   = al256(WS_FTC + (size_t)NB * 256 * 512 * 2);
constexpr size_t WS_QA   = al256(WS_YD + (size_t)M * 256 * 2);
constexpr size_t WS_KA   = al256(WS_QA + (size_t)M * 384 * 2);
constexpr size_t WS_VAT  = al256(WS_KA + (size_t)M * 384 * 2);
constexpr size_t WS_QB   = al256(WS_VAT + (size_t)M * 256 * 2);
constexpr size_t WS_KB   = al256(WS_QB + (size_t)M * 256 * 2);
constexpr size_t WS_VBT  = al256(WS_KB + (size_t)M * 128 * 2);
constexpr size_t WS_VNT  = al256(WS_VBT + (size_t)M * 128 * 2);
constexpr size_t WS_CTX1 = al256(WS_VNT + (size_t)M * 256 * 2 + 65536);
constexpr size_t WS_BAR  = al256(WS_CTX1 + (size_t)NB * CL * 1024 * 4);
constexpr size_t WS_CNT  = al256(WS_BAR + 3456 * 4);
constexpr size_t WS_END  = al256(WS_CNT + 2 * 288 * 4);
constexpr size_t WS_ZERO_BYTES = WS_END - WS_BAR;
static_assert(R1_KR + (size_t)M * 256 * 2 <= (size_t)M * 1024 * 2, "temp region");
static_assert(WS_END <= (size_t)512 * 1024 * 1024, "workspace");

struct Params {
  const float *x, *c, *ctx, *c_ctx, *norm_g, *w_mod, *b_mod, *w_in, *mla_q_norm, *mla_w_uq, *mla_kv_norm, *mla_w_ukv,
              *mla_qn, *mla_kn, *gqa_qn, *gqa_kn, *cm_ln_g, *cm_ln_b, *cm_w_s, *cm_b_s, *fnet_w, *w_out;
  float* out; unsigned char* ws; int ph_lo, ph_hi;
};
typedef const __attribute__((address_space(4))) Params* KP;

DI unsigned cvtpk(float lo, float hi) { f32x2 v = {lo, hi}; bf16x2_t b = __builtin_convertvector(v, bf16x2_t); return __builtin_bit_cast(unsigned, b); }
DI float bflo(unsigned u) { return __uint_as_float(u << 16); }
DI float bfhi(unsigned u) { return __uint_as_float(u & 0xffff0000u); }
DI bf16_t f2bf(float f) { return (bf16_t)(cvtpk(f, 0.f) & 0xffffu); }
DI float silu(float x) { return x / (1.f + __expf(-x)); }
DI f32x4 unpack4(u32x2 v) { f32x4 r = {bflo(v.x), bfhi(v.x), bflo(v.y), bfhi(v.y)}; return r; }
DI u32x2 pack4(f32x4 v) { u32x2 r = {cvtpk(v[0], v[1]), cvtpk(v[2], v[3])}; return r; }
DI float dpp_f(float v, const int ctrl_sel) {
  const int i = __float_as_int(v); int r;
  if (ctrl_sel == 0) r = __builtin_amdgcn_update_dpp(0, i, 0xB1, 0xF, 0xF, true);
  else if (ctrl_sel == 1) r = __builtin_amdgcn_update_dpp(0, i, 0x4E, 0xF, 0xF, true);
  else if (ctrl_sel == 2) r = __builtin_amdgcn_update_dpp(0, i, 0x124, 0xF, 0xF, true);
  else r = __builtin_amdgcn_update_dpp(0, i, 0x128, 0xF, 0xF, true);
  return __int_as_float(r);
}
DI float red16(float v) { v += dpp_f(v, 0); v += dpp_f(v, 1); v += dpp_f(v, 2); v += dpp_f(v, 3); return v; }
DI float red64(float v) { v = red16(v); v += __shfl_xor(v, 16); v += __shfl_xor(v, 32); return v; }
#define MFMA32(a, b, c) __builtin_amdgcn_mfma_f32_32x32x16_bf16((a), (b), (c), 0, 0, 0)


#define XB_TMO      128
#define XB_XCNT(j)  (256  + 64 * (j))
#define XB_XSUB(j)  (1280 + 64 * (j))
#define XB_XGEN(j)  (2304 + 64 * (j))
#define XB_TOP      3328
#define XB_TOPGEN   3392
#define XCD_BAR_WORDS 3456
#define XB_SPIN_CAP (1u << 22)
#define LAS __attribute__((address_space(3)))
DI unsigned xb_ld(unsigned* p)              { return __hip_atomic_load(p, __ATOMIC_RELAXED, __HIP_MEMORY_SCOPE_AGENT); }
DI unsigned xb_add(unsigned* p, unsigned v) { return __hip_atomic_fetch_add(p, v, __ATOMIC_RELAXED, __HIP_MEMORY_SCOPE_AGENT); }
DI unsigned xb_xcc_id() { return (unsigned)__builtin_amdgcn_s_getreg((3 << 11) | 20) & 0xFu; }
#define XB_SPIN(cond, bar) do { unsigned _sp = 0; while (cond) { __builtin_amdgcn_s_sleep(1); \
    if ((++_sp & 255u) == 0u) { if (xb_ld(&(bar)[XB_TMO])) break; if (_sp > XB_SPIN_CAP) { atomicAdd(&(bar)[XB_TMO], 1u); break; } } } } while (0)
struct XcdBarrier { unsigned* bar; unsigned x; volatile LAS unsigned* st; };
DI XcdBarrier xcd_barrier_post(unsigned* bar, volatile LAS unsigned* st) {
  XcdBarrier b; b.bar = bar; b.x = xb_xcc_id(); b.st = st;
  if (threadIdx.x == 0) (void)xb_add(&bar[XB_XCNT(b.x)], 1u);
  return b;
}
DI void xcd_barrier_complete(unsigned* bar, unsigned x, unsigned& nloc, unsigned& nx) {
  const unsigned G = gridDim.x * gridDim.y * gridDim.z;
  unsigned sum, cnt, mine, sp = 0u;
  for (;;) {
    sum = 0u; cnt = 0u; mine = 0u;
#pragma unroll
    for (unsigned j = 0; j < 16; ++j) { const unsigned c = xb_ld(&bar[XB_XCNT(j)]); sum += c; cnt += (c > 0u) ? 1u : 0u; mine = (j == x) ? c : mine; }
    if (sum == G) break;
    __builtin_amdgcn_s_sleep(1);
    if ((++sp & 255u) == 0u) { if (xb_ld(&bar[XB_TMO])) break; if (sp > XB_SPIN_CAP) { atomicAdd(&bar[XB_TMO], 1u); break; } }
  }
  nloc = mine > 0u ? mine : 1u; nx = cnt > 0u ? cnt : 1u;
}
DI void xcd_barrier(const XcdBarrier& b) {
  asm volatile("s_waitcnt vmcnt(0)" ::: "memory");
  __syncthreads();
  if (threadIdx.x == 0) {
    unsigned* bar = b.bar;
    __builtin_amdgcn_s_waitcnt(0);
    unsigned nloc = b.st[0], nx = b.st[1];
    if (nloc == 0u) { xcd_barrier_complete(bar, b.x, nloc, nx); b.st[0] = nloc; b.st[1] = nx; }
    const unsigned old = xb_add(&bar[XB_XSUB(b.x)], 1u);
    const unsigned gen = old / nloc;
    if (old + 1u == (gen + 1u) * nloc) {
      __builtin_amdgcn_fence(__ATOMIC_RELEASE, "agent");
      asm volatile("s_waitcnt vmcnt(0)" ::: "memory");
      const unsigned og = xb_add(&bar[XB_TOP], 1u);
      const unsigned tg = og / nx;
      if (og + 1u == (tg + 1u) * nx) xb_add(&bar[XB_TOPGEN], 1u);
      else XB_SPIN(xb_ld(&bar[XB_TOPGEN]) == tg, bar);
      __builtin_amdgcn_fence(__ATOMIC_ACQUIRE, "agent");
      xb_add(&bar[XB_XGEN(b.x)], 1u);
      asm volatile("s_waitcnt vmcnt(0)" ::: "memory");
    } else {
      XB_SPIN(xb_ld(&bar[XB_XGEN(b.x)]) == gen, bar);
      __builtin_amdgcn_fence(__ATOMIC_ACQUIRE, "agent");
      asm volatile("s_waitcnt vmcnt(0)" ::: "memory");
    }
  }
  __syncthreads();
}

template <class Epi>
DI void gemm_tile(const bf16_t* __restrict__ A, int lda, const bf16_t* __restrict__ Bt, int ldb, int K, char* lds, Epi epi, const size_t bjump = 0) {
  const int tid_full = otid(); const int tid = tid_full & 255; lds += (tid_full >> 8) * HALF_LDS;
  const int lane = tid & 63, w = tid >> 6, l31 = lane & 31, h = lane >> 5;
  const int wr = w >> 1, wc = w & 1;
  const int lrow = tid >> 3, lch = (tid & 7) ^ ((tid >> 4) & 7);
  const bf16_t* ag = A + (size_t)lrow * lda + lch * 8;
  const bf16_t* bg = Bt + (size_t)lrow * ldb + lch * 8;
  const size_t a32 = (size_t)32 * lda, b32 = (size_t)32 * ldb;
  f32x16 acc[2][2];
#pragma unroll
  for (int i = 0; i < 2; ++i)
#pragma unroll
    for (int j = 0; j < 2; ++j)
#pragma unroll
      for (int e = 0; e < 16; ++e) acc[i][j][e] = 0.f;
  const int nk = K >> 6;
  const int rsw = (l31 >> 1) & 7;
  const int aoff = (wr * 64 + l31) * 128, boff = 16384 + (wc * 64 + l31) * 128;
  char* ldst = lds + tid * 16;
#define G_DMA(BUF, KT) { const int ko_ = (KT) * 64; char* nb_ = ldst + (BUF) * 32768; _Pragma("unroll") for (int i = 0; i < 4; ++i) { \
    __builtin_amdgcn_global_load_lds((const unsigned*)(ag + i * a32 + ko_), (__attribute__((address_space(3))) unsigned*)(nb_ + i * 4096), 16, 0, 0); \
    __builtin_amdgcn_global_load_lds((const unsigned*)(bg + i * b32 + (i >= 2 ? bjump : (size_t)0) + ko_), (__attribute__((address_space(3))) unsigned*)(nb_ + 16384 + i * 4096), 16, 0, 0); } }
#define G_COMPUTE(BUF) { const char* cur = lds + (BUF) * 32768; bf16x8 af[2][2], bf[2][2]; \
    { const int off = ((0 + h) ^ rsw) << 4; _Pragma("unroll") for (int i = 0; i < 2; ++i) { af[0][i] = *(const bf16x8*)(cur + aoff + i * 4096 + off); bf[0][i] = *(const bf16x8*)(cur + boff + i * 4096 + off); } } \
    _Pragma("unroll") for (int ks = 0; ks < 4; ++ks) { \
      if (ks < 3) { const int off = ((2 * (ks + 1) + h) ^ rsw) << 4; _Pragma("unroll") for (int i = 0; i < 2; ++i) { af[(ks + 1) & 1][i] = *(const bf16x8*)(cur + aoff + i * 4096 + off); bf[(ks + 1) & 1][i] = *(const bf16x8*)(cur + boff + i * 4096 + off); } } \
      _Pragma("unroll") for (int i = 0; i < 2; ++i) _Pragma("unroll") for (int j = 0; j < 2; ++j) acc[i][j] = MFMA32(bf[ks & 1][j], af[ks & 1][i], acc[i][j]); } }
#define G_WAIT() { asm volatile("s_waitcnt vmcnt(0)" ::: "memory"); __syncthreads(); }
  G_DMA(0, 0);
  G_WAIT();
  for (int kt = 0; kt < nk; kt += 2) {
    if (kt + 1 < nk) G_DMA(1, kt + 1);
    G_COMPUTE(0);
    G_WAIT();
    if (kt + 1 < nk) {
      if (kt + 2 < nk) G_DMA(0, kt + 2);
      G_COMPUTE(1);
      G_WAIT();
    }
  }
#undef G_DMA
#undef G_COMPUTE
#undef G_WAIT
  float* ct = (float*)lds;
#pragma unroll
  for (int i = 0; i < 2; ++i)
#pragma unroll
    for (int j = 0; j < 2; ++j)
#pragma unroll
      for (int q = 0; q < 4; ++q) {
        f32x4 v = {acc[i][j][4 * q], acc[i][j][4 * q + 1], acc[i][j][4 * q + 2], acc[i][j][4 * q + 3]};
        *(f32x4*)(ct + (wr * 64 + i * 32 + l31) * 132 + wc * 64 + j * 32 + 8 * q + 4 * h) = v;
      }
  __syncthreads();
#pragma unroll 4
  for (int it = 0; it < 16; ++it) {
    const int idx = it * 256 + tid; const int row = idx >> 5, c4 = (idx & 31) * 4;
    f32x4 v = *(const f32x4*)(ct + row * 132 + c4);
    epi(row, c4, v);
  }
  __syncthreads();
}


DI int g8_lds_byte(int r, int c) { int st = (r >> 4) * 2 + (c >> 5), rr = r & 15, cc = c & 31, ob = rr * 64 + cc * 2; return st * 1024 + (ob ^ (((ob >> 9) & 1) << 5)); }
DI void g8_stage_rc(int b, int& R, int& C) { int st = b / 1024, sb = b % 1024, swz = sb ^ (((sb >> 9) & 1) << 5); R = (st >> 1) * 16 + swz / 64; C = (st & 1) * 32 + (swz % 64) / 2; }
template <class Epi>
DI void gemm256(const bf16_t* __restrict__ A, int lda, const bf16_t* __restrict__ Bt, int ldb, int K, char* lds, Epi epi) {
  constexpr int BK = 64, HALFR = 128, HTB = HALFR * BK * 2;
  const int tid = otid();
  const int wid = tid >> 6, lane = tid & 63, wr = wid >> 2, wc = wid & 3, fr = lane & 15, fq = lane >> 4;
  const int obs = (fr * 64 + fq * 16) ^ ((((fr * 64 + fq * 16) >> 9) & 1) << 5);
  const char* lrda = lds + wr * 8192 + obs; const char* lrdb = lds + 4 * HTB + wc * 4096 + obs;
  int sr0, sc0, sr1, sc1; g8_stage_rc(tid * 16, sr0, sc0); g8_stage_rc(tid * 16 + 8192, sr1, sc1);
  const unsigned oa0 = (unsigned)(sr0 * lda + sc0) * 2u, oa1 = (unsigned)(sr1 * lda + sc1) * 2u;
#define ob0 oa0
#define ob1 oa1
#define SA8(b, h) (lds + ((b) * 2 + (h)) * HTB)
#define SB8(b, h) (lds + (4 + (b) * 2 + (h)) * HTB)
#define STAGE_A(Pp, br, kt) { const char* g_ = (const char*)(A + (size_t)(br) * lda + (size_t)(kt) * BK); \
    __builtin_amdgcn_global_load_lds((const unsigned*)(g_ + oa0), (LAS unsigned*)((Pp) + tid * 16), 16, 0, 0); \
    __builtin_amdgcn_global_load_lds((const unsigned*)(g_ + oa1), (LAS unsigned*)((Pp) + tid * 16 + 8192), 16, 0, 0); }
#define STAGE_B(Pp, br, kt) { const char* g_ = (const char*)(Bt + (size_t)(br) * ldb + (size_t)(kt) * BK); \
    __builtin_amdgcn_global_load_lds((const unsigned*)(g_ + ob0), (LAS unsigned*)((Pp) + tid * 16), 16, 0, 0); \
    __builtin_amdgcn_global_load_lds((const unsigned*)(g_ + ob1), (LAS unsigned*)((Pp) + tid * 16 + 8192), 16, 0, 0); }
#define LDA8(dst, b, h) _Pragma("unroll") for (int m = 0; m < 4; ++m) _Pragma("unroll") for (int k = 0; k < 2; ++k) \
    dst[m][k] = *(const bf16x8*)(lrda + ((b) * 2 + (h)) * HTB + (2 * m + k) * 1024)
#define LDB8(dst, b, h) _Pragma("unroll") for (int n = 0; n < 2; ++n) _Pragma("unroll") for (int k = 0; k < 2; ++k) \
    dst[n][k] = *(const bf16x8*)(lrdb + ((b) * 2 + (h)) * HTB + (2 * n + k) * 1024)
#define MMA8(ai, bj, AT, BT) { __builtin_amdgcn_s_setprio(1); \
    _Pragma("unroll") for (int m = 0; m < 4; ++m) _Pragma("unroll") for (int n = 0; n < 2; ++n) _Pragma("unroll") for (int k = 0; k < 2; ++k) \
      acc[ai][bj][m][n] = __builtin_amdgcn_mfma_f32_16x16x32_bf16(AT[m][k], BT[n][k], acc[ai][bj][m][n], 0, 0, 0); \
    __builtin_amdgcn_s_setprio(0); }
#define WAIT_V(n) asm volatile("s_waitcnt vmcnt(" #n ")" ::: "memory")
#define WAIT_L(n) asm volatile("s_waitcnt lgkmcnt(" #n ")" ::: "memory")
#define BAR8 __builtin_amdgcn_s_barrier()
#define SCHED8 __builtin_amdgcn_sched_barrier(0)
  f32x4 acc[2][2][4][2];
#pragma unroll
  for (int a = 0; a < 2; ++a)
#pragma unroll
    for (int b = 0; b < 2; ++b)
#pragma unroll
      for (int m = 0; m < 4; ++m)
#pragma unroll
        for (int n = 0; n < 2; ++n) { f32x4 z = {0.f, 0.f, 0.f, 0.f}; acc[a][b][m][n] = z; }
  bf16x8 At[4][2], B0[2][2], B1[2][2];
  const int nt = K / BK;
  WAIT_V(0);
  __syncthreads();
  STAGE_B(SB8(0, 0), 0, 0); STAGE_A(SA8(0, 0), 0, 0);
  STAGE_B(SB8(0, 1), HALFR, 0); STAGE_A(SA8(0, 1), HALFR, 0);
  if (wr == 1) BAR8;
  WAIT_V(4); BAR8;
  STAGE_B(SB8(1, 0), 0, 1); STAGE_A(SA8(1, 0), 0, 1); STAGE_B(SB8(1, 1), HALFR, 1);
  WAIT_V(6); BAR8;
  for (int t = 0; t < nt - 2; t += 2) {
    LDB8(B0, 0, 0); SCHED8; LDA8(At, 0, 0); STAGE_A(SA8(1, 1), HALFR, t + 1);
    WAIT_L(8); BAR8; WAIT_L(0); MMA8(0, 0, At, B0); BAR8; SCHED8;
    LDB8(B1, 0, 1); STAGE_B(SB8(0, 0), 0, t + 2);
    BAR8; WAIT_L(0); MMA8(0, 1, At, B1); BAR8;
    LDA8(At, 0, 1); STAGE_A(SA8(0, 0), 0, t + 2);
    BAR8; WAIT_L(0); MMA8(1, 0, At, B0); BAR8; SCHED8;
    STAGE_B(SB8(0, 1), HALFR, t + 2);
    WAIT_V(6); BAR8; MMA8(1, 1, At, B1); BAR8;
    LDB8(B0, 1, 0); SCHED8; LDA8(At, 1, 0); STAGE_A(SA8(0, 1), HALFR, t + 2);
    WAIT_L(8); BAR8; WAIT_L(0); MMA8(0, 0, At, B0); BAR8; SCHED8;
    LDB8(B1, 1, 1); STAGE_B(SB8(1, 0), 0, t + 3);
    BAR8; WAIT_L(0); MMA8(0, 1, At, B1); BAR8;
    LDA8(At, 1, 1); STAGE_A(SA8(1, 0), 0, t + 3);
    BAR8; WAIT_L(0); MMA8(1, 0, At, B0); BAR8; SCHED8;
    STAGE_B(SB8(1, 1), HALFR, t + 3);
    WAIT_V(6); BAR8; MMA8(1, 1, At, B1); BAR8;
  }
  { LDB8(B0, 0, 0); LDA8(At, 0, 0); STAGE_A(SA8(1, 1), HALFR, nt - 1);
    BAR8; WAIT_L(0); MMA8(0, 0, At, B0); BAR8;
    LDB8(B1, 0, 1); BAR8; WAIT_L(0); MMA8(0, 1, At, B1); BAR8;
    LDA8(At, 0, 1); WAIT_V(4); BAR8; WAIT_L(0); MMA8(1, 0, At, B0); MMA8(1, 1, At, B1); BAR8; }
  { LDB8(B0, 1, 0); LDA8(At, 1, 0); WAIT_V(2); BAR8; WAIT_L(0); MMA8(0, 0, At, B0); BAR8;
    LDB8(B1, 1, 1); WAIT_V(0); BAR8; WAIT_L(0); MMA8(0, 1, At, B1); BAR8;
    LDA8(At, 1, 1); BAR8; WAIT_L(0); MMA8(1, 0, At, B0); MMA8(1, 1, At, B1); BAR8; }
  if (wr == 0) BAR8;
  float* ct = (float*)lds;
#pragma unroll
  for (int ai = 0; ai < 2; ++ai) {
    __syncthreads();
#pragma unroll
    for (int bj = 0; bj < 2; ++bj)
#pragma unroll
      for (int m = 0; m < 4; ++m)
#pragma unroll
        for (int n = 0; n < 2; ++n)
#pragma unroll
          for (int j = 0; j < 4; ++j) ct[(wr * 64 + m * 16 + fq * 4 + j) * 260 + bj * 128 + wc * 32 + n * 16 + fr] = acc[ai][bj][m][n][j];
    __syncthreads();
#pragma unroll 2
    for (int it = 0; it < 16; ++it) {
      const int idx = it * NTHR + tid; const int row = idx >> 6, c4 = (idx & 63) * 4;
      f32x4 v = *(const f32x4*)(ct + row * 260 + c4);
      epi(ai * 128 + row, c4, v);
    }
  }
  __syncthreads();
#undef ob0
#undef ob1
#undef SA8
#undef SB8
#undef STAGE_A
#undef STAGE_B
#undef LDA8
#undef LDB8
#undef MMA8
#undef WAIT_V
#undef WAIT_L
#undef BAR8
#undef SCHED8
}

template <int DQK, bool STATIC>
DI void attn_item(const bf16_t* __restrict__ Q, const bf16_t* __restrict__ Kp, const bf16_t* __restrict__ Vt, int nkeys, char* lds,
                  const bf16_t* __restrict__ Pg, bf16_t* __restrict__ Yg  , float mfix) {
  constexpr int KSTR = DQK * 2 + 16, VSTR = 136, KCH = DQK / 8, NKC = (64 * KCH) / 256, NQS = DQK / 16;
  constexpr int KBUF = 64 * KSTR, BUF = KBUF + 64 * VSTR;
  const int tid_full = otid(); const int tid = tid_full & 255; lds += (tid_full >> 8) * HALF_LDS;
  const int lane = tid & 63, w = tid >> 6, l31 = lane & 31, h = lane >> 5;
  bf16x8 qf[NQS];
#pragma unroll
  for (int ks = 0; ks < NQS; ++ks) qf[ks] = *(const bf16x8*)(Q + (size_t)(32 * w + l31) * DQK + 16 * ks + 8 * h);
  f32x16 o[2];
#pragma unroll
  for (int d = 0; d < 2; ++d)
#pragma unroll
    for (int e = 0; e < 16; ++e) o[d][e] = 0.f;
  float m_run = STATIC ? mfix : -1e30f, l_run = 0.f;
  u32x4 rk[NKC], rv[2];
  int koffg[NKC], koffl[NKC];
#pragma unroll
  for (int i = 0; i < NKC; ++i) { const int c = tid + 256 * i; const int key = c / KCH, part = c % KCH; koffg[i] = c * 8; koffl[i] = key * KSTR + part * 16; }
  const int vdv0 = tid >> 3, vpart = tid & 7;
  const bf16_t* vg = Vt + (size_t)vdv0 * T + vpart * 8;
  const int voffl = KBUF + vdv0 * VSTR + vpart * 16;
  const int nt = nkeys >> 6;
#pragma unroll
  for (int i = 0; i < NKC; ++i) rk[i] = *(const u32x4*)(Kp + koffg[i]);
#pragma unroll
  for (int i = 0; i < 2; ++i) rv[i] = *(const u32x4*)(vg + (size_t)i * 32 * T);
#pragma unroll
  for (int i = 0; i < NKC; ++i) *(u32x4*)(lds + koffl[i]) = rk[i];
#pragma unroll
  for (int i = 0; i < 2; ++i) { u32x2 a = {rv[i].x, rv[i].y}, b = {rv[i].z, rv[i].w}; *(u32x2*)(lds + voffl + i * 32 * VSTR) = a; *(u32x2*)(lds + voffl + i * 32 * VSTR + 8) = b; }
  __syncthreads();
  for (int j = 0; j < nt; ++j) {
    char* cur = lds + (j & 1) * BUF;
    const bool more = (j + 1 < nt);
    if (more) {
#pragma unroll
      for (int i = 0; i < NKC; ++i) rk[i] = *(const u32x4*)(Kp + (size_t)(j + 1) * 64 * DQK + koffg[i]);
#pragma unroll
      for (int i = 0; i < 2; ++i) rv[i] = *(const u32x4*)(vg + (size_t)i * 32 * T + (j + 1) * 64);
    }
    f32x16 s0, s1;
    bf16x8 kf[2][NQS];
#pragma unroll
    for (int kb = 0; kb < 2; ++kb)
#pragma unroll
      for (int ks = 0; ks < NQS; ++ks) kf[kb][ks] = *(const bf16x8*)(cur + (32 * kb + l31) * KSTR + (2 * ks + h) * 16);
    u32x4 vw[2][2][2];
#pragma unroll
    for (int kb = 0; kb < 2; ++kb)
#pragma unroll
      for (int s2 = 0; s2 < 2; ++s2)
#pragma unroll
        for (int d = 0; d < 2; ++d) {
          const char* vp = cur + KBUF + (32 * d + l31) * VSTR + (32 * kb + 16 * s2 + 4 * h) * 2;
          u32x2 v0 = *(const u32x2*)vp, v1 = *(const u32x2*)(vp + 16);
          u32x4 t4 = {v0.x, v0.y, v1.x, v1.y}; vw[kb][s2][d] = t4;
        }
#pragma unroll
    for (int e = 0; e < 16; ++e) { s0[e] = STATIC ? -mfix : 0.f; s1[e] = STATIC ? -mfix : 0.f; }
#pragma unroll
    for (int ks = 0; ks < NQS; ++ks) s0 = MFMA32(kf[0][ks], qf[ks], s0);
    if (!STATIC) {
      float mx = s0[0];
#pragma unroll
      for (int e = 1; e < 16; ++e) mx = fmaxf(mx, s0[e]);
      mx = fmaxf(mx, __shfl_xor(mx, 32));
      if (!__all(mx <= m_run + 8.f)) {
        const float m_new = fmaxf(m_run, mx);
        const float alpha = __builtin_amdgcn_exp2f(m_run - m_new);
        m_run = m_new; l_run *= alpha;
#pragma unroll
        for (int d = 0; d < 2; ++d)
#pragma unroll
          for (int e = 0; e < 16; ++e) o[d][e] *= alpha;
      }
    }
#pragma unroll
    for (int ks = 0; ks < NQS; ++ks) s1 = MFMA32(kf[1][ks], qf[ks], s1);
    {
      float ps = 0.f;
#pragma unroll
      for (int e = 0; e < 16; ++e) { float p = STATIC ? __builtin_amdgcn_exp2f(s0[e]) : __builtin_amdgcn_exp2f(s0[e] - m_run); s0[e] = p; ps += p; }
      l_run += ps;
    }
    if (!STATIC) {
      float mx = s1[0];
#pragma unroll
      for (int e = 1; e < 16; ++e) mx = fmaxf(mx, s1[e]);
      mx = fmaxf(mx, __shfl_xor(mx, 32));
      if (!__all(mx <= m_run + 8.f)) {
        const float m_new = fmaxf(m_run, mx);
        const float alpha = __builtin_amdgcn_exp2f(m_run - m_new);
        m_run = m_new; l_run *= alpha;
#pragma unroll
        for (int e = 0; e < 16; ++e) s0[e] *= alpha;
#pragma unroll
        for (int d = 0; d < 2; ++d)
#pragma unroll
          for (int e = 0; e < 16; ++e) o[d][e] *= alpha;
      }
    }
#pragma unroll
    for (int s2 = 0; s2 < 2; ++s2) {
      u32x4 pw = {cvtpk(s0[8 * s2], s0[8 * s2 + 1]), cvtpk(s0[8 * s2 + 2], s0[8 * s2 + 3]), cvtpk(s0[8 * s2 + 4], s0[8 * s2 + 5]), cvtpk(s0[8 * s2 + 6], s0[8 * s2 + 7])};
      bf16x8 pf = __builtin_bit_cast(bf16x8, pw);
#pragma unroll
      for (int d = 0; d < 2; ++d) o[d] = MFMA32(__builtin_bit_cast(bf16x8, vw[0][s2][d]), pf, o[d]);
    }
    {
      float ps = 0.f;
#pragma unroll
      for (int e = 0; e < 16; ++e) { float p = STATIC ? __builtin_amdgcn_exp2f(s1[e]) : __builtin_amdgcn_exp2f(s1[e] - m_run); s1[e] = p; ps += p; }
      l_run += ps;
    }
#pragma unroll
    for (int s2 = 0; s2 < 2; ++s2) {
      u32x4 pw = {cvtpk(s1[8 * s2], s1[8 * s2 + 1]), cvtpk(s1[8 * s2 + 2], s1[8 * s2 + 3]), cvtpk(s1[8 * s2 + 4], s1[8 * s2 + 5]), cvtpk(s1[8 * s2 + 6], s1[8 * s2 + 7])};
      bf16x8 pf = __builtin_bit_cast(bf16x8, pw);
#pragma unroll
      for (int d = 0; d < 2; ++d) o[d] = MFMA32(__builtin_bit_cast(bf16x8, vw[1][s2][d]), pf, o[d]);
    }
    if (more) {
      char* nxt = lds + ((j + 1) & 1) * BUF;
#pragma unroll
      for (int i = 0; i < NKC; ++i) *(u32x4*)(nxt + koffl[i]) = rk[i];
#pragma unroll
      for (int i = 0; i < 2; ++i) { u32x2 a = {rv[i].x, rv[i].y}, b = {rv[i].z, rv[i].w}; *(u32x2*)(nxt + voffl + i * 32 * VSTR) = a; *(u32x2*)(nxt + voffl + i * 32 * VSTR + 8) = b; }
    }
    __syncthreads();
  }
  const float lt = l_run + __shfl_xor(l_run, 32);
  const float inv = 1.f / lt;
  const size_t rq = (size_t)(32 * w + l31);
#pragma unroll
  for (int d = 0; d < 2; ++d)
#pragma unroll
    for (int q = 0; q < 4; ++q) {
      const int dv = 32 * d + 8 * q + 4 * h;
      f32x4 g = unpack4(*(const u32x2*)(Pg + rq * NIN + dv));
      f32x4 v = {o[d][4 * q] * inv * silu(g[0]), o[d][4 * q + 1] * inv * silu(g[1]), o[d][4 * q + 2] * inv * silu(g[2]), o[d][4 * q + 3] * inv * silu(g[3])};
      *(u32x2*)(Yg + rq * 1024 + dv) = pack4(v);
    }
}

template <int DQK, bool STATIC>
DI void attn_item8(const bf16_t* __restrict__ Q, const bf16_t* __restrict__ Kp, const bf16_t* __restrict__ Vt, int nkeys, char* lds,
                  const bf16_t* __restrict__ Pg, bf16_t* __restrict__ Yg  , float mfix) {
  constexpr int KSTR = DQK * 2 + 16, VSTR = 136, KCH = DQK / 8, NKC = (64 * KCH + 511) / 512, NQS = DQK / 16;
  constexpr int KBUF = 64 * KSTR, BUF = KBUF + 64 * VSTR;
  const int tid = otid();
  const int lane = tid & 63, w = tid >> 6, l31 = lane & 31, h = lane >> 5;
  bf16x8 qf[NQS];
#pragma unroll
  for (int ks = 0; ks < NQS; ++ks) qf[ks] = *(const bf16x8*)(Q + (size_t)(32 * w + l31) * DQK + 16 * ks + 8 * h);
  f32x16 o[2];
#pragma unroll
  for (int d = 0; d < 2; ++d)
#pragma unroll
    for (int e = 0; e < 16; ++e) o[d][e] = 0.f;
  float m_run = STATIC ? mfix : -1e30f, l_run = 0.f;
  u32x4 rk[NKC], rv[1];
  int koffg[NKC], koffl[NKC];
#pragma unroll
  for (int i = 0; i < NKC; ++i) { const int c = tid + 512 * i; const int key = c / KCH, part = c % KCH; koffg[i] = (c < 64 * KCH) ? c * 8 : 0; koffl[i] = (c < 64 * KCH) ? key * KSTR + part * 16 : -1; }
  const int vdv0 = tid >> 3, vpart = tid & 7;
  const bf16_t* vg = Vt + (size_t)vdv0 * T + vpart * 8;
  const int voffl = KBUF + vdv0 * VSTR + vpart * 16;
  const int nt = nkeys >> 6;
#pragma unroll
  for (int i = 0; i < NKC; ++i) rk[i] = *(const u32x4*)(Kp + koffg[i]);
#pragma unroll
  for (int i = 0; i < 1; ++i) rv[i] = *(const u32x4*)(vg + (size_t)i * 32 * T);
#pragma unroll
  for (int i = 0; i < NKC; ++i) if (koffl[i] >= 0) *(u32x4*)(lds + koffl[i]) = rk[i];
#pragma unroll
  for (int i = 0; i < 1; ++i) { u32x2 a = {rv[i].x, rv[i].y}, b = {rv[i].z, rv[i].w}; *(u32x2*)(lds + voffl + i * 32 * VSTR) = a; *(u32x2*)(lds + voffl + i * 32 * VSTR + 8) = b; }
  {
#pragma unroll
    for (int i = 0; i < NKC; ++i) rk[i] = *(const u32x4*)(Kp + (size_t)64 * DQK + koffg[i]);
    rv[0] = *(const u32x4*)(vg + 64);
#pragma unroll
    for (int i = 0; i < NKC; ++i) if (koffl[i] >= 0) *(u32x4*)(lds + BUF + koffl[i]) = rk[i];
    { u32x2 a = {rv[0].x, rv[0].y}, b = {rv[0].z, rv[0].w}; *(u32x2*)(lds + BUF + voffl) = a; *(u32x2*)(lds + BUF + voffl + 8) = b; }
  }
  __syncthreads();
  const int np = nt >> 1;
  for (int jj = 0; jj < np; ++jj) {
   char* curp = lds + (jj & 1) * 2 * BUF; char* nxtp = lds + ((jj + 1) & 1) * 2 * BUF;
   const bool more = (jj + 1 < np);
#pragma nounroll
   for (int sub = 0; sub < 2; ++sub) {
    const char* cur = curp + sub * BUF;
    const int j = 2 * jj + sub + 1;
    if (more) {
#pragma unroll
      for (int i = 0; i < NKC; ++i) rk[i] = *(const u32x4*)(Kp + (size_t)(j + 1) * 64 * DQK + koffg[i]);
#pragma unroll
      for (int i = 0; i < 1; ++i) rv[i] = *(const u32x4*)(vg + (size_t)i * 32 * T + (j + 1) * 64);
    }
    f32x16 s0, s1;
    bf16x8 kf[2][NQS];
#pragma unroll
    for (int kb = 0; kb < 2; ++kb)
#pragma unroll
      for (int ks = 0; ks < NQS; ++ks) kf[kb][ks] = *(const bf16x8*)(cur + (32 * kb + l31) * KSTR + (2 * ks + h) * 16);
    u32x4 vw[2][2][2];
#pragma unroll
    for (int kb = 0; kb < 2; ++kb)
#pragma unroll
      for (int s2 = 0; s2 < 2; ++s2)
#pragma unroll
        for (int d = 0; d < 2; ++d) {
          const char* vp = cur + KBUF + (32 * d + l31) * VSTR + (32 * kb + 16 * s2 + 4 * h) * 2;
          u32x2 v0 = *(const u32x2*)vp, v1 = *(const u32x2*)(vp + 16);
          u32x4 t4 = {v0.x, v0.y, v1.x, v1.y}; vw[kb][s2][d] = t4;
        }
#pragma unroll
    for (int e = 0; e < 16; ++e) { s0[e] = STATIC ? -mfix : 0.f; s1[e] = STATIC ? -mfix : 0.f; }
#pragma unroll
    for (int ks = 0; ks < NQS; ++ks) s0 = MFMA32(kf[0][ks], qf[ks], s0);
    if (!STATIC) {
      float mx = s0[0];
#pragma unroll
      for (int e = 1; e < 16; ++e) mx = fmaxf(mx, s0[e]);
      mx = fmaxf(mx, __shfl_xor(mx, 32));
      if (!__all(mx <= m_run + 8.f)) {
        const float m_new = fmaxf(m_run, mx);
        const float alpha = __builtin_amdgcn_exp2f(m_run - m_new);
        m_run = m_new; l_run *= alpha;
#pragma unroll
        for (int d = 0; d < 2; ++d)
#pragma unroll
          for (int e = 0; e < 16; ++e) o[d][e] *= alpha;
      }
    }
#pragma unroll
    for (int ks = 0; ks < NQS; ++ks) s1 = MFMA32(kf[1][ks], qf[ks], s1);
    {
      float ps = 0.f;
#pragma unroll
      for (int e = 0; e < 16; ++e) { float p = STATIC ? __builtin_amdgcn_exp2f(s0[e]) : __builtin_amdgcn_exp2f(s0[e] - m_run); s0[e] = p; ps += p; }
      l_run += ps;
    }
    if (!STATIC) {
      float mx = s1[0];
#pragma unroll
      for (int e = 1; e < 16; ++e) mx = fmaxf(mx, s1[e]);
      mx = fmaxf(mx, __shfl_xor(mx, 32));
      if (!__all(mx <= m_run + 8.f)) {
        const float m_new = fmaxf(m_run, mx);
        const float alpha = __builtin_amdgcn_exp2f(m_run - m_new);
        m_run = m_new; l_run *= alpha;
#pragma unroll
        for (int e = 0; e < 16; ++e) s0[e] *= alpha;
#pragma unroll
        for (int d = 0; d < 2; ++d)
#pragma unroll
          for (int e = 0; e < 16; ++e) o[d][e] *= alpha;
      }
    }
#pragma unroll
    for (int s2 = 0; s2 < 2; ++s2) {
      u32x4 pw = {cvtpk(s0[8 * s2], s0[8 * s2 + 1]), cvtpk(s0[8 * s2 + 2], s0[8 * s2 + 3]), cvtpk(s0[8 * s2 + 4], s0[8 * s2 + 5]), cvtpk(s0[8 * s2 + 6], s0[8 * s2 + 7])};
      bf16x8 pf = __builtin_bit_cast(bf16x8, pw);
#pragma unroll
      for (int d = 0; d < 2; ++d) o[d] = MFMA32(__builtin_bit_cast(bf16x8, vw[0][s2][d]), pf, o[d]);
    }
    {
      float ps = 0.f;
#pragma unroll
      for (int e = 0; e < 16; ++e) { float p = STATIC ? __builtin_amdgcn_exp2f(s1[e]) : __builtin_amdgcn_exp2f(s1[e] - m_run); s1[e] = p; ps += p; }
      l_run += ps;
    }
#pragma unroll
    for (int s2 = 0; s2 < 2; ++s2) {
      u32x4 pw = {cvtpk(s1[8 * s2], s1[8 * s2 + 1]), cvtpk(s1[8 * s2 + 2], s1[8 * s2 + 3]), cvtpk(s1[8 * s2 + 4], s1[8 * s2 + 5]), cvtpk(s1[8 * s2 + 6], s1[8 * s2 + 7])};
      bf16x8 pf = __builtin_bit_cast(bf16x8, pw);
#pragma unroll
      for (int d = 0; d < 2; ++d) o[d] = MFMA32(__builtin_bit_cast(bf16x8, vw[1][s2][d]), pf, o[d]);
    }
    if (more) {
      char* nxt = nxtp + sub * BUF;
#pragma unroll
      for (int i = 0; i < NKC; ++i) if (koffl[i] >= 0) *(u32x4*)(nxt + koffl[i]) = rk[i];
#pragma unroll
      for (int i = 0; i < 1; ++i) { u32x2 a = {rv[i].x, rv[i].y}, b = {rv[i].z, rv[i].w}; *(u32x2*)(nxt + voffl + i * 32 * VSTR) = a; *(u32x2*)(nxt + voffl + i * 32 * VSTR + 8) = b; }
    }
   }
   __syncthreads();
  }
  const float lt = l_run + __shfl_xor(l_run, 32);
  const float inv = 1.f / lt;
  const size_t rq = (size_t)(32 * w + l31);
#pragma unroll
  for (int d = 0; d < 2; ++d)
#pragma unroll
    for (int q = 0; q < 4; ++q) {
      const int dv = 32 * d + 8 * q + 4 * h;
      f32x4 g = unpack4(*(const u32x2*)(Pg + rq * NIN + dv));
      f32x4 v = {o[d][4 * q] * inv * silu(g[0]), o[d][4 * q + 1] * inv * silu(g[1]), o[d][4 * q + 2] * inv * silu(g[2]), o[d][4 * q + 3] * inv * silu(g[3])};
      *(u32x2*)(Yg + rq * 1024 + dv) = pack4(v);
    }
}

DI void xpose_cvt(const float* __restrict__ src, bf16_t* __restrict__ dst, int K, int N, int Npad, bool perm_kv, size_t gtid, size_t gstride) {
  const size_t total = (size_t)Npad * (K >> 3);
#pragma nounroll
  for (size_t i = gtid; i < total; i += gstride) {
    const int n = (int)(i % Npad), kb = (int)(i / Npad);
    float v[8];
#pragma unroll
    for (int e = 0; e < 8; ++e) v[e] = (n < N) ? src[(size_t)(8 * kb + e) * N + n] : 0.f;
    int row = n;
    if (perm_kv) { const int hh = n >> 7, wv = n & 127; row = (wv < 64) ? (64 * hh + wv) : (256 + 64 * hh + (wv - 64)); }
    u32x4 o = {cvtpk(v[0], v[1]), cvtpk(v[2], v[3]), cvtpk(v[4], v[5]), cvtpk(v[6], v[7])};
    *(u32x4*)(dst + (size_t)row * K + 8 * kb) = o;
  }
}

DI void phase0(KP p, char* lds) {
  unsigned char* ws = p->ws; asm volatile("" : "+s"(ws));
  const int tid = otid();
  const size_t gtid = (size_t)blockIdx.x * NTHR + tid, gstride = (size_t)gridDim.x * NTHR;
  for (int l = 0; l < 2; ++l) {
    xpose_cvt(p->w_in + (size_t)l * 1024 * NIN, (bf16_t*)(ws + WS_WIN) + (size_t)l * NINP * 1024, 1024, NIN, NINP, false, gtid, gstride);
    xpose_cvt(p->mla_w_uq + (size_t)l * 192 * 384, (bf16_t*)(ws + WS_WUQ) + (size_t)l * 384 * 192, 192, 384, 384, false, gtid, gstride);
    xpose_cvt(p->mla_w_ukv + (size_t)l * 128 * 512, (bf16_t*)(ws + WS_WUKV) + (size_t)l * 512 * 128, 128, 512, 512, true, gtid, gstride);
    xpose_cvt(p->fnet_w + (size_t)l * 256 * 256, (bf16_t*)(ws + WS_WF) + (size_t)l * 256 * 256, 256, 256, 256, false, gtid, gstride);
    xpose_cvt(p->w_out + (size_t)l * 1024 * 1024, (bf16_t*)(ws + WS_WOUT) + (size_t)l * 1024 * 1024, 1024, 1024, 1024, false, gtid, gstride);
  }
  {
    const float* src = p->cm_w_s; bf16_t* dst = (bf16_t*)(ws + WS_WS);
    for (size_t i = gtid; i < (size_t)2 * 4 * 128 * 128 / 8; i += gstride) {
      f32x4 a = *(const f32x4*)(src + i * 8), b = *(const f32x4*)(src + i * 8 + 4);
      u32x4 o = {cvtpk(a[0], a[1]), cvtpk(a[2], a[3]), cvtpk(b[0], b[1]), cvtpk(b[2], b[3])};
      *(u32x4*)(dst + i * 8) = o;
    }
  }
  {
    bf16_t* dl = (bf16_t*)(ws + WS_DLAT);
#pragma nounroll
    for (size_t i = gtid; i < (size_t)2048 * 256; i += gstride) {
      const int sp = (int)(i >> 8), k8 = (int)(i & 255) * 8;
      float v[8];
#pragma unroll
      for (int e = 0; e < 8; ++e) { const int k = k8 + e, s = (k <= 1024) ? k : k - 1024; const int ph = (sp * s) & 2047; const float a = (float)ph * (1.f / 1024.f); v[e] = (k <= 1024) ? cospif(a) : -sinpif(a); }
      u32x4 o = {cvtpk(v[0], v[1]), cvtpk(v[2], v[3]), cvtpk(v[4], v[5]), cvtpk(v[6], v[7])};
      *(u32x4*)(dl + (size_t)sp * 2048 + k8) = o;
    }
    bf16_t* dc = (bf16_t*)(ws + WS_DCTX);
    for (size_t i = gtid; i < (size_t)256 * 64; i += gstride) {
      const int sp = (int)(i >> 6), k8 = (int)(i & 63) * 8;
      float v[8];
#pragma unroll
      for (int e = 0; e < 8; ++e) { const int k = k8 + e, s = k & 255; const int ph = (sp * s) & 255; const float a = (float)ph * (1.f / 128.f); v[e] = (k < 256) ? cospif(a) : -sinpif(a); }
      u32x4 o = {cvtpk(v[0], v[1]), cvtpk(v[2], v[3]), cvtpk(v[4], v[5]), cvtpk(v[6], v[7])};
      *(u32x4*)(dc + (size_t)sp * 512 + k8) = o;
    }
    bf16_t* cm = (bf16_t*)(ws + WS_CM);
    for (size_t i = gtid; i < (size_t)128 * 64; i += gstride) {
      const int n = (int)(i >> 6), c = (int)(i & 63);
      const int ph = (c * (n & 63)) & 63; const float a = (float)ph * (1.f / 32.f);
      cm[i] = f2bf((n < 64) ? cospif(a) : sinpif(a));
    }
    float* rg = (float*)(ws + WS_ROPG);
    for (size_t i = gtid; i < 64 * 16; i += gstride) {
      const int pos = (int)(i >> 4), j = (int)(i & 15);
      const float inv = powf(10000.f, -(float)j / 16.f); float sn, cs; sincosf((float)pos * inv, &sn, &cs);
      rg[2 * i] = cs; rg[2 * i + 1] = sn;
    }
    if (blockIdx.x == 0 && tid < 4) {
      const int l = tid >> 1, isb = tid & 1; const int d = isb ? 64 : 96;
      const float* gq = (isb ? p->gqa_qn : p->mla_qn) + l * d; const float* gk = (isb ? p->gqa_kn : p->mla_kn) + l * d;
      float mq = 0.f, mk = 0.f;
      for (int i = 0; i < d; ++i) { mq = fmaxf(mq, fabsf(gq[i])); mk = fmaxf(mk, fabsf(gk[i])); }
      ((float*)(ws + WS_SBND))[l * 2 + isb] = sqrtf((float)d) * mq * mk * 1.4426950408889634f;
    }
    float* rm = (float*)(ws + WS_ROPM);
    for (size_t i = gtid; i < 64 * 8; i += gstride) {
      const int pos = (int)(i >> 3), j = (int)(i & 7);
      const float inv = powf(10000.f, -(float)j / 8.f); float sn, cs; sincosf((float)pos * inv, &sn, &cs);
      rm[2 * i] = cs; rm[2 * i + 1] = sn;
    }
  }
  const int hb = tid >> 8, tq = tid & 255;
  float* sl = (float*)(lds + hb * HALF_LDS);
  float* mod = (float*)(ws + WS_MOD);
  const int kg = tq >> 5, cn = tq & 31;
  for (int it = 2 * blockIdx.x + hb; it < 192; it += 2 * gridDim.x) {
    const int l = it / 96, n = (it % 96) * 32 + cn;
    float acc[17];
#pragma unroll
    for (int i = 0; i < 17; ++i) acc[i] = 0.f;
    for (int half = 0; half < 2; ++half) {
      __syncthreads();
      for (int e = tq; e < 17 * 512; e += 256) {
        const int i = e >> 9, k = (e & 511) + 512 * half;
        const float cv = (i < 16) ? p->c[i * 1024 + k] : p->c_ctx[k];
        sl[e] = silu(cv);
      }
      __syncthreads();
      const float* wp = p->w_mod + ((size_t)l * 1024 + 512 * half + kg * 64) * 3072 + n;
#pragma unroll 4
      for (int kk = 0; kk < 64; ++kk) {
        const float wv = wp[(size_t)kk * 3072];
#pragma unroll
        for (int i = 0; i < 17; ++i) acc[i] = fmaf(sl[i * 512 + kg * 64 + kk], wv, acc[i]);
      }
    }
    __syncthreads();
#pragma unroll
    for (int i = 0; i < 17; ++i) sl[(kg * 17 + i) * 32 + cn] = acc[i];
    __syncthreads();
    for (int e = tq; e < 17 * 32; e += 256) {
      const int i = e >> 5, c2 = e & 31;
      float s = 0.f;
#pragma unroll
      for (int g = 0; g < 8; ++g) s += sl[(g * 17 + i) * 32 + c2];
      const int nn = (it % 96) * 32 + c2;
      mod[((size_t)l * 17 + i) * 3072 + nn] = s + p->b_mod[l * 3072 + nn];
    }
    __syncthreads();
  }
}

DI void phase_norm(KP p, int l) {
  unsigned char* ws = p->ws; asm volatile("" : "+s"(ws));
  const float* xl = (l == 0) ? p->x : p->out;
  const float* xc = (l == 0) ? p->ctx : (const float*)(ws + WS_CTX1);
  const float* g = p->norm_g + l * 1024;
  const float* mod = (const float*)(ws + WS_MOD) + (size_t)l * 17 * 3072;
  bf16_t* hx = (bf16_t*)(ws + WS_R1);
  const int tid = otid(); const int lane = tid & 63;
  const int gw = blockIdx.x * (NTHR / 64) + (tid >> 6), nw = gridDim.x * (NTHR / 64);
  const int rpw = (M + nw - 1) / nw;
  int cur_mod = -1;
  f32x4 G[4], SH[4];
#pragma unroll 2
  for (int r = gw * rpw; r < min(M, (gw + 1) * rpw); ++r) {
    const int b = r / T, t = r % T;
    const float* src = (t < SEQ) ? xl + ((size_t)b * SEQ + t) * 1024 : xc + ((size_t)b * CL + (t - SEQ)) * 1024;
    const int mrow = (t < SEQ) ? b : 16;
    if (mrow != cur_mod) {
      cur_mod = mrow;
      const float* mr = mod + (size_t)mrow * 3072;
#pragma unroll
      for (int i = 0; i < 4; ++i) {
        const int k = i * 256 + lane * 4;
        const f32x4 gg = *(const f32x4*)(g + k), sc = *(const f32x4*)(mr + 1024 + k);
        SH[i] = *(const f32x4*)(mr + k);
#pragma unroll
        for (int e = 0; e < 4; ++e) G[i][e] = gg[e] * (1.f + sc[e]);
      }
    }
    f32x4 v[4]; float ss = 0.f;
#pragma unroll
    for (int i = 0; i < 4; ++i) { v[i] = *(const f32x4*)(src + i * 256 + lane * 4); ss += v[i][0] * v[i][0] + v[i][1] * v[i][1] + v[i][2] * v[i][2] + v[i][3] * v[i][3]; }
    ss = red64(ss);
    const float rstd = rsqrtf(ss * (1.f / 1024.f) + 1e-6f);
#pragma unroll
    for (int i = 0; i < 4; ++i) {
      const int k = i * 256 + lane * 4;
      f32x4 o;
#pragma unroll
      for (int e = 0; e < 4; ++e) o[e] = v[i][e] * rstd * G[i][e] + SH[i][e];
      *(u32x2*)(hx + (size_t)r * 1024 + k) = pack4(o);
    }
  }
}

DI void phase_inproj(KP p, int l, char* lds) {
  unsigned char* ws = p->ws; asm volatile("" : "+s"(ws));
  const bf16_t* hx = (const bf16_t*)(ws + WS_R1);
  const bf16_t* wt = (const bf16_t*)(ws + WS_WIN) + (size_t)l * NINP * 1024;
  bf16_t* P = (bf16_t*)(ws + WS_P);
  const int xcd = blockIdx.x & 7, lb = blockIdx.x >> 3, nlb = gridDim.x >> 3, hb = __builtin_amdgcn_readfirstlane(otid() >> 8);
  constexpr int NBIG = 18 * 10;
  for (int j = lb; j < NBIG; j += nlb) {
    {
      int mloc, ntile;
      if (j < 144) { mloc = (j % 72) >> 2; ntile = (j / 72) * 4 + (j & 3); } else { const int j2 = j - 144; mloc = j2 >> 1; ntile = 8 + (j2 & 1); }
      const int mt = 18 * xcd + mloc;
      if (l == 1 && (mt % 9) == 8 && !(ntile == 0 || ntile == 1 || ntile == 3 || ntile == 4)) continue;
      const int m0 = mt * 256, n0 = ntile * 256;
      gemm256(hx + (size_t)m0 * 1024, 1024, wt + (size_t)n0 * 1024, 1024, 1024, lds, [&](int m, int n, f32x4 v) {
        __builtin_nontemporal_store(pack4(v), (u32x2*)(P + (size_t)(m0 + m) * NIN + n0 + n));
      });
    }
  }
  const int nfull = NBIG % nlb, nfree = (nfull == 0) ? nlb : nlb - nfull;
  for (int sp = (nfull == 0) ? lb : lb - nfull; sp >= 0 && sp < 18; sp += nfree) {
    {
      const int mt = 36 * xcd + 2 * sp + hb;
      if (l == 1 && (mt % 18) >= 16) continue;
      const int m0 = mt * 128;
      gemm_tile(hx + (size_t)m0 * 1024, 1024, wt + (size_t)2560 * 1024, 1024, 1024, lds, [&](int m, int n, f32x4 v) {
        if (2560 + n < NIN) __builtin_nontemporal_store(pack4(v), (u32x2*)(P + (size_t)(m0 + m) * NIN + 2560 + n));
      });
    }
  }
}

DI void rope4(f32x4& v, int u, const float sg, const float* cs) {
#pragma unroll
  for (int e = 0; e < 4; ++e) {
    const float xp = __shfl_xor(v[e], 4);
    v[e] = v[e] * cs[2 * e] + sg * xp * cs[2 * e + 1];
  }
}
DI void rope2(float& a, float& b, const float sg, const f32x4 cs) {
  const float ap = __shfl_xor(a, 4), bp = __shfl_xor(b, 4);
  a = a * cs[0] + sg * ap * cs[1];
  b = b * cs[2] + sg * bp * cs[3];
}

DI void phase_feat_a(KP p, int l, char* lds) {
  unsigned char* ws = p->ws; asm volatile("" : "+s"(ws));
  const bf16_t* P = (const bf16_t*)(ws + WS_P);
  bf16_t* cqn = (bf16_t*)(ws + WS_R1 + R1_CQN);
  bf16_t* ckvn = (bf16_t*)(ws + WS_R1 + R1_CKVN);
  bf16_t* QB = (bf16_t*)(ws + WS_QB); bf16_t* KB = (bf16_t*)(ws + WS_KB); bf16_t* VBT = (bf16_t*)(ws + WS_VBT);
  bf16_t* vnT = (bf16_t*)(ws + WS_VNT);
  const float* rg = (const float*)(ws + WS_ROPG);
  const int tid = otid(); const int lane = tid & 63, u = lane & 15, sub = lane >> 4;
  const int gw = blockIdx.x * (NTHR / 64) + (tid >> 6), nw = gridDim.x * (NTHR / 64);
  const int hb = tid >> 8, tq = tid & 255; char* ldh = lds + hb * HALF_LDS;
  {
    constexpr int STR = 144;
    const float* lg = p->cm_ln_g + l * 256; const float* lbp = p->cm_ln_b + l * 256;
    for (int unit = 2 * blockIdx.x + hb; unit < (M / 64) * 2; unit += 2 * gridDim.x) {
      const int grp = unit >> 1; const bool isv2 = unit & 1;
      const int r0 = grp * 64; const int b = r0 / T, t0 = r0 % T;
      if (!isv2) {
        const int c = tq & 31, rb = 2 * (tq >> 5);
        f32x4 g0 = *(const f32x4*)(lg + 8 * c), g1 = *(const f32x4*)(lg + 8 * c + 4), b0 = *(const f32x4*)(lbp + 8 * c), b1 = *(const f32x4*)(lbp + 8 * c + 4);
        const float gg[8] = {g0[0], g0[1], g0[2], g0[3], g1[0], g1[1], g1[2], g1[3]};
        const float bb[8] = {b0[0], b0[1], b0[2], b0[3], b1[0], b1[1], b1[2], b1[3]};
#pragma unroll
        for (int i = 0; i < 4; ++i) {
          float vn[2][8];
#pragma unroll
          for (int rr = 0; rr < 2; ++rr) {
            const int row = rb + 16 * i + rr;
            u32x4 q = *(const u32x4*)(P + (size_t)(r0 + row) * NIN + O_V + 8 * c);
            float f[8] = {bflo(q.x), bfhi(q.x), bflo(q.y), bfhi(q.y), bflo(q.z), bfhi(q.z), bflo(q.w), bfhi(q.w)};
            float s1 = 0.f, s2 = 0.f;
#pragma unroll
            for (int e = 0; e < 8; ++e) { s1 += f[e]; s2 += f[e] * f[e]; }
#pragma unroll
            for (int m = 1; m < 32; m <<= 1) { s1 += __shfl_xor(s1, m); s2 += __shfl_xor(s2, m); }
            const float mu = s1 * (1.f / 256.f); const float var = fmaxf(s2 * (1.f / 256.f) - mu * mu, 0.f); const float rs = rsqrtf(var + 1e-6f);
#pragma unroll
            for (int e = 0; e < 8; ++e) vn[rr][e] = (f[e] - mu) * rs * gg[e] + bb[e];
          }
#pragma unroll
          for (int e = 0; e < 8; ++e) *(unsigned*)(ldh + (8 * c + e) * STR + (rb + 16 * i) * 2) = cvtpk(vn[0][e], vn[1][e]);
        }
        __syncthreads();
        bf16_t* vo = vnT + (size_t)(r0 >> 7) * 256 * 128 + (r0 & 127);
#pragma unroll
        for (int i = 0; i < 8; ++i) {
          const int ch = (tq >> 3) + 32 * i, part = tq & 7;
          *(u32x4*)(vo + (size_t)ch * 128 + part * 8) = *(const u32x4*)(ldh + ch * STR + part * 16);
        }
      } else {
        const int c = tq & 15, rb = 2 * (tq >> 4);
#pragma unroll
        for (int i = 0; i < 2; ++i) {
          u32x4 q0 = *(const u32x4*)(P + (size_t)(r0 + rb + 32 * i) * NIN + O_V2 + 8 * c);
          u32x4 q1 = *(const u32x4*)(P + (size_t)(r0 + rb + 32 * i + 1) * NIN + O_V2 + 8 * c);
          const unsigned a[4] = {q0.x, q0.y, q0.z, q0.w}, d[4] = {q1.x, q1.y, q1.z, q1.w};
#pragma unroll
          for (int e = 0; e < 4; ++e) {
            *(unsigned*)(ldh + (8 * c + 2 * e) * STR + (rb + 32 * i) * 2) = (a[e] & 0xffffu) | (d[e] << 16);
            *(unsigned*)(ldh + (8 * c + 2 * e + 1) * STR + (rb + 32 * i) * 2) = (a[e] >> 16) | (d[e] & 0xffff0000u);
          }
        }
        __syncthreads();
        bf16_t* vb = VBT + (size_t)b * 2 * 64 * T + t0;
#pragma unroll
        for (int i = 0; i < 4; ++i) {
          const int ch = (tq >> 3) + 32 * i, part = tq & 7;
          *(u32x4*)(vb + (size_t)ch * T + part * 8) = *(const u32x4*)(ldh + ch * STR + part * 16);
        }
      }
      __syncthreads();
    }
  }
  constexpr int NTA = M / 4;
  f32x4 gcq[3], gckv[2];
#pragma unroll
  for (int e = 0; e < 3; ++e) gcq[e] = *(const f32x4*)(p->mla_q_norm + l * 192 + 12 * u + 4 * e);
#pragma unroll
  for (int e = 0; e < 2; ++e) gckv[e] = *(const f32x4*)(p->mla_kv_norm + l * 128 + 8 * u + 4 * e);
#pragma unroll 4
  for (int task = gw; task < NTA; task += nw) {
    {
      const int r = task * 4 + sub; const int b = r / T, t = r % T;
      const bf16_t* pr = P + (size_t)r * NIN;
      {
        f32x4 v[3]; float ss = 0.f;
#pragma unroll
        for (int e = 0; e < 3; ++e) { v[e] = unpack4(*(const u32x2*)(pr + O_CQ + 12 * u + 4 * e)); ss += v[e][0] * v[e][0] + v[e][1] * v[e][1] + v[e][2] * v[e][2] + v[e][3] * v[e][3]; }
        ss = red16(ss); const float rs = rsqrtf(ss * (1.f / 192.f) + 1e-6f);
#pragma unroll
        for (int e = 0; e < 3; ++e) {
          const f32x4 g = gcq[e];
          f32x4 o = {v[e][0] * rs * g[0], v[e][1] * rs * g[1], v[e][2] * rs * g[2], v[e][3] * rs * g[3]};
          *(u32x2*)(cqn + (size_t)r * 192 + 12 * u + 4 * e) = pack4(o);
        }
      }
      {
        f32x4 v[2]; float ss = 0.f;
#pragma unroll
        for (int e = 0; e < 2; ++e) { v[e] = unpack4(*(const u32x2*)(pr + O_CKV + 8 * u + 4 * e)); ss += v[e][0] * v[e][0] + v[e][1] * v[e][1] + v[e][2] * v[e][2] + v[e][3] * v[e][3]; }
        ss = red16(ss); const float rs = rsqrtf(ss * (1.f / 128.f) + 1e-6f);
#pragma unroll
        for (int e = 0; e < 2; ++e) {
          const f32x4 g = gckv[e];
          f32x4 o = {v[e][0] * rs * g[0], v[e][1] * rs * g[1], v[e][2] * rs * g[2], v[e][3] * rs * g[3]};
          *(u32x2*)(ckvn + (size_t)r * 128 + 8 * u + 4 * e) = pack4(o);
        }
      }
      const int posg = (u & 8) ? (t & 63) : (t >> 6); const float sgg = (u & 4) ? 1.f : -1.f;
      const f32x4 c01 = *(const f32x4*)(rg + (posg * 16 + 4 * (u & 3)) * 2), c23 = *(const f32x4*)(rg + (posg * 16 + 4 * (u & 3) + 2) * 2);
      const float csg[8] = {c01[0], c01[1], c01[2], c01[3], c23[0], c23[1], c23[2], c23[3]};
      const f32x4 gqv = *(const f32x4*)(p->gqa_qn + l * 64 + 4 * u), gkv = *(const f32x4*)(p->gqa_kn + l * 64 + 4 * u);
#pragma unroll
      for (int hh = 0; hh < 6; ++hh) {
        const bool isq = hh < 4; const int hd = isq ? hh : hh - 4;
        f32x4 v = unpack4(*(const u32x2*)(pr + (isq ? O_Q2 : O_K2) + 64 * hd + 4 * u));
        float ss = red16(v[0] * v[0] + v[1] * v[1] + v[2] * v[2] + v[3] * v[3]);
        const float rs = rsqrtf(ss * (1.f / 64.f) + 1e-6f);
        const f32x4 g = isq ? gqv : gkv;
#pragma unroll
        for (int e = 0; e < 4; ++e) v[e] = v[e] * rs * g[e];
        if (t < SEQ) rope4(v, u, sgg, csg);
        if (isq) {
#pragma unroll
          for (int e = 0; e < 4; ++e) v[e] *= 0.18033688011112042f;
        }
        bf16_t* dst = isq ? QB + (((size_t)b * 4 + hd) * T + t) * 64 + 4 * u : KB + (((size_t)b * 2 + hd) * T + t) * 64 + 4 * u;
        *(u32x2*)dst = pack4(v);
      }
    }
  }
}

DI void phase_feat_b(KP p, int l, char* lds) {
  unsigned char* ws = p->ws; asm volatile("" : "+s"(ws));
  const bf16_t* P = (const bf16_t*)(ws + WS_P);
  const bf16_t* cqn = (const bf16_t*)(ws + WS_R1 + R1_CQN);
  const bf16_t* ckvn = (const bf16_t*)(ws + WS_R1 + R1_CKVN);
  bf16_t* q1r = (bf16_t*)(ws + WS_R1 + R1_Q1R);
  bf16_t* kr = (bf16_t*)(ws + WS_R1 + R1_KR);
  const bf16_t* wuq = (const bf16_t*)(ws + WS_WUQ) + (size_t)l * 384 * 192;
  const bf16_t* wukv = (const bf16_t*)(ws + WS_WUKV) + (size_t)l * 512 * 128;
  const bf16_t* cm = (const bf16_t*)(ws + WS_CM);
  bf16_t* VAT = (bf16_t*)(ws + WS_VAT); bf16_t* FT = (bf16_t*)(ws + WS_FT); bf16_t* FTC = (bf16_t*)(ws + WS_FTC);
  constexpr int N1 = 288 * 3, N2 = 288 * 2, N3 = 288 * 2, N4 = 288 * 4;
  const int hbb = __builtin_amdgcn_readfirstlane(otid() >> 8);
  for (int it = 2 * blockIdx.x + hbb; it < N1 + N2 + N3 + N4; it += 2 * gridDim.x) {
    if (it < N1) {
      const int mt = it / 3, nt = it % 3; const int m0 = mt * 128, n0 = nt * 128;
      gemm_tile(cqn + (size_t)m0 * 192, 192, wuq + (size_t)n0 * 192, 192, 192, lds, [&](int m, int n, f32x4 v) {
        *(u32x2*)(q1r + (size_t)(m0 + m) * 384 + n0 + n) = pack4(v); });
    } else if (it < N1 + N2) {
      const int i2 = it - N1; const int mt = i2 >> 1, nt = i2 & 1; const int m0 = mt * 128, n0 = nt * 128;
      gemm_tile(ckvn + (size_t)m0 * 128, 128, wukv + (size_t)n0 * 128, 128, 128, lds, [&](int m, int n, f32x4 v) {
        *(u32x2*)(kr + (size_t)(m0 + m) * 256 + n0 + n) = pack4(v); });
    } else if (it < N1 + N2 + N3) {
      const int i2 = it - N1 - N2; const int tt = i2 >> 1, mt2 = i2 & 1;
      gemm_tile(wukv + (size_t)(256 + 128 * mt2) * 128, 128, ckvn + (size_t)tt * 128 * 128, 128, 128, lds, [&](int m, int n, f32x4 v) {
        const int mm = 128 * mt2 + m, head = mm >> 6, dv = mm & 63; const int r = tt * 128 + n; const int b = r / T, t = r % T;
        *(u32x2*)(VAT + (((size_t)b * 4 + head) * 64 + dv) * T + t) = pack4(v); });
    } else {
      const int i2 = it - N1 - N2 - N3; const int tt = i2 >> 2, g = i2 & 3;
      gemm_tile(cm, 64, P + (size_t)tt * 128 * NIN + O_F + 64 * g, NIN, 64, lds, [&](int m, int n, f32x4 v) {
        const int col = 64 * g + (m & 63), part = m >> 6; const int r = tt * 128 + n; const int b = r / T, t = r % T;
        if (t < SEQ) *(u32x2*)(FT + ((size_t)b * 256 + col) * 4096 + part * 2048 + t) = pack4(v);
        else *(u32x2*)(FTC + ((size_t)b * 256 + col) * 512 + part * 256 + (t - SEQ)) = pack4(v); });
    }
  }
}

DI void phase_feat_c(KP p, int l) {
  unsigned char* ws = p->ws; asm volatile("" : "+s"(ws));
  const bf16_t* P = (const bf16_t*)(ws + WS_P);
  const bf16_t* q1r = (const bf16_t*)(ws + WS_R1 + R1_Q1R);
  const bf16_t* krw = (const bf16_t*)(ws + WS_R1 + R1_KR);
  bf16_t* QA = (bf16_t*)(ws + WS_QA); bf16_t* KA = (bf16_t*)(ws + WS_KA);
  const float* rm = (const float*)(ws + WS_ROPM);
  const int tid = otid(); const int lane = tid & 63, u = lane & 15, sub = lane >> 4;
  const int gw = blockIdx.x * (NTHR / 64) + (tid >> 6), nw = gridDim.x * (NTHR / 64);
  {
    const bf16_t* FT = (const bf16_t*)(ws + WS_FT); bf16_t* FTF = (bf16_t*)(ws + WS_FTF);
    for (int task = gw; task < NB * 256 * 4; task += nw) {
      const int row = task >> 2, k8 = (task & 3) * 512 + lane * 8;
      const bf16_t* fr = FT + (size_t)row * 4096;
      const bool cosp = k8 < 1024;
      const int f0 = cosp ? k8 : 2048 + (k8 - 1024);
      const int mi = cosp ? 2048 - k8 : 4096 - (k8 - 1024);
      const u32x4 fw = *(const u32x4*)(fr + f0), ml = *(const u32x4*)(fr + mi - 8);
      const float m0v = bflo((unsigned)fr[(mi < 4096) ? mi : 4095]);
      const float f[8] = {bflo(fw.x), bfhi(fw.x), bflo(fw.y), bfhi(fw.y), bflo(fw.z), bfhi(fw.z), bflo(fw.w), bfhi(fw.w)};
      const float mr[8] = {m0v, bfhi(ml.w), bflo(ml.w), bfhi(ml.z), bflo(ml.z), bfhi(ml.y), bflo(ml.y), bfhi(ml.x)};
      float v[8];
#pragma unroll
      for (int e = 0; e < 8; ++e) {
        const int k = k8 + e;
        if (k < 1024) v[e] = f[e] + ((k == 0) ? 0.f : mr[e]);
        else if (k == 1024) v[e] = bflo((unsigned)fr[1024]);
        else v[e] = f[e] - mr[e];
      }
      u32x4 o = {cvtpk(v[0], v[1]), cvtpk(v[2], v[3]), cvtpk(v[4], v[5]), cvtpk(v[6], v[7])};
      *(u32x4*)(FTF + (size_t)row * 2048 + k8) = o;
    }
  }
#pragma unroll 4
  for (int task = gw; task < M / 4; task += nw) {
    const int r = task * 4 + sub; const int b = r / T, t = r % T;
    const unsigned krp = *(const unsigned*)(P + (size_t)r * NIN + O_KR + 2 * u);
    const int posm = (u & 8) ? (t & 63) : (t >> 6); const float sgm = (u & 4) ? 1.f : -1.f;
    const f32x4 csm = *(const f32x4*)(rm + (posm * 8 + 2 * (u & 3)) * 2);
    const f32x4 gq4 = *(const f32x4*)(p->mla_qn + l * 96 + 4 * u), gk4 = *(const f32x4*)(p->mla_kn + l * 96 + 4 * u);
    const f32x2 gq2 = *(const f32x2*)(p->mla_qn + l * 96 + 64 + 2 * u), gk2 = *(const f32x2*)(p->mla_kn + l * 96 + 64 + 2 * u);
#pragma unroll
    for (int hh = 0; hh < 8; ++hh) {
      const bool isq = hh < 4; const int hd = hh & 3;
      f32x4 v; float ra, rb;
      if (isq) {
        v = unpack4(*(const u32x2*)(q1r + (size_t)r * 384 + 96 * hd + 4 * u));
        const unsigned rr = *(const unsigned*)(q1r + (size_t)r * 384 + 96 * hd + 64 + 2 * u); ra = bflo(rr); rb = bfhi(rr);
      } else {
        v = unpack4(*(const u32x2*)(krw + (size_t)r * 256 + 64 * hd + 4 * u));
        ra = bflo(krp); rb = bfhi(krp);
      }
      float ss = red16(v[0] * v[0] + v[1] * v[1] + v[2] * v[2] + v[3] * v[3] + ra * ra + rb * rb);
      const float rs = rsqrtf(ss * (1.f / 96.f) + 1e-6f);
      const f32x4 g = isq ? gq4 : gk4; const f32x2 g2 = isq ? gq2 : gk2;
#pragma unroll
      for (int e = 0; e < 4; ++e) v[e] = v[e] * rs * g[e];
      ra = ra * rs * g2[0]; rb = rb * rs * g2[1];
      if (t < SEQ) rope2(ra, rb, sgm, csm);
      if (isq) {
        const float cq = 1.4426950408889634f / __builtin_sqrtf(96.f);
#pragma unroll
        for (int e = 0; e < 4; ++e) v[e] *= cq;
        ra *= cq; rb *= cq;
      }
      bf16_t* dst = (isq ? QA : KA) + (((size_t)b * 4 + hd) * T + t) * 96;
      *(u32x2*)(dst + 4 * u) = pack4(v);
      *(unsigned*)(dst + 64 + 2 * u) = cvtpk(ra, rb);
    }
  }
}

DI void phase_mix(KP p, int l, char* lds) {
  unsigned char* ws = p->ws; asm volatile("" : "+s"(ws));
  const bf16_t* P = (const bf16_t*)(ws + WS_P);
  bf16_t* Y = (bf16_t*)(ws + WS_R1);
  bf16_t* YD = (bf16_t*)(ws + WS_YD);
  const bf16_t* QA = (const bf16_t*)(ws + WS_QA); const bf16_t* KA = (const bf16_t*)(ws + WS_KA); const bf16_t* VAT = (const bf16_t*)(ws + WS_VAT);
  const bf16_t* QB = (const bf16_t*)(ws + WS_QB); const bf16_t* KB = (const bf16_t*)(ws + WS_KB); const bf16_t* VBT = (const bf16_t*)(ws + WS_VBT);
  const bf16_t* FTF = (const bf16_t*)(ws + WS_FTF); const bf16_t* FTC = (const bf16_t*)(ws + WS_FTC);
  const bf16_t* DL = (const bf16_t*)(ws + WS_DLAT); const bf16_t* DC = (const bf16_t*)(ws + WS_DCTX);
  const bf16_t* vnT = (const bf16_t*)(ws + WS_VNT);
  const bf16_t* wsb = (const bf16_t*)(ws + WS_WS) + (size_t)l * 4 * 128 * 128;
  const bool upd = (l == 0);
  const float sbA = ((const float*)(ws + WS_SBND))[l * 2], sbB = ((const float*)(ws + WS_SBND))[l * 2 + 1];
  const int xcd = blockIdx.x & 7, lb = 2 * (blockIdx.x >> 3) + __builtin_amdgcn_readfirstlane(otid() >> 8), nlb = 2 * (gridDim.x >> 3);
  const int nDL = 64, nA = 0, nB = 0, nDC = upd ? 8 : 0, nAc = 0, nBc = 0, nCM = 72, nFN = upd ? 72 : 64;
  const int e0 = nDL, e1 = e0 + nA, e2 = e1 + nB, e3 = e2 + nDC, e4 = e3 + nAc, e5 = e4 + nBc, e6 = e5 + nCM, e7 = e6 + nFN;
  unsigned* cnt = (unsigned*)(ws + WS_CNT) + l * 288;
  const bf16_t* wf = (const bf16_t*)(ws + WS_WF) + (size_t)l * 256 * 256;
  {
    const int lbw = blockIdx.x >> 3, nlbw = gridDim.x >> 3;
    const int nW = upd ? 144 : 128;
    for (int it = lbw; it < nW; it += nlbw) {
      const bool isA = (it < 64) || (it >= 128 && it < 136);
      int b, hd, q0, k0, nk;
      if (it < 128) { const int i2 = it & 63; b = 2 * xcd + (i2 >> 5); hd = (i2 >> 3) & 3; q0 = (i2 & 7) * 256; k0 = 0; nk = T; }
      else { const int i2 = (it - 128) & 7; b = 2 * xcd + (i2 >> 2); hd = i2 & 3; q0 = SEQ; k0 = SEQ; nk = CL; }
      const size_t r0 = (size_t)b * T + q0; const size_t bh = (size_t)b * 4 + hd, bk = (size_t)b * 2 + (hd >> 1);
      if (isA) {
        if (sbA <= 30.f) attn_item8<96, true>(QA + (bh * T + q0) * 96, KA + (bh * T + k0) * 96, VAT + bh * 64 * T + k0, nk, lds, P + r0 * NIN + O_GA + 64 * hd, Y + r0 * 1024 + 64 * hd, sbA);
        else attn_item8<96, false>(QA + (bh * T + q0) * 96, KA + (bh * T + k0) * 96, VAT + bh * 64 * T + k0, nk, lds, P + r0 * NIN + O_GA + 64 * hd, Y + r0 * 1024 + 64 * hd, 0.f);
      } else {
        if (sbB <= 30.f) attn_item8<64, true>(QB + (bh * T + q0) * 64, KB + (bk * T + k0) * 64, VBT + bk * 64 * T + k0, nk, lds, P + r0 * NIN + O_GB + 64 * hd, Y + r0 * 1024 + 256 + 64 * hd, sbB);
        else attn_item8<64, false>(QB + (bh * T + q0) * 64, KB + (bk * T + k0) * 64, VBT + bk * 64 * T + k0, nk, lds, P + r0 * NIN + O_GB + 64 * hd, Y + r0 * 1024 + 256 + 64 * hd, 0.f);
      }
    }
    __syncthreads();
  }
  const int tid0 = otid() & 255;
  for (int it = lb; it < e7; it += nlb) {
    if (it >= e6) {
      const int i2 = it - e6; const int mpb = upd ? 18 : 16; const int mloc = i2 >> 1, nt = i2 & 1;
      const int mt = (2 * xcd + mloc / mpb) * 18 + (mloc % mpb);
      if (tid0 == 0) {
        unsigned sp = 0;
        while (__hip_atomic_load(&cnt[mt], __ATOMIC_RELAXED, __HIP_MEMORY_SCOPE_AGENT) < 2u) { __builtin_amdgcn_s_sleep(2); if (++sp > (1u << 24)) break; }
        __builtin_amdgcn_fence(__ATOMIC_ACQUIRE, "agent");
        asm volatile("s_waitcnt vmcnt(0)" ::: "memory");
      }
      __syncthreads();
      const int m0 = mt * 128, n0 = nt * 128;
      gemm_tile(YD + (size_t)m0 * 256, 256, wf + (size_t)n0 * 256, 256, 256, lds, [&](int m, int n, f32x4 v) {
        const size_t r = (size_t)m0 + m;
        f32x4 gd = unpack4(*(const u32x2*)(P + r * NIN + O_GD + n0 + n));
        f32x4 o = {v[0] * silu(gd[0]), v[1] * silu(gd[1]), v[2] * silu(gd[2]), v[3] * silu(gd[3])};
        *(u32x2*)(Y + r * 1024 + 768 + n0 + n) = pack4(o); });
      continue;
    }
    if (it < e0 || (it >= e2 && it < e3)) {
      const bool isl = it < e0; const int i2 = isl ? it : it - e2;
      int b, mt, nt, K; const bf16_t* Ap; const bf16_t* Bp; float sc; size_t rbase;
      if (isl) { b = 2 * xcd + (i2 >> 5); mt = (i2 >> 1) & 15; nt = i2 & 1; K = 2048; Ap = DL + (size_t)mt * 128 * 2048; Bp = FTF + ((size_t)b * 256 + nt * 128) * 2048; sc = 0.00276213586f; rbase = (size_t)b * T + mt * 128; }
      else { b = 2 * xcd + (i2 >> 2); mt = (i2 >> 1) & 1; nt = i2 & 1; K = 512; Ap = DC + (size_t)mt * 128 * 512; Bp = FTC + ((size_t)b * 256 + nt * 128) * 512; sc = 0.0078125f; rbase = (size_t)b * T + SEQ + mt * 128; }
      bf16_t* yo = YD + rbase * 256 + nt * 128;
      gemm_tile(Ap, K, Bp, K, K, lds, [&](int m, int n, f32x4 v) {
        f32x4 o = {v[0] * sc, v[1] * sc, v[2] * sc, v[3] * sc};
        *(u32x2*)(yo + (size_t)m * 256 + n) = pack4(o); });
      asm volatile("s_waitcnt vmcnt(0)" ::: "memory");
      __syncthreads();
      if (tid0 == 0) {
        __builtin_amdgcn_fence(__ATOMIC_RELEASE, "agent");
        asm volatile("s_waitcnt vmcnt(0)" ::: "memory");
        __hip_atomic_fetch_add(&cnt[b * 18 + (isl ? mt : 16 + mt)], 1u, __ATOMIC_RELAXED, __HIP_MEMORY_SCOPE_AGENT);
      }
    } else {
      const int i2 = it - e5; const int bl = i2 / 36, rem = i2 % 36; const int cpl = rem >> 2, g = rem & 3;
      const int ch = (2 * xcd + bl) * 18 + 2 * cpl;
      if (!upd && cpl >= 8) continue;
      const float* bs = p->cm_b_s + ((size_t)l * 4 + g) * 128;
      const bf16_t* Pr = P + (size_t)ch * 128 * NIN + 64 * g; bf16_t* Yr = Y + (size_t)ch * 128 * 1024 + 512 + 64 * g;
      gemm_tile(wsb + (size_t)g * 128 * 128, 128, vnT + ((size_t)ch * 256 + 64 * g) * 128, 128, 128, lds, [&](int m, int n, f32x4 v) {
        const int c2 = n >> 6, nn = n & 63;
        const size_t rr = (size_t)c2 * 128 + m;
        const float bias = bs[m];
        f32x4 uu = unpack4(*(const u32x2*)(Pr + rr * NIN + O_U + nn)), gc = unpack4(*(const u32x2*)(Pr + rr * NIN + O_GC + nn));
        f32x4 o;
#pragma unroll
        for (int e = 0; e < 4; ++e) o[e] = uu[e] * (v[e] + bias) * silu(gc[e]);
        *(u32x2*)(Yr + rr * 1024 + nn) = pack4(o);
      }, (size_t)192 * 128);
    }
  }
}

DI void phase_outproj(KP p, int l, char* lds) {
  unsigned char* ws = p->ws; asm volatile("" : "+s"(ws));
  const bf16_t* Y = (const bf16_t*)(ws + WS_R1);
  const bf16_t* wo = (const bf16_t*)(ws + WS_WOUT) + (size_t)l * 1024 * 1024;
  const float* mod = (const float*)(ws + WS_MOD) + (size_t)l * 17 * 3072;
  const float* xl = (l == 0) ? p->x : p->out;
  float* ctx1 = (float*)(ws + WS_CTX1);
  const int xcd = blockIdx.x & 7, lb = blockIdx.x >> 3, nlb = gridDim.x >> 3, hb = __builtin_amdgcn_readfirstlane(otid() >> 8);
  const int nsm = (l == 0) ? 16 : 0;
  for (int j = lb; j < 64; j += nlb) {
    {
      const int mi = j >> 2, nt = j & 3;
      const int bb = 2 * xcd + (mi >> 3), tt = mi & 7;
      const int m0 = (bb * 9 + tt) * 256, n0 = nt * 256;
      const float* src = xl + ((size_t)bb * SEQ + tt * 256) * 1024;
      float* dst = p->out + ((size_t)bb * SEQ + tt * 256) * 1024;
      const float* gt = mod + (size_t)bb * 3072 + 2048;
      gemm256(Y + (size_t)m0 * 1024, 1024, wo + (size_t)n0 * 1024, 1024, 1024, lds, [&](int m, int n, f32x4 v) {
        const size_t o = (size_t)m * 1024 + n0 + n;
        f32x4 xv = __builtin_nontemporal_load((const f32x4*)(src + o)), g = *(const f32x4*)(gt + n0 + n);
        f32x4 r = {xv[0] + g[0] * v[0], xv[1] + g[1] * v[1], xv[2] + g[2] * v[2], xv[3] + g[3] * v[3]};
        __builtin_nontemporal_store(r, (f32x4*)(dst + o)); });
    }
  }
  for (int j = lb; j < nsm; j += nlb) {
    {
      const int item = 2 * j + hb; const int bb = 2 * xcd + (item >> 4), m128 = (item >> 3) & 1, nt = item & 7;
      const int m0 = (bb * 18 + 16 + m128) * 128, n0 = nt * 128;
      const float* src = p->ctx + ((size_t)bb * CL + m128 * 128) * 1024;
      float* dst = ctx1 + ((size_t)bb * CL + m128 * 128) * 1024;
      const float* gt = mod + (size_t)16 * 3072 + 2048;
      gemm_tile(Y + (size_t)m0 * 1024, 1024, wo + (size_t)n0 * 1024, 1024, 1024, lds, [&](int m, int n, f32x4 v) {
        const size_t o = (size_t)m * 1024 + n0 + n;
        f32x4 xv = *(const f32x4*)(src + o), g = *(const f32x4*)(gt + n0 + n);
        f32x4 r = {xv[0] + g[0] * v[0], xv[1] + g[1] * v[1], xv[2] + g[2] * v[2], xv[3] + g[3] * v[3]};
        *(f32x4*)(dst + o) = r; });
    }
  }
}

__global__ void __launch_bounds__(NTHR, 2) fwd_megakernel(Params p_byval) {
  KP p = (KP)__builtin_amdgcn_kernarg_segment_ptr();
  extern __shared__ __attribute__((aligned(16))) char lds[];
  cg::grid_group grid = cg::this_grid();
  uint4* xbw = (uint4*)(lds + LDS_MAIN);
  if (threadIdx.x == 0) *xbw = make_uint4(0u, 0u, 0u, 0u);
  __syncthreads();
  XcdBarrier xb = xcd_barrier_post((unsigned*)(p->ws + WS_BAR), (volatile LAS unsigned*)xbw);
  if (p->ph_hi < p->ph_lo) grid.sync();
  (void)p_byval;
  for (int ph = p->ph_lo; ph < p->ph_hi; ++ph) {
    asm volatile("" : "+s"(p));
    if (ph == 0) phase0(p, lds);
    else {
      const int l = (ph - 1) / 7, s = (ph - 1) % 7;
      switch (s) {
        case 0: phase_norm(p, l); break;
        case 1: phase_inproj(p, l, lds); break;
        case 2: phase_feat_a(p, l, lds); break;
        case 3: phase_feat_b(p, l, lds); break;
        case 4: phase_feat_c(p, l); break;
        case 5: phase_mix(p, l, lds); break;
        default: phase_outproj(p, l, lds); break;
      }
    }
    if (ph + 1 < p->ph_hi) xcd_barrier(xb);
  }
}

extern "C" void kernel_launch(void* const* d_in, const int* in_sizes, int n_in, void* d_out, int out_size, void* d_ws, size_t ws_size, hipStream_t stream) {
  static int grid_blocks = 0;
  if (!grid_blocks) {
    int dev = 0, cus = 0, per_cu = 0;
    hipGetDevice(&dev);
    hipDeviceGetAttribute(&cus, hipDeviceAttributeMultiprocessorCount, dev);
    hipFuncSetAttribute((const void*)fwd_megakernel, hipFuncAttributeMaxDynamicSharedMemorySize, LDS_BYTES);
    hipOccupancyMaxActiveBlocksPerMultiprocessor(&per_cu, fwd_megakernel, NTHR, LDS_BYTES);
    if (per_cu > 1) per_cu = 1;
    if (per_cu < 1) per_cu = 1;
    grid_blocks = cus * per_cu;
    if (ws_size < WS_END) fprintf(stderr, "kernel_launch: workspace too small: %zu < %zu\n", ws_size, (size_t)WS_END);
  }
  hipMemsetAsync((unsigned char*)d_ws + WS_BAR, 0, WS_ZERO_BYTES, stream);
  Params p{};
  const float** pp = (const float**)&p;
  for (int i = 0; i < 22; ++i) pp[i] = (const float*)d_in[i];
  p.out = (float*)d_out; p.ws = (unsigned char*)d_ws;
  constexpr int NPH = 15;
#if PER_PHASE_LAUNCH
  for (int ph = 0; ph < NPH; ++ph) {
    p.ph_lo = ph; p.ph_hi = ph + 1;
    hipLaunchKernelGGL(fwd_megakernel, dim3(grid_blocks), dim3(NTHR), LDS_BYTES, stream, p);
  }
#else
  p.ph_lo = 0; p.ph_hi = NPH;
  void* args[] = {&p};
  hipError_t e = hipLaunchCooperativeKernel((void*)fwd_megakernel, dim3(grid_blocks), dim3(NTHR), args, LDS_BYTES, stream);
  if (e != hipSuccess) fprintf(stderr, "cooperative launch failed: %s (grid %d)\n", hipGetErrorString(e), grid_blocks);
#endif
}
```

```cpp
#include <hip/hip_runtime.h>
#include <hip/hip_cooperative_groups.h>
#include <stdint.h>
#include <stdio.h>
namespace cg = cooperative_groups;

#ifndef PER_PHASE_LAUNCH
#define PER_PHASE_LAUNCH 0
#endif

#define DI __device__ __forceinline__
DI int otid() { int t = threadIdx.x; asm volatile("" : "+v"(t)); return t; }
typedef unsigned short bf16_t;
using bf16x8 = __attribute__((ext_vector_type(8))) short;
using f32x16 = __attribute__((ext_vector_type(16))) float;
using f32x4  = __attribute__((ext_vector_type(4))) float;
using f32x2  = __attribute__((ext_vector_type(2))) float;
using u32x4  = __attribute__((ext_vector_type(4))) unsigned;
using u32x2  = __attribute__((ext_vector_type(2))) unsigned;
typedef __bf16 bf16x2_t __attribute__((ext_vector_type(2)));

constexpr int NB = 16, SEQ = 2048, CL = 256, T = 2304, D = 1024, M = NB * T, NIN = 2656, NINP = 2816;
constexpr int O_CQ = 0, O_CKV = 192, O_KR = 320, O_GA = 352, O_Q2 = 608, O_K2 = 864, O_V2 = 992, O_GB = 1120,
              O_U = 1376, O_V = 1632, O_GC = 1888, O_F = 2144, O_GD = 2400;
constexpr int NTHR = 512;
constexpr int HALF_LDS = 69632, LDS_MAIN = 2 * HALF_LDS, LDS_BYTES = LDS_MAIN + 256;

constexpr size_t al256(size_t x) { return (x + 255) & ~(size_t)255; }
constexpr size_t WS_MOD  = 0;
constexpr size_t WS_ROPG = al256(WS_MOD + 2 * 17 * 3072 * 4);
constexpr size_t WS_ROPM = al256(WS_ROPG + 64 * 16 * 2 * 4);
constexpr size_t WS_SBND = al256(WS_ROPM + 64 * 8 * 2 * 4);
constexpr size_t WS_WIN  = al256(WS_SBND + 256);
constexpr size_t WS_WUQ  = al256(WS_WIN + (size_t)2 * NINP * 1024 * 2);
constexpr size_t WS_WUKV = al256(WS_WUQ + 2 * 384 * 192 * 2);
constexpr size_t WS_WF   = al256(WS_WUKV + 2 * 512 * 128 * 2);
constexpr size_t WS_WOUT = al256(WS_WF + 2 * 256 * 256 * 2);
constexpr size_t WS_WS   = al256(WS_WOUT + (size_t)2 * 1024 * 1024 * 2);
constexpr size_t WS_CM   = al256(WS_WS + 2 * 4 * 128 * 128 * 2);
constexpr size_t WS_DLAT = al256(WS_CM + 128 * 64 * 2);
constexpr size_t WS_DCTX = al256(WS_DLAT + (size_t)2048 * 2048 * 2);
constexpr size_t WS_R1   = al256(WS_DCTX + 256 * 512 * 2);
constexpr size_t R1_CQN = 0, R1_CKVN = (size_t)M * 192 * 2, R1_Q1R = R1_CKVN + (size_t)M * 128 * 2, R1_KR = R1_Q1R + (size_t)M * 384 * 2;
constexpr size_t WS_P    = al256(WS_R1 + (size_t)M * 1024 * 2);
constexpr size_t WS_FT   = al256(WS_P + (size_t)M * NIN * 2);
constexpr size_t WS_FTF  = al256(WS_FT + (size_t)NB * 256 * 4096 * 2);
constexpr size_t WS_FTC  = al256(WS_FTF + (size_t)NB * 256 * 2048 * 2);
constexpr size_t WS_YD   = al256(WS_FTC + (size_t)NB * 256 * 512 * 2);
constexpr size_t WS_QA   = al256(WS_YD + (size_t)M * 256 * 2);
constexpr size_t WS_KA   = al256(WS_QA + (size_t)M * 384 * 2);
constexpr size_t WS_VAT  = al256(WS_KA + (size_t)M * 384 * 2);
constexpr size_t WS_QB   = al256(WS_VAT + (size_t)M * 256 * 2);
constexpr size_t WS_KB   = al256(WS_QB + (size_t)M * 256 * 2);
constexpr size_t WS_VBT  = al256(WS_KB + (size_t)M * 128 * 2);
constexpr size_t WS_VNT  = al256(WS_VBT + (size_t)M * 128 * 2);
constexpr size_t WS_CTX1 = al256(WS_VNT + (size_t)M * 256 * 2 + 65536);
constexpr size_t WS_BAR  = al256(WS_CTX1 + (size_t)NB * CL * 1024 * 4);
constexpr size_t WS_CNT  = al256(WS_BAR + 3456 * 4);
constexpr size_t WS_END  = al256(WS_CNT + 2 * 288 * 4);
constexpr size_t WS_ZERO_BYTES = WS_END - WS_BAR;
static_assert(R1_KR + (size_t)M * 256 * 2 <= (size_t)M * 1024 * 2, "temp region");
static_assert(WS_END <= (size_t)512 * 1024 * 1024, "workspace");

struct Params {
  const float *x, *c, *ctx, *c_ctx, *norm_g, *w_mod, *b_mod, *w_in, *mla_q_norm, *mla_w_uq, *mla_kv_norm, *mla_w_ukv,
              *mla_qn, *mla_kn, *gqa_qn, *gqa_kn, *cm_ln_g, *cm_ln_b, *cm_w_s, *cm_b_s, *fnet_w, *w_out;
  float* out; unsigned char* ws; int ph_lo, ph_hi;
};
typedef const __attribute__((address_space(4))) Params* KP;

DI unsigned cvtpk(float lo, float hi) { f32x2 v = {lo, hi}; bf16x2_t b = __builtin_convertvector(v, bf16x2_t); return __builtin_bit_cast(unsigned, b); }
DI float bflo(unsigned u) { return __uint_as_float(u << 16); }
DI float bfhi(unsigned u) { return __uint_as_float(u & 0xffff0000u); }
DI bf16_t f2bf(float f) { return (bf16_t)(cvtpk(f, 0.f) & 0xffffu); }
DI float silu(float x) { return x / (1.f + __expf(-x)); }
DI f32x4 unpack4(u32x2 v) { f32x4 r = {bflo(v.x), bfhi(v.x), bflo(v.y), bfhi(v.y)}; return r; }
DI u32x2 pack4(f32x4 v) { u32x2 r = {cvtpk(v[0], v[1]), cvtpk(v[2], v[3])}; return r; }
DI float dpp_f(float v, const int ctrl_sel) {
  const int i = __float_as_int(v); int r;
  if (ctrl_sel == 0) r = __builtin_amdgcn_update_dpp(0, i, 0xB1, 0xF, 0xF, true);
  else if (ctrl_sel == 1) r = __builtin_amdgcn_update_dpp(0, i, 0x4E, 0xF, 0xF, true);
  else if (ctrl_sel == 2) r = __builtin_amdgcn_update_dpp(0, i, 0x124, 0xF, 0xF, true);
  else r = __builtin_amdgcn_update_dpp(0, i, 0x128, 0xF, 0xF, true);
  return __int_as_float(r);
}
DI float red16(float v) { v += dpp_f(v, 0); v += dpp_f(v, 1); v += dpp_f(v, 2); v += dpp_f(v, 3); return v; }
DI float red64(float v) { v = red16(v); v += __shfl_xor(v, 16); v += __shfl_xor(v, 32); return v; }
#define MFMA32(a, b, c) __builtin_amdgcn_mfma_f32_32x32x16_bf16((a), (b), (c), 0, 0, 0)


#define XB_TMO      128
#define XB_XCNT(j)  (256  + 64 * (j))
#define XB_XSUB(j)  (1280 + 64 * (j))
#define XB_XGEN(j)  (2304 + 64 * (j))
#define XB_TOP      3328
#define XB_TOPGEN   3392
#define XCD_BAR_WORDS 3456
#define XB_SPIN_CAP (1u << 22)
#define LAS __attribute__((address_space(3)))
DI unsigned xb_ld(unsigned* p)              { return __hip_atomic_load(p, __ATOMIC_RELAXED, __HIP_MEMORY_SCOPE_AGENT); }
DI unsigned xb_add(unsigned* p, unsigned v) { return __hip_atomic_fetch_add(p, v, __ATOMIC_RELAXED, __HIP_MEMORY_SCOPE_AGENT); }
DI unsigned xb_xcc_id() { return (unsigned)__builtin_amdgcn_s_getreg((3 << 11) | 20) & 0xFu; }
#define XB_SPIN(cond, bar) do { unsigned _sp = 0; while (cond) { __builtin_amdgcn_s_sleep(1); \
    if ((++_sp & 255u) == 0u) { if (xb_ld(&(bar)[XB_TMO])) break; if (_sp > XB_SPIN_CAP) { atomicAdd(&(bar)[XB_TMO], 1u); break; } } } } while (0)
struct XcdBarrier { unsigned* bar; unsigned x; volatile LAS unsigned* st; };
DI XcdBarrier xcd_barrier_post(unsigned* bar, volatile LAS unsigned* st) {
  XcdBarrier b; b.bar = bar; b.x = xb_xcc_id(); b.st = st;
  if (threadIdx.x == 0) (void)xb_add(&bar[XB_XCNT(b.x)], 1u);
  return b;
}
DI void xcd_barrier_complete(unsigned* bar, unsigned x, unsigned& nloc, unsigned& nx) {
  const unsigned G = gridDim.x * gridDim.y * gridDim.z;
  unsigned sum, cnt, mine, sp = 0u;
  for (;;) {
    sum = 0u; cnt = 0u; mine = 0u;
#pragma unroll
    for (unsigned j = 0; j < 16; ++j) { const unsigned c = xb_ld(&bar[XB_XCNT(j)]); sum += c; cnt += (c > 0u) ? 1u : 0u; mine = (j == x) ? c : mine; }
    if (sum == G) break;
    __builtin_amdgcn_s_sleep(1);
    if ((++sp & 255u) == 0u) { if (xb_ld(&bar[XB_TMO])) break; if (sp > XB_SPIN_CAP) { atomicAdd(&bar[XB_TMO], 1u); break; } }
  }
  nloc = mine > 0u ? mine : 1u; nx = cnt > 0u ? cnt : 1u;
}
DI void xcd_barrier(const XcdBarrier& b) {
  asm volatile("s_waitcnt vmcnt(0)" ::: "memory");
  __syncthreads();
  if (threadIdx.x == 0) {
    unsigned* bar = b.bar;
    __builtin_amdgcn_s_waitcnt(0);
    unsigned nloc = b.st[0], nx = b.st[1];
    if (nloc == 0u) { xcd_barrier_complete(bar, b.x, nloc, nx); b.st[0] = nloc; b.st[1] = nx; }
    const unsigned old = xb_add(&bar[XB_XSUB(b.x)], 1u);
    const unsigned gen = old / nloc;
    if (old + 1u == (gen + 1u) * nloc) {
      __builtin_amdgcn_fence(__ATOMIC_RELEASE, "agent");
      asm volatile("s_waitcnt vmcnt(0)" ::: "memory");
      const unsigned og = xb_add(&bar[XB_TOP], 1u);
      const unsigned tg = og / nx;
      if (og + 1u == (tg + 1u) * nx) xb_add(&bar[XB_TOPGEN], 1u);
      else XB_SPIN(xb_ld(&bar[XB_TOPGEN]) == tg, bar);
      __builtin_amdgcn_fence(__ATOMIC_ACQUIRE, "agent");
      xb_add(&bar[XB_XGEN(b.x)], 1u);
      asm volatile("s_waitcnt vmcnt(0)" ::: "memory");
    } else {
      XB_SPIN(xb_ld(&bar[XB_XGEN(b.x)]) == gen, bar);
      __builtin_amdgcn_fence(__ATOMIC_ACQUIRE, "agent");
      asm volatile("s_waitcnt vmcnt(0)" ::: "memory");
    }
  }
  __syncthreads();
}

template <class Epi>
DI void gemm_tile(const bf16_t* __restrict__ A, int lda, const bf16_t* __restrict__ Bt, int ldb, int K, char* lds, Epi epi, const size_t bjump = 0) {
  const int tid_full = otid(); const int tid = tid_full & 255; lds += (tid_full >> 8) * HALF_LDS;
  const int lane = tid & 63, w = tid >> 6, l31 = lane & 31, h = lane >> 5;
  const int wr = w >> 1, wc = w & 1;
  const int lrow = tid >> 3, lch = (tid & 7) ^ ((tid >> 4) & 7);
  const bf16_t* ag = A + (size_t)lrow * lda + lch * 8;
  const bf16_t* bg = Bt + (size_t)lrow * ldb + lch * 8;
  const size_t a32 = (size_t)32 * lda, b32 = (size_t)32 * ldb;
  f32x16 acc[2][2];
#pragma unroll
  for (int i = 0; i < 2; ++i)
#pragma unroll
    for (int j = 0; j < 2; ++j)
#pragma unroll
      for (int e = 0; e < 16; ++e) acc[i][j][e] = 0.f;
  const int nk = K >> 6;
  const int rsw = (l31 >> 1) & 7;
  const int aoff = (wr * 64 + l31) * 128, boff = 16384 + (wc * 64 + l31) * 128;
  char* ldst = lds + tid * 16;
#define G_DMA(BUF, KT) { const int ko_ = (KT) * 64; char* nb_ = ldst + (BUF) * 32768; _Pragma("unroll") for (int i = 0; i < 4; ++i) { \
    __builtin_amdgcn_global_load_lds((const unsigned*)(ag + i * a32 + ko_), (__attribute__((address_space(3))) unsigned*)(nb_ + i * 4096), 16, 0, 0); \
    __builtin_amdgcn_global_load_lds((const unsigned*)(bg + i * b32 + (i >= 2 ? bjump : (size_t)0) + ko_), (__attribute__((address_space(3))) unsigned*)(nb_ + 16384 + i * 4096), 16, 0, 0); } }
#define G_COMPUTE(BUF) { const char* cur = lds + (BUF) * 32768; bf16x8 af[2][2], bf[2][2]; \
    { const int off = ((0 + h) ^ rsw) << 4; _Pragma("unroll") for (int i = 0; i < 2; ++i) { af[0][i] = *(const bf16x8*)(cur + aoff + i * 4096 + off); bf[0][i] = *(const bf16x8*)(cur + boff + i * 4096 + off); } } \
    _Pragma("unroll") for (int ks = 0; ks < 4; ++ks) { \
      if (ks < 3) { const int off = ((2 * (ks + 1) + h) ^ rsw) << 4; _Pragma("unroll") for (int i = 0; i < 2; ++i) { af[(ks + 1) & 1][i] = *(const bf16x8*)(cur + aoff + i * 4096 + off); bf[(ks + 1) & 1][i] = *(const bf16x8*)(cur + boff + i * 4096 + off); } } \
      _Pragma("unroll") for (int i = 0; i < 2; ++i) _Pragma("unroll") for (int j = 0; j < 2; ++j) acc[i][j] = MFMA32(bf[ks & 1][j], af[ks & 1][i], acc[i][j]); } }
#define G_WAIT() { asm volatile("s_waitcnt vmcnt(0)" ::: "memory"); __syncthreads(); }
  G_DMA(0, 0);
  G_WAIT();
  for (int kt = 0; kt < nk; kt += 2) {
    if (kt + 1 < nk) G_DMA(1, kt + 1);
    G_COMPUTE(0);
    G_WAIT();
    if (kt + 1 < nk) {
      if (kt + 2 < nk) G_DMA(0, kt + 2);
      G_COMPUTE(1);
      G_WAIT();
    }
  }
#undef G_DMA
#undef G_COMPUTE
#undef G_WAIT
  float* ct = (float*)lds;
#pragma unroll
  for (int i = 0; i < 2; ++i)
#pragma unroll
    for (int j = 0; j < 2; ++j)
#pragma unroll
      for (int q = 0; q < 4; ++q) {
        f32x4 v = {acc[i][j][4 * q], acc[i][j][4 * q + 1], acc[i][j][4 * q + 2], acc[i][j][4 * q + 3]};
        *(f32x4*)(ct + (wr * 64 + i * 32 + l31) * 132 + wc * 64 + j * 32 + 8 * q + 4 * h) = v;
      }
  __syncthreads();
#pragma unroll 4
  for (int it = 0; it < 16; ++it) {
    const int idx = it * 256 + tid; const int row = idx >> 5, c4 = (idx & 31) * 4;
    f32x4 v = *(const f32x4*)(ct + row * 132 + c4);
    epi(row, c4, v);
  }
  __syncthreads();
}


DI int g8_lds_byte(int r, int c) { int st = (r >> 4) * 2 + (c >> 5), rr = r & 15, cc = c & 31, ob = rr * 64 + cc * 2; return st * 1024 + (ob ^ (((ob >> 9) & 1) << 5)); }
DI void g8_stage_rc(int b, int& R, int& C) { int st = b / 1024, sb = b % 1024, swz = sb ^ (((sb >> 9) & 1) << 5); R = (st >> 1) * 16 + swz / 64; C = (st & 1) * 32 + (swz % 64) / 2; }
template <class Epi>
DI void gemm256(const bf16_t* __restrict__ A, int lda, const bf16_t* __restrict__ Bt, int ldb, int K, char* lds, Epi epi) {
  constexpr int BK = 64, HALFR = 128, HTB = HALFR * BK * 2;
  const int tid = otid();
  const int wid = tid >> 6, lane = tid & 63, wr = wid >> 2, wc = wid & 3, fr = lane & 15, fq = lane >> 4;
  const int obs = (fr * 64 + fq * 16) ^ ((((fr * 64 + fq * 16) >> 9) & 1) << 5);
  const char* lrda = lds + wr * 8192 + obs; const char* lrdb = lds + 4 * HTB + wc * 4096 + obs;
  int sr0, sc0, sr1, sc1; g8_stage_rc(tid * 16, sr0, sc0); g8_stage_rc(tid * 16 + 8192, sr1, sc1);
  const unsigned oa0 = (unsigned)(sr0 * lda + sc0) * 2u, oa1 = (unsigned)(sr1 * lda + sc1) * 2u;
#define ob0 oa0
#define ob1 oa1
#define SA8(b, h) (lds + ((b) * 2 + (h)) * HTB)
#define SB8(b, h) (lds + (4 + (b) * 2 + (h)) * HTB)
#define STAGE_A(Pp, br, kt) { const char* g_ = (const char*)(A + (size_t)(br) * lda + (size_t)(kt) * BK); \
    __builtin_amdgcn_global_load_lds((const unsigned*)(g_ + oa0), (LAS unsigned*)((Pp) + tid * 16), 16, 0, 0); \
    __builtin_amdgcn_global_load_lds((const unsigned*)(g_ + oa1), (LAS unsigned*)((Pp) + tid * 16 + 8192), 16, 0, 0); }
#define STAGE_B(Pp, br, kt) { const char* g_ = (const char*)(Bt + (size_t)(br) * ldb + (size_t)(kt) * BK); \
    __builtin_amdgcn_global_load_lds((const unsigned*)(g_ + ob0), (LAS unsigned*)((Pp) + tid * 16), 16, 0, 0); \
    __builtin_amdgcn_global_load_lds((const unsigned*)(g_ + ob1), (LAS unsigned*)((Pp) + tid * 16 + 8192), 16, 0, 0); }
#define LDA8(dst, b, h) _Pragma("unroll") for (int m = 0; m < 4; ++m) _Pragma("unroll") for (int k = 0; k < 2; ++k) \
    dst[m][k] = *(const bf16x8*)(lrda + ((b) * 2 + (h)) * HTB + (2 * m + k) * 1024)
#define LDB8(dst, b, h) _Pragma("unroll") for (int n = 0; n < 2; ++n) _Pragma("unroll") for (int k = 0; k < 2; ++k) \
    dst[n][k] = *(const bf16x8*)(lrdb + ((b) * 2 + (h)) * HTB + (2 * n + k) * 1024)
#define MMA8(ai, bj, AT, BT) { __builtin_amdgcn_s_setprio(1); \
    _Pragma("unroll") for (int m = 0; m < 4; ++m) _Pragma("unroll") for (int n = 0; n < 2; ++n) _Pragma("unroll") for (int k = 0; k < 2; ++k) \
      acc[ai][bj][m][n] = __builtin_amdgcn_mfma_f32_16x16x32_bf16(AT[m][k], BT[n][k], acc[ai][bj][m][n], 0, 0, 0); \
    __builtin_amdgcn_s_setprio(0); }
#define WAIT_V(n) asm volatile("s_waitcnt vmcnt(" #n ")" ::: "memory")
#define WAIT_L(n) asm volatile("s_waitcnt lgkmcnt(" #n ")" ::: "memory")
#define BAR8 __builtin_amdgcn_s_barrier()
#define SCHED8 __builtin_amdgcn_sched_barrier(0)
  f32x4 acc[2][2][4][2];
#pragma unroll
  for (int a = 0; a < 2; ++a)
#pragma unroll
    for (int b = 0; b < 2; ++b)
#pragma unroll
      for (int m = 0; m < 4; ++m)
#pragma unroll
        for (int n = 0; n < 2; ++n) { f32x4 z = {0.f, 0.f, 0.f, 0.f}; acc[a][b][m][n] = z; }
  bf16x8 At[4][2], B0[2][2], B1[2][2];
  const int nt = K / BK;
  WAIT_V(0);
  __syncthreads();
  STAGE_B(SB8(0, 0), 0, 0); STAGE_A(SA8(0, 0), 0, 0);
  STAGE_B(SB8(0, 1), HALFR, 0); STAGE_A(SA8(0, 1), HALFR, 0);
  if (wr == 1) BAR8;
  WAIT_V(4); BAR8;
  STAGE_B(SB8(1, 0), 0, 1); STAGE_A(SA8(1, 0), 0, 1); STAGE_B(SB8(1, 1), HALFR, 1);
  WAIT_V(6); BAR8;
  for (int t = 0; t < nt - 2; t += 2) {
    LDB8(B0, 0, 0); SCHED8; LDA8(At, 0, 0); STAGE_A(SA8(1, 1), HALFR, t + 1);
    WAIT_L(8); BAR8; WAIT_L(0); MMA8(0, 0, At, B0); BAR8; SCHED8;
    LDB8(B1, 0, 1); STAGE_B(SB8(0, 0), 0, t + 2);
    BAR8; WAIT_L(0); MMA8(0, 1, At, B1); BAR8;
    LDA8(At, 0, 1); STAGE_A(SA8(0, 0), 0, t + 2);
    BAR8; WAIT_L(0); MMA8(1, 0, At, B0); BAR8; SCHED8;
    STAGE_B(SB8(0, 1), HALFR, t + 2);
    WAIT_V(6); BAR8; MMA8(1, 1, At, B1); BAR8;
    LDB8(B0, 1, 0); SCHED8; LDA8(At, 1, 0); STAGE_A(SA8(0, 1), HALFR, t + 2);
    WAIT_L(8); BAR8; WAIT_L(0); MMA8(0, 0, At, B0); BAR8; SCHED8;
    LDB8(B1, 1, 1); STAGE_B(SB8(1, 0), 0, t + 3);
    BAR8; WAIT_L(0); MMA8(0, 1, At, B1); BAR8;
    LDA8(At, 1, 1); STAGE_A(SA8(1, 0), 0, t + 3);
    BAR8; WAIT_L(0); MMA8(1, 0, At, B0); BAR8; SCHED8;
    STAGE_B(SB8(1, 1), HALFR, t + 3);
    WAIT_V(6); BAR8; MMA8(1, 1, At, B1); BAR8;
  }
  { LDB8(B0, 0, 0); LDA8(At, 0, 0); STAGE_A(SA8(1, 1), HALFR, nt - 1);
    BAR8; WAIT_L(0); MMA8(0, 0, At, B0); BAR8;
    LDB8(B1, 0, 1); BAR8; WAIT_L(0); MMA8(0, 1, At, B1); BAR8;
    LDA8(At, 0, 1); WAIT_V(4); BAR8; WAIT_L(0); MMA8(1, 0, At, B0); MMA8(1, 1, At, B1); BAR8; }
  { LDB8(B0, 1, 0); LDA8(At, 1, 0); WAIT_V(2); BAR8; WAIT_L(0); MMA8(0, 0, At, B0); BAR8;
    LDB8(B1, 1, 1); WAIT_V(0); BAR8; WAIT_L(0); MMA8(0, 1, At, B1); BAR8;
    LDA8(At, 1, 1); BAR8; WAIT_L(0); MMA8(1, 0, At, B0); MMA8(1, 1, At, B1); BAR8; }
  if (wr == 0) BAR8;
  float* ct = (float*)lds;
#pragma unroll
  for (int ai = 0; ai < 2; ++ai) {
    __syncthreads();
#pragma unroll
    for (int bj = 0; bj < 2; ++bj)
#pragma unroll
      for (int m = 0; m < 4; ++m)
#pragma unroll
        for (int n = 0; n < 2; ++n)
#pragma unroll
          for (int j = 0; j < 4; ++j) ct[(wr * 64 + m * 16 + fq * 4 + j) * 260 + bj * 128 + wc * 32 + n * 16 + fr] = acc[ai][bj][m][n][j];
    __syncthreads();
#pragma unroll 2
    for (int it = 0; it < 16; ++it) {
      const int idx = it * NTHR + tid; const int row = idx >> 6, c4 = (idx & 63) * 4;
      f32x4 v = *(const f32x4*)(ct + row * 260 + c4);
      epi(ai * 128 + row, c4, v);
    }
  }
  __syncthreads();
#undef ob0
#undef ob1
#undef SA8
#undef SB8
#undef STAGE_A
#undef STAGE_B
#undef LDA8
#undef LDB8
#undef MMA8
#undef WAIT_V
#undef WAIT_L
#undef BAR8
#undef SCHED8
}

template <int DQK, bool STATIC>
DI void attn_item(const bf16_t* __restrict__ Q, const bf16_t* __restrict__ Kp, const bf16_t* __restrict__ Vt, int nkeys, char* lds,
                  const bf16_t* __restrict__ Pg, bf16_t* __restrict__ Yg  , float mfix) {
  constexpr int KSTR = DQK * 2 + 16, VSTR = 136, KCH = DQK / 8, NKC = (64 * KCH) / 256, NQS = DQK / 16;
  constexpr int KBUF = 64 * KSTR, BUF = KBUF + 64 * VSTR;
  const int tid_full = otid(); const int tid = tid_full & 255; lds += (tid_full >> 8) * HALF_LDS;
  const int lane = tid & 63, w = tid >> 6, l31 = lane & 31, h = lane >> 5;
  bf16x8 qf[NQS];
#pragma unroll
  for (int ks = 0; ks < NQS; ++ks) qf[ks] = *(const bf16x8*)(Q + (size_t)(32 * w + l31) * DQK + 16 * ks + 8 * h);
  f32x16 o[2];
#pragma unroll
  for (int d = 0; d < 2; ++d)
#pragma unroll
    for (int e = 0; e < 16; ++e) o[d][e] = 0.f;
  float m_run = STATIC ? mfix : -1e30f, l_run = 0.f;
  u32x4 rk[NKC], rv[2];
  int koffg[NKC], koffl[NKC];
#pragma unroll
  for (int i = 0; i < NKC; ++i) { const int c = tid + 256 * i; const int key = c / KCH, part = c % KCH; koffg[i] = c * 8; koffl[i] = key * KSTR + part * 16; }
  const int vdv0 = tid >> 3, vpart = tid & 7;
  const bf16_t* vg = Vt + (size_t)vdv0 * T + vpart * 8;
  const int voffl = KBUF + vdv0 * VSTR + vpart * 16;
  const int nt = nkeys >> 6;
#pragma unroll
  for (int i = 0; i < NKC; ++i) rk[i] = *(const u32x4*)(Kp + koffg[i]);
#pragma unroll
  for (int i = 0; i < 2; ++i) rv[i] = *(const u32x4*)(vg + (size_t)i * 32 * T);
#pragma unroll
  for (int i = 0; i < NKC; ++i) *(u32x4*)(lds + koffl[i]) = rk[i];
#pragma unroll
  for (int i = 0; i < 2; ++i) { u32x2 a = {rv[i].x, rv[i].y}, b = {rv[i].z, rv[i].w}; *(u32x2*)(lds + voffl + i * 32 * VSTR) = a; *(u32x2*)(lds + voffl + i * 32 * VSTR + 8) = b; }
  __syncthreads();
  for (int j = 0; j < nt; ++j) {
    char* cur = lds + (j & 1) * BUF;
    const bool more = (j + 1 < nt);
    if (more) {
#pragma unroll
      for (int i = 0; i < NKC; ++i) rk[i] = *(const u32x4*)(Kp + (size_t)(j + 1) * 64 * DQK + koffg[i]);
#pragma unroll
      for (int i = 0; i < 2; ++i) rv[i] = *(const u32x4*)(vg + (size_t)i * 32 * T + (j + 1) * 64);
    }
    f32x16 s0, s1;
    bf16x8 kf[2][NQS];
#pragma unroll
    for (int kb = 0; kb < 2; ++kb)
#pragma unroll
      for (int ks = 0; ks < NQS; ++ks) kf[kb][ks] = *(const bf16x8*)(cur + (32 * kb + l31) * KSTR + (2 * ks + h) * 16);
    u32x4 vw[2][2][2];
#pragma unroll
    for (int kb = 0; kb < 2; ++kb)
#pragma unroll
      for (int s2 = 0; s2 < 2; ++s2)
#pragma unroll
        for (int d = 0; d < 2; ++d) {
          const char* vp = cur + KBUF + (32 * d + l31) * VSTR + (32 * kb + 16 * s2 + 4 * h) * 2;
          u32x2 v0 = *(const u32x2*)vp, v1 = *(const u32x2*)(vp + 16);
          u32x4 t4 = {v0.x, v0.y, v1.x, v1.y}; vw[kb][s2][d] = t4;
        }
#pragma unroll
    for (int e = 0; e < 16; ++e) { s0[e] = STATIC ? -mfix : 0.f; s1[e] = STATIC ? -mfix : 0.f; }
#pragma unroll
    for (int ks = 0; ks < NQS; ++ks) s0 = MFMA32(kf[0][ks], qf[ks], s0);
    if (!STATIC) {
      float mx = s0[0];
#pragma unroll
      for (int e = 1; e < 16; ++e) mx = fmaxf(mx, s0[e]);
      mx = fmaxf(mx, __shfl_xor(mx, 32));
      if (!__all(mx <= m_run + 8.f)) {
        const float m_new = fmaxf(m_run, mx);
        const float alpha = __builtin_amdgcn_exp2f(m_run - m_new);
        m_run = m_new; l_run *= alpha;
#pragma unroll
        for (int d = 0; d < 2; ++d)
#pragma unroll
          for (int e = 0; e < 16; ++e) o[d][e] *= alpha;
      }
    }
#pragma unroll
    for (int ks = 0; ks < NQS; ++ks) s1 = MFMA32(kf[1][ks], qf[ks], s1);
    {
      float ps = 0.f;
#pragma unroll
      for (int e = 0; e < 16; ++e) { float p = STATIC ? __builtin_amdgcn_exp2f(s0[e]) : __builtin_amdgcn_exp2f(s0[e] - m_run); s0[e] = p; ps += p; }
      l_run += ps;
    }
    if (!STATIC) {
      float mx = s1[0];
#pragma unroll
      for (int e = 1; e < 16; ++e) mx = fmaxf(mx, s1[e]);
      mx = fmaxf(mx, __shfl_xor(mx, 32));
      if (!__all(mx <= m_run + 8.f)) {
        const float m_new = fmaxf(m_run, mx);
        const float alpha = __builtin_amdgcn_exp2f(m_run - m_new);
        m_run = m_new; l_run *= alpha;
#pragma unroll
        for (int e = 0; e < 16; ++e) s0[e] *= alpha;
#pragma unroll
        for (int d = 0; d < 2; ++d)
#pragma unroll
          for (int e = 0; e < 16; ++e) o[d][e] *= alpha;
      }
    }
#pragma unroll
    for (int s2 = 0; s2 < 2; ++s2) {
      u32x4 pw = {cvtpk(s0[8 * s2], s0[8 * s2 + 1]), cvtpk(s0[8 * s2 + 2], s0[8 * s2 + 3]), cvtpk(s0[8 * s2 + 4], s0[8 * s2 + 5]), cvtpk(s0[8 * s2 + 6], s0[8 * s2 + 7])};
      bf16x8 pf = __builtin_bit_cast(bf16x8, pw);
#pragma unroll
      for (int d = 0; d < 2; ++d) o[d] = MFMA32(__builtin_bit_cast(bf16x8, vw[0][s2][d]), pf, o[d]);
    }
    {
      float ps = 0.f;
#pragma unroll
      for (int e = 0; e < 16; ++e) { float p = STATIC ? __builtin_amdgcn_exp2f(s1[e]) : __builtin_amdgcn_exp2f(s1[e] - m_run); s1[e] = p; ps += p; }
      l_run += ps;
    }
#pragma unroll
    for (int s2 = 0; s2 < 2; ++s2) {
      u32x4 pw = {cvtpk(s1[8 * s2], s1[8 * s2 + 1]), cvtpk(s1[8 * s2 + 2], s1[8 * s2 + 3]), cvtpk(s1[8 * s2 + 4], s1[8 * s2 + 5]), cvtpk(s1[8 * s2 + 6], s1[8 * s2 + 7])};
      bf16x8 pf = __builtin_bit_cast(bf16x8, pw);
#pragma unroll
      for (int d = 0; d < 2; ++d) o[d] = MFMA32(__builtin_bit_cast(bf16x8, vw[1][s2][d]), pf, o[d]);
    }
    if (more) {
      char* nxt = lds + ((j + 1) & 1) * BUF;
#pragma unroll
      for (int i = 0; i < NKC; ++i) *(u32x4*)(nxt + koffl[i]) = rk[i];
#pragma unroll
      for (int i = 0; i < 2; ++i) { u32x2 a = {rv[i].x, rv[i].y}, b = {rv[i].z, rv[i].w}; *(u32x2*)(nxt + voffl + i * 32 * VSTR) = a; *(u32x2*)(nxt + voffl + i * 32 * VSTR + 8) = b; }
    }
    __syncthreads();
  }
  const float lt = l_run + __shfl_xor(l_run, 32);
  const float inv = 1.f / lt;
  const size_t rq = (size_t)(32 * w + l31);
#pragma unroll
  for (int d = 0; d < 2; ++d)
#pragma unroll
    for (int q = 0; q < 4; ++q) {
      const int dv = 32 * d + 8 * q + 4 * h;
      f32x4 g = unpack4(*(const u32x2*)(Pg + rq * NIN + dv));
      f32x4 v = {o[d][4 * q] * inv * silu(g[0]), o[d][4 * q + 1] * inv * silu(g[1]), o[d][4 * q + 2] * inv * silu(g[2]), o[d][4 * q + 3] * inv * silu(g[3])};
      *(u32x2*)(Yg + rq * 1024 + dv) = pack4(v);
    }
}

template <int DQK, bool STATIC>
DI void attn_item8(const bf16_t* __restrict__ Q, const bf16_t* __restrict__ Kp, const bf16_t* __restrict__ Vt, int nkeys, char* lds,
                  const bf16_t* __restrict__ Pg, bf16_t* __restrict__ Yg  , float mfix) {
  constexpr int KSTR = DQK * 2 + 16, VSTR = 136, KCH = DQK / 8, NKC = (64 * KCH + 511) / 512, NQS = DQK / 16;
  constexpr int KBUF = 64 * KSTR, BUF = KBUF + 64 * VSTR;
  const int tid = otid();
  const int lane = tid & 63, w = tid >> 6, l31 = lane & 31, h = lane >> 5;
  bf16x8 qf[NQS];
#pragma unroll
  for (int ks = 0; ks < NQS; ++ks) qf[ks] = *(const bf16x8*)(Q + (size_t)(32 * w + l31) * DQK + 16 * ks + 8 * h);
  f32x16 o[2];
#pragma unroll
  for (int d = 0; d < 2; ++d)
#pragma unroll
    for (int e = 0; e < 16; ++e) o[d][e] = 0.f;
  float m_run = STATIC ? mfix : -1e30f, l_run = 0.f;
  u32x4 rk[NKC], rv[1];
  int koffg[NKC], koffl[NKC];
#pragma unroll
  for (int i = 0; i < NKC; ++i) { const int c = tid + 512 * i; const int key = c / KCH, part = c % KCH; koffg[i] = (c < 64 * KCH) ? c * 8 : 0; koffl[i] = (c < 64 * KCH) ? key * KSTR + part * 16 : -1; }
  const int vdv0 = tid >> 3, vpart = tid & 7;
  const bf16_t* vg = Vt + (size_t)vdv0 * T + vpart * 8;
  const int voffl = KBUF + vdv0 * VSTR + vpart * 16;
  const int nt = nkeys >> 6;
#pragma unroll
  for (int i = 0; i < NKC; ++i) rk[i] = *(const u32x4*)(Kp + koffg[i]);
#pragma unroll
  for (int i = 0; i < 1; ++i) rv[i] = *(const u32x4*)(vg + (size_t)i * 32 * T);
#pragma unroll
  for (int i = 0; i < NKC; ++i) if (koffl[i] >= 0) *(u32x4*)(lds + koffl[i]) = rk[i];
#pragma unroll
  for (int i = 0; i < 1; ++i) { u32x2 a = {rv[i].x, rv[i].y}, b = {rv[i].z, rv[i].w}; *(u32x2*)(lds + voffl + i * 32 * VSTR) = a; *(u32x2*)(lds + voffl + i * 32 * VSTR + 8) = b; }
  {
#pragma unroll
    for (int i = 0; i < NKC; ++i) rk[i] = *(const u32x4*)(Kp + (size_t)64 * DQK + koffg[i]);
    rv[0] = *(const u32x4*)(vg + 64);
#pragma unroll
    for (int i = 0; i < NKC; ++i) if (koffl[i] >= 0) *(u32x4*)(lds + BUF + koffl[i]) = rk[i];
    { u32x2 a = {rv[0].x, rv[0].y}, b = {rv[0].z, rv[0].w}; *(u32x2*)(lds + BUF + voffl) = a; *(u32x2*)(lds + BUF + voffl + 8) = b; }
  }
  __syncthreads();
  const int np = nt >> 1;
  for (int jj = 0; jj < np; ++jj) {
   char* curp = lds + (jj & 1) * 2 * BUF; char* nxtp = lds + ((jj + 1) & 1) * 2 * BUF;
   const bool more = (jj + 1 < np);
#pragma nounroll
   for (int sub = 0; sub < 2; ++sub) {
    const char* cur = curp + sub * BUF;
    const int j = 2 * jj + sub + 1;
    if (more) {
#pragma unroll
      for (int i = 0; i < NKC; ++i) rk[i] = *(const u32x4*)(Kp + (size_t)(j + 1) * 64 * DQK + koffg[i]);
#pragma unroll
      for (int i = 0; i < 1; ++i) rv[i] = *(const u32x4*)(vg + (size_t)i * 32 * T + (j + 1) * 64);
    }
    f32x16 s0, s1;
    bf16x8 kf[2][NQS];
#pragma unroll
    for (int kb = 0; kb < 2; ++kb)
#pragma unroll
      for (int ks = 0; ks < NQS; ++ks) kf[kb][ks] = *(const bf16x8*)(cur + (32 * kb + l31) * KSTR + (2 * ks + h) * 16);
    u32x4 vw[2][2][2];
#pragma unroll
    for (int kb = 0; kb < 2; ++kb)
#pragma unroll
      for (int s2 = 0; s2 < 2; ++s2)
#pragma unroll
        for (int d = 0; d < 2; ++d) {
          const char* vp = cur + KBUF + (32 * d + l31) * VSTR + (32 * kb + 16 * s2 + 4 * h) * 2;
          u32x2 v0 = *(const u32x2*)vp, v1 = *(const u32x2*)(vp + 16);
          u32x4 t4 = {v0.x, v0.y, v1.x, v1.y}; vw[kb][s2][d] = t4;
        }
#pragma unroll
    for (int e = 0; e < 16; ++e) { s0[e] = STATIC ? -mfix : 0.f; s1[e] = STATIC ? -mfix : 0.f; }
#pragma unroll
    for (int ks = 0; ks < NQS; ++ks) s0 = MFMA32(kf[0][ks], qf[ks], s0);
    if (!STATIC) {
      float mx = s0[0];
#pragma unroll
      for (int e = 1; e < 16; ++e) mx = fmaxf(mx, s0[e]);
      mx = fmaxf(mx, __shfl_xor(mx, 32));
      if (!__all(mx <= m_run + 8.f)) {
        const float m_new = fmaxf(m_run, mx);
        const float alpha = __builtin_amdgcn_exp2f(m_run - m_new);
        m_run = m_new; l_run *= alpha;
#pragma unroll
        for (int d = 0; d < 2; ++d)
#pragma unroll
          for (int e = 0; e < 16; ++e) o[d][e] *= alpha;
      }
    }
#pragma unroll
    for (int ks = 0; ks < NQS; ++ks) s1 = MFMA32(kf[1][ks], qf[ks], s1);
    {
      float ps = 0.f;
#pragma unroll
      for (int e = 0; e < 16; ++e) { float p = STATIC ? __builtin_amdgcn_exp2f(s0[e]) : __builtin_amdgcn_exp2f(s0[e] - m_run); s0[e] = p; ps += p; }
      l_run += ps;
    }
    if (!STATIC) {
      float mx = s1[0];
#pragma unroll
      for (int e = 1; e < 16; ++e) mx = fmaxf(mx, s1[e]);
      mx = fmaxf(mx, __shfl_xor(mx, 32));
      if (!__all(mx <= m_run + 8.f)) {
        const float m_new = fmaxf(m_run, mx);
        const float alpha = __builtin_amdgcn_exp2f(m_run - m_new);
        m_run = m_new; l_run *= alpha;
#pragma unroll
        for (int e = 0; e < 16; ++e) s0[e] *= alpha;
#pragma unroll
        for (int d = 0; d < 2; ++d)
#pragma unroll
          for (int e = 0; e < 16; ++e) o[d][e] *= alpha;
      }
    }
#pragma unroll
    for (int s2 = 0; s2 < 2; ++s2) {
      u32x4 pw = {cvtpk(s0[8 * s2], s0[8 * s2 + 1]), cvtpk(s0[8 * s2 + 2], s0[8 * s2 + 3]), cvtpk(s0[8 * s2 + 4], s0[8 * s2 + 5]), cvtpk(s0[8 * s2 + 6], s0[8 * s2 + 7])};
      bf16x8 pf = __builtin_bit_cast(bf16x8, pw);
#pragma unroll
      for (int d = 0; d < 2; ++d) o[d] = MFMA32(__builtin_bit_cast(bf16x8, vw[0][s2][d]), pf, o[d]);
    }
    {
      float ps = 0.f;
#pragma unroll
      for (int e = 0; e < 16; ++e) { float p = STATIC ? __builtin_amdgcn_exp2f(s1[e]) : __builtin_amdgcn_exp2f(s1[e] - m_run); s1[e] = p; ps += p; }
      l_run += ps;
    }
#pragma unroll
    for (int s2 = 0; s2 < 2; ++s2) {
      u32x4 pw = {cvtpk(s1[8 * s2], s1[8 * s2 + 1]), cvtpk(s1[8 * s2 + 2], s1[8 * s2 + 3]), cvtpk(s1[8 * s2 + 4], s1[8 * s2 + 5]), cvtpk(s1[8 * s2 + 6], s1[8 * s2 + 7])};
      bf16x8 pf = __builtin_bit_cast(bf16x8, pw);
#pragma unroll
      for (int d = 0; d < 2; ++d) o[d] = MFMA32(__builtin_bit_cast(bf16x8, vw[1][s2][d]), pf, o[d]);
    }
    if (more) {
      char* nxt = nxtp + sub * BUF;
#pragma unroll
      for (int i = 0; i < NKC; ++i) if (koffl[i] >= 0) *(u32x4*)(nxt + koffl[i]) = rk[i];
#pragma unroll
      for (int i = 0; i < 1; ++i) { u32x2 a = {rv[i].x, rv[i].y}, b = {rv[i].z, rv[i].w}; *(u32x2*)(nxt + voffl + i * 32 * VSTR) = a; *(u32x2*)(nxt + voffl + i * 32 * VSTR + 8) = b; }
    }
   }
   __syncthreads();
  }
  const float lt = l_run + __shfl_xor(l_run, 32);
  const float inv = 1.f / lt;
  const size_t rq = (size_t)(32 * w + l31);
#pragma unroll
  for (int d = 0; d < 2; ++d)
#pragma unroll
    for (int q = 0; q < 4; ++q) {
      const int dv = 32 * d + 8 * q + 4 * h;
      f32x4 g = unpack4(*(const u32x2*)(Pg + rq * NIN + dv));
      f32x4 v = {o[d][4 * q] * inv * silu(g[0]), o[d][4 * q + 1] * inv * silu(g[1]), o[d][4 * q + 2] * inv * silu(g[2]), o[d][4 * q + 3] * inv * silu(g[3])};
      *(u32x2*)(Yg + rq * 1024 + dv) = pack4(v);
    }
}

DI void xpose_cvt(const float* __restrict__ src, bf16_t* __restrict__ dst, int K, int N, int Npad, bool perm_kv, size_t gtid, size_t gstride) {
  const size_t total = (size_t)Npad * (K >> 3);
#pragma nounroll
  for (size_t i = gtid; i < total; i += gstride) {
    const int n = (int)(i % Npad), kb = (int)(i / Npad);
    float v[8];
#pragma unroll
    for (int e = 0; e < 8; ++e) v[e] = (n < N) ? src[(size_t)(8 * kb + e) * N + n] : 0.f;
    int row = n;
    if (perm_kv) { const int hh = n >> 7, wv = n & 127; row = (wv < 64) ? (64 * hh + wv) : (256 + 64 * hh + (wv - 64)); }
    u32x4 o = {cvtpk(v[0], v[1]), cvtpk(v[2], v[3]), cvtpk(v[4], v[5]), cvtpk(v[6], v[7])};
    *(u32x4*)(dst + (size_t)row * K + 8 * kb) = o;
  }
}

DI void phase0(KP p, char* lds) {
  unsigned char* ws = p->ws; asm volatile("" : "+s"(ws));
  const int tid = otid();
  const size_t gtid = (size_t)blockIdx.x * NTHR + tid, gstride = (size_t)gridDim.x * NTHR;
  for (int l = 0; l < 2; ++l) {
    xpose_cvt(p->w_in + (size_t)l * 1024 * NIN, (bf16_t*)(ws + WS_WIN) + (size_t)l * NINP * 1024, 1024, NIN, NINP, false, gtid, gstride);
    xpose_cvt(p->mla_w_uq + (size_t)l * 192 * 384, (bf16_t*)(ws + WS_WUQ) + (size_t)l * 384 * 192, 192, 384, 384, false, gtid, gstride);
    xpose_cvt(p->mla_w_ukv + (size_t)l * 128 * 512, (bf16_t*)(ws + WS_WUKV) + (size_t)l * 512 * 128, 128, 512, 512, true, gtid, gstride);
    xpose_cvt(p->fnet_w + (size_t)l * 256 * 256, (bf16_t*)(ws + WS_WF) + (size_t)l * 256 * 256, 256, 256, 256, false, gtid, gstride);
    xpose_cvt(p->w_out + (size_t)l * 1024 * 1024, (bf16_t*)(ws + WS_WOUT) + (size_t)l * 1024 * 1024, 1024, 1024, 1024, false, gtid, gstride);
  }
  {
    const float* src = p->cm_w_s; bf16_t* dst = (bf16_t*)(ws + WS_WS);
    for (size_t i = gtid; i < (size_t)2 * 4 * 128 * 128 / 8; i += gstride) {
      f32x4 a = *(const f32x4*)(src + i * 8), b = *(const f32x4*)(src + i * 8 + 4);
      u32x4 o = {cvtpk(a[0], a[1]), cvtpk(a[2], a[3]), cvtpk(b[0], b[1]), cvtpk(b[2], b[3])};
      *(u32x4*)(dst + i * 8) = o;
    }
  }
  {
    bf16_t* dl = (bf16_t*)(ws + WS_DLAT);
#pragma nounroll
    for (size_t i = gtid; i < (size_t)2048 * 256; i += gstride) {
      const int sp = (int)(i >> 8), k8 = (int)(i & 255) * 8;
      float v[8];
#pragma unroll
      for (int e = 0; e < 8; ++e) { const int k = k8 + e, s = (k <= 1024) ? k : k - 1024; const int ph = (sp * s) & 2047; const float a = (float)ph * (1.f / 1024.f); v[e] = (k <= 1024) ? cospif(a) : -sinpif(a); }
      u32x4 o = {cvtpk(v[0], v[1]), cvtpk(v[2], v[3]), cvtpk(v[4], v[5]), cvtpk(v[6], v[7])};
      *(u32x4*)(dl + (size_t)sp * 2048 + k8) = o;
    }
    bf16_t* dc = (bf16_t*)(ws + WS_DCTX);
    for (size_t i = gtid; i < (size_t)256 * 64; i += gstride) {
      const int sp = (int)(i >> 6), k8 = (int)(i & 63) * 8;
      float v[8];
#pragma unroll
      for (int e = 0; e < 8; ++e) { const int k = k8 + e, s = k & 255; const int ph = (sp * s) & 255; const float a = (float)ph * (1.f / 128.f); v[e] = (k < 256) ? cospif(a) : -sinpif(a); }
      u32x4 o = {cvtpk(v[0], v[1]), cvtpk(v[2], v[3]), cvtpk(v[4], v[5]), cvtpk(v[6], v[7])};
      *(u32x4*)(dc + (size_t)sp * 512 + k8) = o;
    }
    bf16_t* cm = (bf16_t*)(ws + WS_CM);
    for (size_t i = gtid; i < (size_t)128 * 64; i += gstride) {
      const int n = (int)(i >> 6), c = (int)(i & 63);
      const int ph = (c * (n & 63)) & 63; const float a = (float)ph * (1.f / 32.f);
      cm[i] = f2bf((n < 64) ? cospif(a) : sinpif(a));
    }
    float* rg = (float*)(ws + WS_ROPG);
    for (size_t i = gtid; i < 64 * 16; i += gstride) {
      const int pos = (int)(i >> 4), j = (int)(i & 15);
      const float inv = powf(10000.f, -(float)j / 16.f); float sn, cs; sincosf((float)pos * inv, &sn, &cs);
      rg[2 * i] = cs; rg[2 * i + 1] = sn;
    }
    if (blockIdx.x == 0 && tid < 4) {
      const int l = tid >> 1, isb = tid & 1; const int d = isb ? 64 : 96;
      const float* gq = (isb ? p->gqa_qn : p->mla_qn) + l * d; const float* gk = (isb ? p->gqa_kn : p->mla_kn) + l * d;
      float mq = 0.f, mk = 0.f;
      for (int i = 0; i < d; ++i) { mq = fmaxf(mq, fabsf(gq[i])); mk = fmaxf(mk, fabsf(gk[i])); }
      ((float*)(ws + WS_SBND))[l * 2 + isb] = sqrtf((float)d) * mq * mk * 1.4426950408889634f;
    }
    float* rm = (float*)(ws + WS_ROPM);
    for (size_t i = gtid; i < 64 * 8; i += gstride) {
      const int pos = (int)(i >> 3), j = (int)(i & 7);
      const float inv = powf(10000.f, -(float)j / 8.f); float sn, cs; sincosf((float)pos * inv, &sn, &cs);
      rm[2 * i] = cs; rm[2 * i + 1] = sn;
    }
  }
  const int hb = tid >> 8, tq = tid & 255;
  float* sl = (float*)(lds + hb * HALF_LDS);
  float* mod = (float*)(ws + WS_MOD);
  const int kg = tq >> 5, cn = tq & 31;
  for (int it = 2 * blockIdx.x + hb; it < 192; it += 2 * gridDim.x) {
    const int l = it / 96, n = (it % 96) * 32 + cn;
    float acc[17];
#pragma unroll
    for (int i = 0; i < 17; ++i) acc[i] = 0.f;
    for (int half = 0; half < 2; ++half) {
      __syncthreads();
#pragma unroll
      for (int e0 = 0; e0 < 17 * 512; e0 += 256) {
        const int e = e0 + tq;
        const int i = e >> 9, k = (e & 511) + 512 * half;
        const float cv = (i < 16) ? p->c[i * 1024 + k] : p->c_ctx[k];
        sl[e] = silu(cv);
      }
      __syncthreads();
      const float* wp = p->w_mod + ((size_t)l * 1024 + 512 * half + kg * 64) * 3072 + n;
#pragma unroll 4
      for (int kk = 0; kk < 64; ++kk) {
        const float wv = wp[(size_t)kk * 3072];
#pragma unroll
        for (int i = 0; i < 17; ++i) acc[i] = fmaf(sl[i * 512 + kg * 64 + kk], wv, acc[i]);
      }
    }
    __syncthreads();
#pragma unroll
    for (int i = 0; i < 17; ++i) sl[(kg * 17 + i) * 32 + cn] = acc[i];
    __syncthreads();
    for (int e = tq; e < 17 * 32; e += 256) {
      const int i = e >> 5, c2 = e & 31;
      float s = 0.f;
#pragma unroll
      for (int g = 0; g < 8; ++g) s += sl[(g * 17 + i) * 32 + c2];
      const int nn = (it % 96) * 32 + c2;
      mod[((size_t)l * 17 + i) * 3072 + nn] = s + p->b_mod[l * 3072 + nn];
    }
    __syncthreads();
  }
}

DI void phase_norm(KP p, int l) {
  unsigned char* ws = p->ws; asm volatile("" : "+s"(ws));
  const float* xl = (l == 0) ? p->x : p->out;
  const float* xc = (l == 0) ? p->ctx : (const float*)(ws + WS_CTX1);
  const float* g = p->norm_g + l * 1024;
  const float* mod = (const float*)(ws + WS_MOD) + (size_t)l * 17 * 3072;
  bf16_t* hx = (bf16_t*)(ws + WS_R1);
  const int tid = otid(); const int lane = tid & 63;
  const int gw = blockIdx.x * (NTHR / 64) + (tid >> 6), nw = gridDim.x * (NTHR / 64);
  const int rpw = (M + nw - 1) / nw;
  int cur_mod = -1;
  f32x4 G[4], SH[4];
#pragma unroll 2
  for (int r = gw * rpw; r < min(M, (gw + 1) * rpw); ++r) {
    const int b = r / T, t = r % T;
    const float* src = (t < SEQ) ? xl + ((size_t)b * SEQ + t) * 1024 : xc + ((size_t)b * CL + (t - SEQ)) * 1024;
    const int mrow = (t < SEQ) ? b : 16;
    if (mrow != cur_mod) {
      cur_mod = mrow;
      const float* mr = mod + (size_t)mrow * 3072;
#pragma unroll
      for (int i = 0; i < 4; ++i) {
        const int k = i * 256 + lane * 4;
        const f32x4 gg = *(const f32x4*)(g + k), sc = *(const f32x4*)(mr + 1024 + k);
        SH[i] = *(const f32x4*)(mr + k);
#pragma unroll
        for (int e = 0; e < 4; ++e) G[i][e] = gg[e] * (1.f + sc[e]);
      }
    }
    f32x4 v[4]; float ss = 0.f;
#pragma unroll
    for (int i = 0; i < 4; ++i) { v[i] = *(const f32x4*)(src + i * 256 + lane * 4); ss += v[i][0] * v[i][0] + v[i][1] * v[i][1] + v[i][2] * v[i][2] + v[i][3] * v[i][3]; }
    ss = red64(ss);
    const float rstd = rsqrtf(ss * (1.f / 1024.f) + 1e-6f);
#pragma unroll
    for (int i = 0; i < 4; ++i) {
      const int k = i * 256 + lane * 4;
      f32x4 o;
#pragma unroll
      for (int e = 0; e < 4; ++e) o[e] = v[i][e] * rstd * G[i][e] + SH[i][e];
      *(u32x2*)(hx + (size_t)r * 1024 + k) = pack4(o);
    }
  }
}

DI void phase_inproj(KP p, int l, char* lds) {
  unsigned char* ws = p->ws; asm volatile("" : "+s"(ws));
  const bf16_t* hx = (const bf16_t*)(ws + WS_R1);
  const bf16_t* wt = (const bf16_t*)(ws + WS_WIN) + (size_t)l * NINP * 1024;
  bf16_t* P = (bf16_t*)(ws + WS_P);
  const int xcd = blockIdx.x & 7, lb = blockIdx.x >> 3, nlb = gridDim.x >> 3, hb = __builtin_amdgcn_readfirstlane(otid() >> 8);
  constexpr int NBIG = 18 * 10;
  for (int j = lb; j < NBIG; j += nlb) {
    {
      int mloc, ntile;
      if (j < 144) { mloc = (j % 72) >> 2; ntile = (j / 72) * 4 + (j & 3); } else { const int j2 = j - 144; mloc = j2 >> 1; ntile = 8 + (j2 & 1); }
      const int mt = 18 * xcd + mloc;
      if (l == 1 && (mt % 9) == 8 && !(ntile == 0 || ntile == 1 || ntile == 3 || ntile == 4)) continue;
      const int m0 = mt * 256, n0 = ntile * 256;
      gemm256(hx + (size_t)m0 * 1024, 1024, wt + (size_t)n0 * 1024, 1024, 1024, lds, [&](int m, int n, f32x4 v) {
        __builtin_nontemporal_store(pack4(v), (u32x2*)(P + (size_t)(m0 + m) * NIN + n0 + n));
      });
    }
  }
  const int nfull = NBIG % nlb, nfree = (nfull == 0) ? nlb : nlb - nfull;
  for (int sp = (nfull == 0) ? lb : lb - nfull; sp >= 0 && sp < 18; sp += nfree) {
    {
      const int mt = 36 * xcd + 2 * sp + hb;
      if (l == 1 && (mt % 18) >= 16) continue;
      const int m0 = mt * 128;
      gemm_tile(hx + (size_t)m0 * 1024, 1024, wt + (size_t)2560 * 1024, 1024, 1024, lds, [&](int m, int n, f32x4 v) {
        if (2560 + n < NIN) __builtin_nontemporal_store(pack4(v), (u32x2*)(P + (size_t)(m0 + m) * NIN + 2560 + n));
      });
    }
  }
}

DI void rope4(f32x4& v, int u, const float sg, const float* cs) {
#pragma unroll
  for (int e = 0; e < 4; ++e) {
    const float xp = __shfl_xor(v[e], 4);
    v[e] = v[e] * cs[2 * e] + sg * xp * cs[2 * e + 1];
  }
}
DI void rope2(float& a, float& b, const float sg, const f32x4 cs) {
  const float ap = __shfl_xor(a, 4), bp = __shfl_xor(b, 4);
  a = a * cs[0] + sg * ap * cs[1];
  b = b * cs[2] + sg * bp * cs[3];
}

DI void phase_feat_a(KP p, int l, char* lds) {
  unsigned char* ws = p->ws; asm volatile("" : "+s"(ws));
  const bf16_t* P = (const bf16_t*)(ws + WS_P);
  bf16_t* cqn = (bf16_t*)(ws + WS_R1 + R1_CQN);
  bf16_t* ckvn = (bf16_t*)(ws + WS_R1 + R1_CKVN);
  bf16_t* QB = (bf16_t*)(ws + WS_QB); bf16_t* KB = (bf16_t*)(ws + WS_KB); bf16_t* VBT = (bf16_t*)(ws + WS_VBT);
  bf16_t* vnT = (bf16_t*)(ws + WS_VNT);
  const float* rg = (const float*)(ws + WS_ROPG);
  const int tid = otid(); const int lane = tid & 63, u = lane & 15, sub = lane >> 4;
  const int gw = blockIdx.x * (NTHR / 64) + (tid >> 6), nw = gridDim.x * (NTHR / 64);
  const int hb = tid >> 8, tq = tid & 255; char* ldh = lds + hb * HALF_LDS;
  {
    constexpr int STR = 144;
    const float* lg = p->cm_ln_g + l * 256; const float* lbp = p->cm_ln_b + l * 256;
    for (int unit = 2 * blockIdx.x + hb; unit < (M / 64) * 2; unit += 2 * gridDim.x) {
      const int grp = unit >> 1; const bool isv2 = unit & 1;
      const int r0 = grp * 64; const int b = r0 / T, t0 = r0 % T;
      if (!isv2) {
        const int c = tq & 31, rb = 2 * (tq >> 5);
        f32x4 g0 = *(const f32x4*)(lg + 8 * c), g1 = *(const f32x4*)(lg + 8 * c + 4), b0 = *(const f32x4*)(lbp + 8 * c), b1 = *(const f32x4*)(lbp + 8 * c + 4);
        const float gg[8] = {g0[0], g0[1], g0[2], g0[3], g1[0], g1[1], g1[2], g1[3]};
        const float bb[8] = {b0[0], b0[1], b0[2], b0[3], b1[0], b1[1], b1[2], b1[3]};
#pragma unroll
        for (int i = 0; i < 4; ++i) {
          float vn[2][8];
#pragma unroll
          for (int rr = 0; rr < 2; ++rr) {
            const int row = rb + 16 * i + rr;
            u32x4 q = *(const u32x4*)(P + (size_t)(r0 + row) * NIN + O_V + 8 * c);
            float f[8] = {bflo(q.x), bfhi(q.x), bflo(q.y), bfhi(q.y), bflo(q.z), bfhi(q.z), bflo(q.w), bfhi(q.w)};
            float s1 = 0.f, s2 = 0.f;
#pragma unroll
            for (int e = 0; e < 8; ++e) { s1 += f[e]; s2 += f[e] * f[e]; }
#pragma unroll
            for (int m = 1; m < 32; m <<= 1) { s1 += __shfl_xor(s1, m); s2 += __shfl_xor(s2, m); }
            const float mu = s1 * (1.f / 256.f); const float var = fmaxf(s2 * (1.f / 256.f) - mu * mu, 0.f); const float rs = rsqrtf(var + 1e-6f);
#pragma unroll
            for (int e = 0; e < 8; ++e) vn[rr][e] = (f[e] - mu) * rs * gg[e] + bb[e];
          }
#pragma unroll
          for (int e = 0; e < 8; ++e) *(unsigned*)(ldh + (8 * c + e) * STR + (rb + 16 * i) * 2) = cvtpk(vn[0][e], vn[1][e]);
        }
        __syncthreads();
        bf16_t* vo = vnT + (size_t)(r0 >> 7) * 256 * 128 + (r0 & 127);
#pragma unroll
        for (int i = 0; i < 8; ++i) {
          const int ch = (tq >> 3) + 32 * i, part = tq & 7;
          *(u32x4*)(vo + (size_t)ch * 128 + part * 8) = *(const u32x4*)(ldh + ch * STR + part * 16);
        }
      } else {
        const int c = tq & 15, rb = 2 * (tq >> 4);
#pragma unroll
        for (int i = 0; i < 2; ++i) {
          u32x4 q0 = *(const u32x4*)(P + (size_t)(r0 + rb + 32 * i) * NIN + O_V2 + 8 * c);
          u32x4 q1 = *(const u32x4*)(P + (size_t)(r0 + rb + 32 * i + 1) * NIN + O_V2 + 8 * c);
          const unsigned a[4] = {q0.x, q0.y, q0.z, q0.w}, d[4] = {q1.x, q1.y, q1.z, q1.w};
#pragma unroll
          for (int e = 0; e < 4; ++e) {
            *(unsigned*)(ldh + (8 * c + 2 * e) * STR + (rb + 32 * i) * 2) = (a[e] & 0xffffu) | (d[e] << 16);
            *(unsigned*)(ldh + (8 * c + 2 * e + 1) * STR + (rb + 32 * i) * 2) = (a[e] >> 16) | (d[e] & 0xffff0000u);
          }
        }
        __syncthreads();
        bf16_t* vb = VBT + (size_t)b * 2 * 64 * T + t0;
#pragma unroll
        for (int i = 0; i < 4; ++i) {
          const int ch = (tq >> 3) + 32 * i, part = tq & 7;
          *(u32x4*)(vb + (size_t)ch * T + part * 8) = *(const u32x4*)(ldh + ch * STR + part * 16);
        }
      }
      __syncthreads();
    }
  }
  constexpr int NTA = M / 4;
  f32x4 gcq[3], gckv[2];
#pragma unroll
  for (int e = 0; e < 3; ++e) gcq[e] = *(const f32x4*)(p->mla_q_norm + l * 192 + 12 * u + 4 * e);
#pragma unroll
  for (int e = 0; e < 2; ++e) gckv[e] = *(const f32x4*)(p->mla_kv_norm + l * 128 + 8 * u + 4 * e);
#pragma unroll 4
  for (int task = gw; task < NTA; task += nw) {
    {
      const int r = task * 4 + sub; const int b = r / T, t = r % T;
      const bf16_t* pr = P + (size_t)r * NIN;
      {
        f32x4 v[3]; float ss = 0.f;
#pragma unroll
        for (int e = 0; e < 3; ++e) { v[e] = unpack4(*(const u32x2*)(pr + O_CQ + 12 * u + 4 * e)); ss += v[e][0] * v[e][0] + v[e][1] * v[e][1] + v[e][2] * v[e][2] + v[e][3] * v[e][3]; }
        ss = red16(ss); const float rs = rsqrtf(ss * (1.f / 192.f) + 1e-6f);
#pragma unroll
        for (int e = 0; e < 3; ++e) {
          const f32x4 g = gcq[e];
          f32x4 o = {v[e][0] * rs * g[0], v[e][1] * rs * g[1], v[e][2] * rs * g[2], v[e][3] * rs * g[3]};
          *(u32x2*)(cqn + (size_t)r * 192 + 12 * u + 4 * e) = pack4(o);
        }
      }
      {
        f32x4 v[2]; float ss = 0.f;
#pragma unroll
        for (int e = 0; e < 2; ++e) { v[e] = unpack4(*(const u32x2*)(pr + O_CKV + 8 * u + 4 * e)); ss += v[e][0] * v[e][0] + v[e][1] * v[e][1] + v[e][2] * v[e][2] + v[e][3] * v[e][3]; }
        ss = red16(ss); const float rs = rsqrtf(ss * (1.f / 128.f) + 1e-6f);
#pragma unroll
        for (int e = 0; e < 2; ++e) {
          const f32x4 g = gckv[e];
          f32x4 o = {v[e][0] * rs * g[0], v[e][1] * rs * g[1], v[e][2] * rs * g[2], v[e][3] * rs * g[3]};
          *(u32x2*)(ckvn + (size_t)r * 128 + 8 * u + 4 * e) = pack4(o);
        }
      }
      const int posg = (u & 8) ? (t & 63) : (t >> 6); const float sgg = (u & 4) ? 1.f : -1.f;
      const f32x4 c01 = *(const f32x4*)(rg + (posg * 16 + 4 * (u & 3)) * 2), c23 = *(const f32x4*)(rg + (posg * 16 + 4 * (u & 3) + 2) * 2);
      const float csg[8] = {c01[0], c01[1], c01[2], c01[3], c23[0], c23[1], c23[2], c23[3]};
      const f32x4 gqv = *(const f32x4*)(p->gqa_qn + l * 64 + 4 * u), gkv = *(const f32x4*)(p->gqa_kn + l * 64 + 4 * u);
#pragma unroll
      for (int hh = 0; hh < 6; ++hh) {
        const bool isq = hh < 4; const int hd = isq ? hh : hh - 4;
        f32x4 v = unpack4(*(const u32x2*)(pr + (isq ? O_Q2 : O_K2) + 64 * hd + 4 * u));
        float ss = red16(v[0] * v[0] + v[1] * v[1] + v[2] * v[2] + v[3] * v[3]);
        const float rs = rsqrtf(ss * (1.f / 64.f) + 1e-6f);
        const f32x4 g = isq ? gqv : gkv;
#pragma unroll
        for (int e = 0; e < 4; ++e) v[e] = v[e] * rs * g[e];
        if (t < SEQ) rope4(v, u, sgg, csg);
        if (isq) {
#pragma unroll
          for (int e = 0; e < 4; ++e) v[e] *= 0.18033688011112042f;
        }
        bf16_t* dst = isq ? QB + (((size_t)b * 4 + hd) * T + t) * 64 + 4 * u : KB + (((size_t)b * 2 + hd) * T + t) * 64 + 4 * u;
        *(u32x2*)dst = pack4(v);
      }
    }
  }
}

DI void phase_feat_b(KP p, int l, char* lds) {
  unsigned char* ws = p->ws; asm volatile("" : "+s"(ws));
  const bf16_t* P = (const bf16_t*)(ws + WS_P);
  const bf16_t* cqn = (const bf16_t*)(ws + WS_R1 + R1_CQN);
  const bf16_t* ckvn = (const bf16_t*)(ws + WS_R1 + R1_CKVN);
  bf16_t* q1r = (bf16_t*)(ws + WS_R1 + R1_Q1R);
  bf16_t* kr = (bf16_t*)(ws + WS_R1 + R1_KR);
  const bf16_t* wuq = (const bf16_t*)(ws + WS_WUQ) + (size_t)l * 384 * 192;
  const bf16_t* wukv = (const bf16_t*)(ws + WS_WUKV) + (size_t)l * 512 * 128;
  const bf16_t* cm = (const bf16_t*)(ws + WS_CM);
  bf16_t* VAT = (bf16_t*)(ws + WS_VAT); bf16_t* FT = (bf16_t*)(ws + WS_FT); bf16_t* FTC = (bf16_t*)(ws + WS_FTC);
  constexpr int N1 = 288 * 3, N2 = 288 * 2, N3 = 288 * 2, N4 = 288 * 4;
  const int hbb = __builtin_amdgcn_readfirstlane(otid() >> 8);
  for (int it = 2 * blockIdx.x + hbb; it < N1 + N2 + N3 + N4; it += 2 * gridDim.x) {
    if (it < N1) {
      const int mt = it / 3, nt = it % 3; const int m0 = mt * 128, n0 = nt * 128;
      gemm_tile(cqn + (size_t)m0 * 192, 192, wuq + (size_t)n0 * 192, 192, 192, lds, [&](int m, int n, f32x4 v) {
        *(u32x2*)(q1r + (size_t)(m0 + m) * 384 + n0 + n) = pack4(v); });
    } else if (it < N1 + N2) {
      const int i2 = it - N1; const int mt = i2 >> 1, nt = i2 & 1; const int m0 = mt * 128, n0 = nt * 128;
      gemm_tile(ckvn + (size_t)m0 * 128, 128, wukv + (size_t)n0 * 128, 128, 128, lds, [&](int m, int n, f32x4 v) {
        *(u32x2*)(kr + (size_t)(m0 + m) * 256 + n0 + n) = pack4(v); });
    } else if (it < N1 + N2 + N3) {
      const int i2 = it - N1 - N2; const int tt = i2 >> 1, mt2 = i2 & 1;
      gemm_tile(wukv + (size_t)(256 + 128 * mt2) * 128, 128, ckvn + (size_t)tt * 128 * 128, 128, 128, lds, [&](int m, int n, f32x4 v) {
        const int mm = 128 * mt2 + m, head = mm >> 6, dv = mm & 63; const int r = tt * 128 + n; const int b = r / T, t = r % T;
        *(u32x2*)(VAT + (((size_t)b * 4 + head) * 64 + dv) * T + t) = pack4(v); });
    } else {
      const int i2 = it - N1 - N2 - N3; const int tt = i2 >> 2, g = i2 & 3;
      gemm_tile(cm, 64, P + (size_t)tt * 128 * NIN + O_F + 64 * g, NIN, 64, lds, [&](int m, int n, f32x4 v) {
        const int col = 64 * g + (m & 63), part = m >> 6; const int r = tt * 128 + n; const int b = r / T, t = r % T;
        if (t < SEQ) *(u32x2*)(FT + ((size_t)b * 256 + col) * 4096 + part * 2048 + t) = pack4(v);
        else *(u32x2*)(FTC + ((size_t)b * 256 + col) * 512 + part * 256 + (t - SEQ)) = pack4(v); });
    }
  }
}

DI void phase_feat_c(KP p, int l) {
  unsigned char* ws = p->ws; asm volatile("" : "+s"(ws));
  const bf16_t* P = (const bf16_t*)(ws + WS_P);
  const bf16_t* q1r = (const bf16_t*)(ws + WS_R1 + R1_Q1R);
  const bf16_t* krw = (const bf16_t*)(ws + WS_R1 + R1_KR);
  bf16_t* QA = (bf16_t*)(ws + WS_QA); bf16_t* KA = (bf16_t*)(ws + WS_KA);
  const float* rm = (const float*)(ws + WS_ROPM);
  const int tid = otid(); const int lane = tid & 63, u = lane & 15, sub = lane >> 4;
  const int gw = blockIdx.x * (NTHR / 64) + (tid >> 6), nw = gridDim.x * (NTHR / 64);
  {
    const bf16_t* FT = (const bf16_t*)(ws + WS_FT); bf16_t* FTF = (bf16_t*)(ws + WS_FTF);
    for (int task = gw; task < NB * 256 * 4; task += nw) {
      const int row = task >> 2, k8 = (task & 3) * 512 + lane * 8;
      const bf16_t* fr = FT + (size_t)row * 4096;
      const bool cosp = k8 < 1024;
      const int f0 = cosp ? k8 : 2048 + (k8 - 1024);
      const int mi = cosp ? 2048 - k8 : 4096 - (k8 - 1024);
      const u32x4 fw = *(const u32x4*)(fr + f0), ml = *(const u32x4*)(fr + mi - 8);
      const float m0v = bflo((unsigned)fr[(mi < 4096) ? mi : 4095]);
      const float f[8] = {bflo(fw.x), bfhi(fw.x), bflo(fw.y), bfhi(fw.y), bflo(fw.z), bfhi(fw.z), bflo(fw.w), bfhi(fw.w)};
      const float mr[8] = {m0v, bfhi(ml.w), bflo(ml.w), bfhi(ml.z), bflo(ml.z), bfhi(ml.y), bflo(ml.y), bfhi(ml.x)};
      float v[8];
#pragma unroll
      for (int e = 0; e < 8; ++e) {
        const int k = k8 + e;
        if (k < 1024) v[e] = f[e] + ((k == 0) ? 0.f : mr[e]);
        else if (k == 1024) v[e] = bflo((unsigned)fr[1024]);
        else v[e] = f[e] - mr[e];
      }
      u32x4 o = {cvtpk(v[0], v[1]), cvtpk(v[2], v[3]), cvtpk(v[4], v[5]), cvtpk(v[6], v[7])};
      *(u32x4*)(FTF + (size_t)row * 2048 + k8) = o;
    }
  }
#pragma unroll 4
  for (int task = gw; task < M / 4; task += nw) {
    const int r = task * 4 + sub; const int b = r / T, t = r % T;
    const unsigned krp = *(const unsigned*)(P + (size_t)r * NIN + O_KR + 2 * u);
    const int posm = (u & 8) ? (t & 63) : (t >> 6); const float sgm = (u & 4) ? 1.f : -1.f;
    const f32x4 csm = *(const f32x4*)(rm + (posm * 8 + 2 * (u & 3)) * 2);
    const f32x4 gq4 = *(const f32x4*)(p->mla_qn + l * 96 + 4 * u), gk4 = *(const f32x4*)(p->mla_kn + l * 96 + 4 * u);
    const f32x2 gq2 = *(const f32x2*)(p->mla_qn + l * 96 + 64 + 2 * u), gk2 = *(const f32x2*)(p->mla_kn + l * 96 + 64 + 2 * u);
#pragma unroll
    for (int hh = 0; hh < 8; ++hh) {
      const bool isq = hh < 4; const int hd = hh & 3;
      f32x4 v; float ra, rb;
      if (isq) {
        v = unpack4(*(const u32x2*)(q1r + (size_t)r * 384 + 96 * hd + 4 * u));
        const unsigned rr = *(const unsigned*)(q1r + (size_t)r * 384 + 96 * hd + 64 + 2 * u); ra = bflo(rr); rb = bfhi(rr);
      } else {
        v = unpack4(*(const u32x2*)(krw + (size_t)r * 256 + 64 * hd + 4 * u));
        ra = bflo(krp); rb = bfhi(krp);
      }
      float ss = red16(v[0] * v[0] + v[1] * v[1] + v[2] * v[2] + v[3] * v[3] + ra * ra + rb * rb);
      const float rs = rsqrtf(ss * (1.f / 96.f) + 1e-6f);
      const f32x4 g = isq ? gq4 : gk4; const f32x2 g2 = isq ? gq2 : gk2;
#pragma unroll
      for (int e = 0; e < 4; ++e) v[e] = v[e] * rs * g[e];
      ra = ra * rs * g2[0]; rb = rb * rs * g2[1];
      if (t < SEQ) rope2(ra, rb, sgm, csm);
      if (isq) {
        const float cq = 1.4426950408889634f / __builtin_sqrtf(96.f);
#pragma unroll
        for (int e = 0; e < 4; ++e) v[e] *= cq;
        ra *= cq; rb *= cq;
      }
      bf16_t* dst = (isq ? QA : KA) + (((size_t)b * 4 + hd) * T + t) * 96;
      *(u32x2*)(dst + 4 * u) = pack4(v);
      *(unsigned*)(dst + 64 + 2 * u) = cvtpk(ra, rb);
    }
  }
}

DI void phase_mix(KP p, int l, char* lds) {
  unsigned char* ws = p->ws; asm volatile("" : "+s"(ws));
  const bf16_t* P = (const bf16_t*)(ws + WS_P);
  bf16_t* Y = (bf16_t*)(ws + WS_R1);
  bf16_t* YD = (bf16_t*)(ws + WS_YD);
  const bf16_t* QA = (const bf16_t*)(ws + WS_QA); const bf16_t* KA = (const bf16_t*)(ws + WS_KA); const bf16_t* VAT = (const bf16_t*)(ws + WS_VAT);
  const bf16_t* QB = (const bf16_t*)(ws + WS_QB); const bf16_t* KB = (const bf16_t*)(ws + WS_KB); const bf16_t* VBT = (const bf16_t*)(ws + WS_VBT);
  const bf16_t* FTF = (const bf16_t*)(ws + WS_FTF); const bf16_t* FTC = (const bf16_t*)(ws + WS_FTC);
  const bf16_t* DL = (const bf16_t*)(ws + WS_DLAT); const bf16_t* DC = (const bf16_t*)(ws + WS_DCTX);
  const bf16_t* vnT = (const bf16_t*)(ws + WS_VNT);
  const bf16_t* wsb = (const bf16_t*)(ws + WS_WS) + (size_t)l * 4 * 128 * 128;
  const bool upd = (l == 0);
  const float sbA = ((const float*)(ws + WS_SBND))[l * 2], sbB = ((const float*)(ws + WS_SBND))[l * 2 + 1];
  const int xcd = blockIdx.x & 7, lb = 2 * (blockIdx.x >> 3) + __builtin_amdgcn_readfirstlane(otid() >> 8), nlb = 2 * (gridDim.x >> 3);
  const int nDL = 64, nA = 0, nB = 0, nDC = upd ? 8 : 0, nAc = 0, nBc = 0, nCM = 72, nFN = upd ? 72 : 64;
  const int e0 = nDL, e1 = e0 + nA, e2 = e1 + nB, e3 = e2 + nDC, e4 = e3 + nAc, e5 = e4 + nBc, e6 = e5 + nCM, e7 = e6 + nFN;
  unsigned* cnt = (unsigned*)(ws + WS_CNT) + l * 288;
  const bf16_t* wf = (const bf16_t*)(ws + WS_WF) + (size_t)l * 256 * 256;
  {
    const int lbw = blockIdx.x >> 3, nlbw = gridDim.x >> 3;
    const int nW = upd ? 144 : 128;
    for (int it = lbw; it < nW; it += nlbw) {
      const bool isA = (it < 64) || (it >= 128 && it < 136);
      int b, hd, q0, k0, nk;
      if (it < 128) { const int i2 = it & 63; b = 2 * xcd + (i2 >> 5); hd = (i2 >> 3) & 3; q0 = (i2 & 7) * 256; k0 = 0; nk = T; }
      else { const int i2 = (it - 128) & 7; b = 2 * xcd + (i2 >> 2); hd = i2 & 3; q0 = SEQ; k0 = SEQ; nk = CL; }
      const size_t r0 = (size_t)b * T + q0; const size_t bh = (size_t)b * 4 + hd, bk = (size_t)b * 2 + (hd >> 1);
      if (isA) {
        if (sbA <= 30.f) attn_item8<96, true>(QA + (bh * T + q0) * 96, KA + (bh * T + k0) * 96, VAT + bh * 64 * T + k0, nk, lds, P + r0 * NIN + O_GA + 64 * hd, Y + r0 * 1024 + 64 * hd, sbA);
        else attn_item8<96, false>(QA + (bh * T + q0) * 96, KA + (bh * T + k0) * 96, VAT + bh * 64 * T + k0, nk, lds, P + r0 * NIN + O_GA + 64 * hd, Y + r0 * 1024 + 64 * hd, 0.f);
      } else {
        if (sbB <= 30.f) attn_item8<64, true>(QB + (bh * T + q0) * 64, KB + (bk * T + k0) * 64, VBT + bk * 64 * T + k0, nk, lds, P + r0 * NIN + O_GB + 64 * hd, Y + r0 * 1024 + 256 + 64 * hd, sbB);
        else attn_item8<64, false>(QB + (bh * T + q0) * 64, KB + (bk * T + k0) * 64, VBT + bk * 64 * T + k0, nk, lds, P + r0 * NIN + O_GB + 64 * hd, Y + r0 * 1024 + 256 + 64 * hd, 0.f);
      }
    }
    __syncthreads();
  }
  const int tid0 = otid() & 255;
  for (int it = lb; it < e7; it += nlb) {
    if (it >= e6) {
      const int i2 = it - e6; const int mpb = upd ? 18 : 16; const int mloc = i2 >> 1, nt = i2 & 1;
      const int mt = (2 * xcd + mloc / mpb) * 18 + (mloc % mpb);
      if (tid0 == 0) {
        unsigned sp = 0;
        while (__hip_atomic_load(&cnt[mt], __ATOMIC_RELAXED, __HIP_MEMORY_SCOPE_AGENT) < 2u) { __builtin_amdgcn_s_sleep(2); if (++sp > (1u << 24)) break; }
        __builtin_amdgcn_fence(__ATOMIC_ACQUIRE, "agent");
        asm volatile("s_waitcnt vmcnt(0)" ::: "memory");
      }
      __syncthreads();
      const int m0 = mt * 128, n0 = nt * 128;
      gemm_tile(YD + (size_t)m0 * 256, 256, wf + (size_t)n0 * 256, 256, 256, lds, [&](int m, int n, f32x4 v) {
        const size_t r = (size_t)m0 + m;
        f32x4 gd = unpack4(*(const u32x2*)(P + r * NIN + O_GD + n0 + n));
        f32x4 o = {v[0] * silu(gd[0]), v[1] * silu(gd[1]), v[2] * silu(gd[2]), v[3] * silu(gd[3])};
        *(u32x2*)(Y + r * 1024 + 768 + n0 + n) = pack4(o); });
      continue;
    }
    if (it < e0 || (it >= e2 && it < e3)) {
      const bool isl = it < e0; const int i2 = isl ? it : it - e2;
      int b, mt, nt, K; const bf16_t* Ap; const bf16_t* Bp; float sc; size_t rbase;
      if (isl) { b = 2 * xcd + (i2 >> 5); mt = (i2 >> 1) & 15; nt = i2 & 1; K = 2048; Ap = DL + (size_t)mt * 128 * 2048; Bp = FTF + ((size_t)b * 256 + nt * 128) * 2048; sc = 0.00276213586f; rbase = (size_t)b * T + mt * 128; }
      else { b = 2 * xcd + (i2 >> 2); mt = (i2 >> 1) & 1; nt = i2 & 1; K = 512; Ap = DC + (size_t)mt * 128 * 512; Bp = FTC + ((size_t)b * 256 + nt * 128) * 512; sc = 0.0078125f; rbase = (size_t)b * T + SEQ + mt * 128; }
      bf16_t* yo = YD + rbase * 256 + nt * 128;
      gemm_tile(Ap, K, Bp, K, K, lds, [&](int m, int n, f32x4 v) {
        f32x4 o = {v[0] * sc, v[1] * sc, v[2] * sc, v[3] * sc};
        *(u32x2*)(yo + (size_t)m * 256 + n) = pack4(o); });
      asm volatile("s_waitcnt vmcnt(0)" ::: "memory");
      __syncthreads();
      if (tid0 == 0) {
        __builtin_amdgcn_fence(__ATOMIC_RELEASE, "agent");
        asm volatile("s_waitcnt vmcnt(0)" ::: "memory");
        __hip_atomic_fetch_add(&cnt[b * 18 + (isl ? mt : 16 + mt)], 1u, __ATOMIC_RELAXED, __HIP_MEMORY_SCOPE_AGENT);
      }
    } else {
      const int i2 = it - e5; const int bl = i2 / 36, rem = i2 % 36; const int cpl = rem >> 2, g = rem & 3;
      const int ch = (2 * xcd + bl) * 18 + 2 * cpl;
      if (!upd && cpl >= 8) continue;
      const float* bs = p->cm_b_s + ((size_t)l * 4 + g) * 128;
      const bf16_t* Pr = P + (size_t)ch * 128 * NIN + 64 * g; bf16_t* Yr = Y + (size_t)ch * 128 * 1024 + 512 + 64 * g;
      gemm_tile(wsb + (size_t)g * 128 * 128, 128, vnT + ((size_t)ch * 256 + 64 * g) * 128, 128, 128, lds, [&](int m, int n, f32x4 v) {
        const int c2 = n >> 6, nn = n & 63;
        const size_t rr = (size_t)c2 * 128 + m;
        const float bias = bs[m];
        f32x4 uu = unpack4(*(const u32x2*)(Pr + rr * NIN + O_U + nn)), gc = unpack4(*(const u32x2*)(Pr + rr * NIN + O_GC + nn));
        f32x4 o;
#pragma unroll
        for (int e = 0; e < 4; ++e) o[e] = uu[e] * (v[e] + bias) * silu(gc[e]);
        *(u32x2*)(Yr + rr * 1024 + nn) = pack4(o);
      }, (size_t)192 * 128);
    }
  }
}

DI void phase_outproj(KP p, int l, char* lds) {
  unsigned char* ws = p->ws; asm volatile("" : "+s"(ws));
  const bf16_t* Y = (const bf16_t*)(ws + WS_R1);
  const bf16_t* wo = (const bf16_t*)(ws + WS_WOUT) + (size_t)l * 1024 * 1024;
  const float* mod = (const float*)(ws + WS_MOD) + (size_t)l * 17 * 3072;
  const float* xl = (l == 0) ? p->x : p->out;
  float* ctx1 = (float*)(ws + WS_CTX1);
  const int xcd = blockIdx.x & 7, lb = blockIdx.x >> 3, nlb = gridDim.x >> 3, hb = __builtin_amdgcn_readfirstlane(otid() >> 8);
  const int nsm = (l == 0) ? 16 : 0;
  for (int j = lb; j < 64; j += nlb) {
    {
      const int mi = j >> 2, nt = j & 3;
      const int bb = 2 * xcd + (mi >> 3), tt = mi & 7;
      const int m0 = (bb * 9 + tt) * 256, n0 = nt * 256;
      const float* src = xl + ((size_t)bb * SEQ + tt * 256) * 1024;
      float* dst = p->out + ((size_t)bb * SEQ + tt * 256) * 1024;
      const float* gt = mod + (size_t)bb * 3072 + 2048;
      gemm256(Y + (size_t)m0 * 1024, 1024, wo + (size_t)n0 * 1024, 1024, 1024, lds, [&](int m, int n, f32x4 v) {
        const size_t o = (size_t)m * 1024 + n0 + n;
        f32x4 xv = __builtin_nontemporal_load((const f32x4*)(src + o)), g = *(const f32x4*)(gt + n0 + n);
        f32x4 r = {xv[0] + g[0] * v[0], xv[1] + g[1] * v[1], xv[2] + g[2] * v[2], xv[3] + g[3] * v[3]};
        __builtin_nontemporal_store(r, (f32x4*)(dst + o)); });
    }
  }
  for (int j = lb; j < nsm; j += nlb) {
    {
      const int item = 2 * j + hb; const int bb = 2 * xcd + (item >> 4), m128 = (item >> 3) & 1, nt = item & 7;
      const int m0 = (bb * 18 + 16 + m128) * 128, n0 = nt * 128;
      const float* src = p->ctx + ((size_t)bb * CL + m128 * 128) * 1024;
      float* dst = ctx1 + ((size_t)bb * CL + m128 * 128) * 1024;
      const float* gt = mod + (size_t)16 * 3072 + 2048;
      gemm_tile(Y + (size_t)m0 * 1024, 1024, wo + (size_t)n0 * 1024, 1024, 1024, lds, [&](int m, int n, f32x4 v) {
        const size_t o = (size_t)m * 1024 + n0 + n;
        f32x4 xv = *(const f32x4*)(src + o), g = *(const f32x4*)(gt + n0 + n);
        f32x4 r = {xv[0] + g[0] * v[0], xv[1] + g[1] * v[1], xv[2] + g[2] * v[2], xv[3] + g[3] * v[3]};
        *(f32x4*)(dst + o) = r; });
    }
  }
}

__global__ void __launch_bounds__(NTHR, 2) fwd_megakernel(Params p_byval) {
  KP p = (KP)__builtin_amdgcn_kernarg_segment_ptr();
  extern __shared__ __attribute__((aligned(16))) char lds[];
  cg::grid_group grid = cg::this_grid();
  uint4* xbw = (uint4*)(lds + LDS_MAIN);
  if (threadIdx.x == 0) *xbw = make_uint4(0u, 0u, 0u, 0u);
  __syncthreads();
  XcdBarrier xb = xcd_barrier_post((unsigned*)(p->ws + WS_BAR), (volatile LAS unsigned*)xbw);
  if (p->ph_hi < p->ph_lo) grid.sync();
  (void)p_byval;
  for (int ph = p->ph_lo; ph < p->ph_hi; ++ph) {
    asm volatile("" : "+s"(p));
    if (ph == 0) phase0(p, lds);
    else {
      const int l = (ph - 1) / 7, s = (ph - 1) % 7;
      switch (s) {
        case 0: phase_norm(p, l); break;
        case 1: phase_inproj(p, l, lds); break;
        case 2: phase_feat_a(p, l, lds); break;
        case 3: phase_feat_b(p, l, lds); break;
        case 4: phase_feat_c(p, l); break;
        case 5: phase_mix(p, l, lds); break;
        default: phase_outproj(p, l, lds); break;
      }
    }
    if (ph + 1 < p->ph_hi) xcd_barrier(xb);
  }
}

extern "C" void kernel_launch(void* const* d_in, const int* in_sizes, int n_in, void* d_out, int out_size, void* d_ws, size_t ws_size, hipStream_t stream) {
  static int grid_blocks = 0;
  if (!grid_blocks) {
    int dev = 0, cus = 0, per_cu = 0;
    hipGetDevice(&dev);
    hipDeviceGetAttribute(&cus, hipDeviceAttributeMultiprocessorCount, dev);
    hipFuncSetAttribute((const void*)fwd_megakernel, hipFuncAttributeMaxDynamicSharedMemorySize, LDS_BYTES);
    hipOccupancyMaxActiveBlocksPerMultiprocessor(&per_cu, fwd_megakernel, NTHR, LDS_BYTES);
    if (per_cu > 1) per_cu = 1;
    if (per_cu < 1) per_cu = 1;
    grid_blocks = cus * per_cu;
    if (ws_size < WS_END) fprintf(stderr, "kernel_launch: workspace too small: %zu < %zu\n", ws_size, (size_t)WS_END);
  }
  hipMemsetAsync((unsigned char*)d_ws + WS_BAR, 0, WS_ZERO_BYTES, stream);
  Params p{};
  const float** pp = (const float**)&p;
  for (int i = 0; i < 22; ++i) pp[i] = (const float*)d_in[i];
  p.out = (float*)d_out; p.ws = (unsigned char*)d_ws;
  constexpr int NPH = 15;
#if PER_PHASE_LAUNCH
  for (int ph = 0; ph < NPH; ++ph) {
    p.ph_lo = ph; p.ph_hi = ph + 1;
    hipLaunchKernelGGL(fwd_megakernel, dim3(grid_blocks), dim3(NTHR), LDS_BYTES, stream, p);
  }
#else
  p.ph_lo = 0; p.ph_hi = NPH;
  void* args[] = {&p};
  hipError_t e = hipLaunchCooperativeKernel((void*)fwd_megakernel, dim3(grid_blocks), dim3(NTHR), args, LDS_BYTES, stream);
  if (e != hipSuccess) fprintf(stderr, "cooperative launch failed: %s (grid %d)\n", hipGetErrorString(e), grid_blocks);
#endif
}
```
